# Optimizing an MI355X kernel written in HIP

```python
import math
import jax, jax.numpy as jnp
from jax import lax
import numpy as np

D_MODEL = 1024
BATCH = 2
SEQ = 8192
DEPTH = 2

HEAD_DIM = 64
RET_HEADS = 4
FOX_HEADS = 4
RWKV_HEADS = 4
RET_W = RET_HEADS * HEAD_DIM
FOX_W = FOX_HEADS * HEAD_DIM
RWKV_W = RWKV_HEADS * HEAD_DIM
RET_CHUNK = 128
FOX_BLOCK = 128
ROPE_BASE = 10000.0
DECAY_LORA = 64
AAA_LORA = 64
GATE_LORA = 128
N_BRANCH = 3
D_FF = -(-(8 * D_MODEL) // (3 * 256)) * 256
NORM_EPS = 1e-6
RET_GN_EPS = 1e-5
RWKV_GN_EPS = 64e-5

RET_COLS = 4 * RET_W
FOX_COLS = 3 * FOX_W + FOX_HEADS
RWKV_COLS = 3 * RWKV_W + DECAY_LORA + AAA_LORA + GATE_LORA
GATE_COLS = N_BRANCH * D_MODEL
IN_COLS = RET_COLS + FOX_COLS + RWKV_COLS + GATE_COLS

kernel_name = "hybrid_retention_fox_rwkv7_gated_block"


def _rmsnorm(x, g, eps=NORM_EPS):
    xf = x.astype(jnp.float32)
    y = xf * lax.rsqrt(jnp.mean(xf * xf, axis=-1, keepdims=True) + eps)
    return (y * g.astype(jnp.float32)).astype(x.dtype)


def _head_layernorm(y, eps):
    mu = jnp.mean(y, axis=-1, keepdims=True)
    var = jnp.mean(jnp.square(y - mu), axis=-1, keepdims=True)
    return (y - mu) * lax.rsqrt(var + eps)


def _heads(t, n_heads):
    B, S, _ = t.shape
    return t.reshape(B, S, n_heads, HEAD_DIM).transpose(0, 2, 1, 3)


def _rotary(t, pos):
    half = HEAD_DIM // 2
    inv_freq = ROPE_BASE ** (-jnp.arange(half, dtype=jnp.float32) / half)
    ang = pos[:, None] * inv_freq[None, :]
    cos, sin = jnp.cos(ang), jnp.sin(ang)
    t1, t2 = t[..., :half], t[..., half:]
    return jnp.concatenate([t1 * cos - t2 * sin, t1 * sin + t2 * cos], axis=-1)


def _retention(q, k, v):
    B, H, S, Dh = q.shape
    C = RET_CHUNK
    N = S // C
    log_gamma = jnp.log1p(-jnp.exp2(-5.0 - jnp.arange(H, dtype=jnp.float32)))
    q = q.reshape(B, H, N, C, Dh)
    k = (k * Dh ** -0.5).reshape(B, H, N, C, Dh)
    v = v.reshape(B, H, N, C, Dh)
    idx = jnp.arange(C, dtype=jnp.float32)
    dist = idx[:, None] - idx[None, :]
    lg = log_gamma[:, None, None]
    dmat = jnp.where(dist >= 0, jnp.exp(lg * jnp.maximum(dist, 0.0)), 0.0)
    scores = jnp.einsum('bhnid,bhnjd->bhnij', q, k) * dmat[None, :, None]
    inner = jnp.einsum('bhnij,bhnjd->bhnid', scores, v)
    k_dec = jnp.exp(log_gamma[:, None] * (C - 1 - idx)[None, :])
    upd = jnp.einsum('bhnjd,bhnje->bhnde', k * k_dec[None, :, None, :, None], v)
    chunk_dec = jnp.exp(log_gamma * C)[None, :, None, None]

    def step(R, u):
        return R * chunk_dec + u, R

    _, r_prev = lax.scan(step, jnp.zeros((B, H, Dh, Dh), jnp.float32), jnp.moveaxis(upd, 2, 0))
    r_prev = jnp.moveaxis(r_prev, 0, 2)
    q_dec = jnp.exp(log_gamma[:, None] * (idx + 1.0)[None, :])
    cross = jnp.einsum('bhnid,bhnde->bhnie', q * q_dec[None, :, None, :, None], r_prev)
    return (inner + cross).reshape(B, H, S, Dh)


def _retention_branch(cols, gn_gain):
    B, S, _ = cols.shape
    q, k, v, g = jnp.split(cols, 4, axis=-1)
    pos = jnp.arange(S, dtype=jnp.float32)
    q = _rotary(_heads(q, RET_HEADS), pos)
    k = _rotary(_heads(k, RET_HEADS), pos)
    y = _retention(q, k, _heads(v, RET_HEADS))
    y = _head_layernorm(y, RET_GN_EPS).transpose(0, 2, 1, 3).reshape(B, S, RET_W)
    return jax.nn.silu(g) * (y * gn_gain)


def _forgetting_attention(q, k, v, log_f):
    B, H, S, Dh = q.shape
    c = jnp.cumsum(log_f, axis=-1)
    scale = Dh ** -0.5
    kpos = jnp.arange(S)
    n_blocks = S // FOX_BLOCK

    def block(i):
        t0 = i * FOX_BLOCK
        qb = lax.dynamic_slice_in_dim(q, t0, FOX_BLOCK, axis=2)
        cb = lax.dynamic_slice_in_dim(c, t0, FOX_BLOCK, axis=2)
        logits = jnp.einsum('bhqd,bhkd->bhqk', qb, k) * scale + cb[..., None] - c[:, :, None, :]
        qpos = t0 + jnp.arange(FOX_BLOCK)
        logits = jnp.where(kpos[None, :] <= qpos[:, None], logits, -jnp.inf)
        p = jax.nn.softmax(logits, axis=-1)
        return jnp.einsum('bhqk,bhkd->bhqd', p, v)

    out = lax.map(block, jnp.arange(n_blocks))
    return jnp.moveaxis(out, 0, 2).reshape(B, H, S, Dh)


def _fox_branch(cols, f_bias, q_gain, k_gain):
    B, S, _ = cols.shape
    q, k, v, f = jnp.split(cols, [FOX_W, 2 * FOX_W, 3 * FOX_W], axis=-1)
    q = _rmsnorm(_heads(q, FOX_HEADS), q_gain)
    k = _rmsnorm(_heads(k, FOX_HEADS), k_gain)
    log_f = jax.nn.log_sigmoid(f + f_bias).transpose(0, 2, 1)
    y = _forgetting_attention(q, k, _heads(v, FOX_HEADS), log_f)
    return y.transpose(0, 2, 1, 3).reshape(B, S, FOX_W)


def _rwkv7_scan(r, w, k, v, a, b):
    B, S, H, Dh = r.shape

    def step(state, inp):
        r_t, w_t, k_t, v_t, a_t, b_t = inp
        sa = jnp.einsum('bhvk,bhk->bhv', state, a_t)
        state = (state * w_t[:, :, None, :] + sa[..., None] * b_t[:, :, None, :]
                 + v_t[..., None] * k_t[:, :, None, :])
        return state, jnp.einsum('bhvk,bhk->bhv', state, r_t)

    xs = tuple(jnp.moveaxis(t, 1, 0) for t in (r, w, k, v, a, b))
    _, y = lax.scan(step, jnp.zeros((B, H, Dh, Dh), jnp.float32), xs)
    return jnp.moveaxis(y, 0, 1)


def _rwkv7_branch(cols, mu, w0, w2, a0, a2, g2, k_k, k_a, r_k, gn_gain):
    B, S, _ = cols.shape
    prev = jnp.pad(cols[:, :-1], ((0, 0), (1, 0), (0, 0)))
    cols = cols + (prev - cols) * mu
    r, k, v, xw, xa, xg = jnp.split(
        cols, [RWKV_W, 2 * RWKV_W, 3 * RWKV_W, 3 * RWKV_W + DECAY_LORA,
               3 * RWKV_W + DECAY_LORA + AAA_LORA], axis=-1)
    w_pre = -jax.nn.softplus(-(w0 + jnp.tanh(xw) @ w2)) - 0.5
    decay = jnp.exp(-jnp.exp(w_pre))
    a = jax.nn.sigmoid(a0 + xa @ a2)
    g = jax.nn.sigmoid(xg) @ g2
    hd = lambda t: t.reshape(B, S, RWKV_HEADS, HEAD_DIM)
    kk = hd(k * k_k)
    kk = kk / jnp.maximum(jnp.sqrt(jnp.sum(kk * kk, axis=-1, keepdims=True)), 1e-12)
    k = k * (1.0 + (a - 1.0) * k_a)
    r_h, k_h, v_h, a_h = hd(r), hd(k), hd(v), hd(a)
    y = _rwkv7_scan(r_h, hd(decay), k_h, v_h, -kk, kk * a_h)
    y = _head_layernorm(y, RWKV_GN_EPS).reshape(B, S, RWKV_W) * gn_gain
    r_k_h = r_k.reshape(RWKV_HEADS, HEAD_DIM)
    bonus = jnp.sum(r_h * k_h * r_k_h, axis=-1, keepdims=True) * v_h
    return (y + bonus.reshape(B, S, RWKV_W)) * g


def setup_inputs(seed: int = 0) -> dict:
    key = jax.random.key(seed)
    ks = jax.random.split(key, 32)
    f32 = jnp.float32
    nrm = lambda k, shape, s: (jax.random.normal(k, shape, f32) * s)
    L, D = DEPTH, D_MODEL
    return {
        "x": nrm(ks[0], (BATCH, SEQ, D), 1.0),
        "mix_norm": 1.0 + nrm(ks[1], (L, D), 0.02),
        "w_in": nrm(ks[2], (L, D, IN_COLS), D ** -0.5),
        "ret_gn": 1.0 + nrm(ks[3], (L, RET_W), 0.02),
        "fox_q_norm": 1.0 + nrm(ks[4], (L, HEAD_DIM), 0.02),
        "fox_k_norm": 1.0 + nrm(ks[5], (L, HEAD_DIM), 0.02),
        "fox_f_bias": 2.0 + nrm(ks[6], (L, FOX_HEADS), 0.5),
        "rwkv_mu": jax.random.uniform(ks[7], (L, RWKV_COLS), f32),
        "rwkv_w0": nrm(ks[8], (L, RWKV_W), 0.5),
        "rwkv_w2": nrm(ks[9], (L, DECAY_LORA, RWKV_W), 0.1),
        "rwkv_a0": nrm(ks[10], (L, RWKV_W), 0.1),
        "rwkv_a2": nrm(ks[11], (L, AAA_LORA, RWKV_W), 0.1),
        "rwkv_g2": nrm(ks[12], (L, GATE_LORA, RWKV_W), GATE_LORA ** -0.5),
        "rwkv_k_k": 0.85 + nrm(ks[13], (L, RWKV_W), 0.02),
        "rwkv_k_a": 1.0 + nrm(ks[14], (L, RWKV_W), 0.02),
        "rwkv_r_k": nrm(ks[15], (L, RWKV_W), 0.1),
        "rwkv_gn": 1.0 + nrm(ks[16], (L, RWKV_W), 0.02),
        "p_ret": nrm(ks[17], (L, RET_W, D), RET_W ** -0.5),
        "p_fox": nrm(ks[18], (L, FOX_W, D), FOX_W ** -0.5),
        "p_rwkv": nrm(ks[19], (L, RWKV_W, D), RWKV_W ** -0.5),
        "w_out": nrm(ks[20], (L, D, D), D ** -0.5),
        "ffn_norm": 1.0 + nrm(ks[21], (L, D), 0.02),
        "w_gate_up": nrm(ks[22], (L, D, 2 * D_FF), D ** -0.5),
        "w_down": nrm(ks[23], (L, D_FF, D), D_FF ** -0.5),
    }


def reference(x, mix_norm, w_in, ret_gn, fox_q_norm, fox_k_norm, fox_f_bias,
              rwkv_mu, rwkv_w0, rwkv_w2, rwkv_a0, rwkv_a2, rwkv_g2, rwkv_k_k, rwkv_k_a,
              rwkv_r_k, rwkv_gn, p_ret, p_fox, p_rwkv, w_out, ffn_norm, w_gate_up, w_down):
    B, S, D = x.shape
    splits = [RET_COLS, RET_COLS + FOX_COLS, RET_COLS + FOX_COLS + RWKV_COLS]
    for l in range(DEPTH):
        h = _rmsnorm(x, mix_norm[l])
        proj = (h @ w_in[l]).astype(jnp.float32)
        ret_c, fox_c, rwkv_c, gate_c = jnp.split(proj, splits, axis=-1)
        y_ret = _retention_branch(ret_c, ret_gn[l])
        y_fox = _fox_branch(fox_c, fox_f_bias[l], fox_q_norm[l], fox_k_norm[l])
        y_rwkv = _rwkv7_branch(rwkv_c, rwkv_mu[l], rwkv_w0[l], rwkv_w2[l], rwkv_a0[l],
                               rwkv_a2[l], rwkv_g2[l], rwkv_k_k[l], rwkv_k_a[l],
                               rwkv_r_k[l], rwkv_gn[l])
        gates = jax.nn.sigmoid(gate_c).astype(x.dtype).reshape(B, S, N_BRANCH, D)
        merged = (gates[:, :, 0] * (y_ret.astype(x.dtype) @ p_ret[l])
                  + gates[:, :, 1] * (y_fox.astype(x.dtype) @ p_fox[l])
                  + gates[:, :, 2] * (y_rwkv.astype(x.dtype) @ p_rwkv[l]))
        x = x + merged @ w_out[l]
        h = _rmsnorm(x, ffn_norm[l])
        gu = h @ w_gate_up[l]
        g, u = jnp.split(gu, 2, axis=-1)
        x = x + (jax.nn.silu(g) * u) @ w_down[l]
    return x
```

```cpp
#include <hip/hip_runtime.h>
#include <cstdio>
#include <cstdint>
#include <cmath>
namespace pg8 {
#define PG8_LAS __attribute__((address_space(3)))
typedef unsigned short bf16_t;
typedef short bf16x8 __attribute__((ext_vector_type(8)));
typedef float f32x4 __attribute__((ext_vector_type(4)));
typedef unsigned u32x4 __attribute__((ext_vector_type(4)));
constexpr int BM = 256, BK = 64, HALF = 128, HTB = HALF * BK * 2  , STAGE_BYTES = 8 * HTB, NXCD = 8, WGM = 8;

__host__ __device__ __forceinline__ int lds_byte(int r, int c) { const int st = (r >> 4) * 2 + (c >> 5), rr = r & 15, cc = c & 31, ob = rr * 64 + cc * 2; return st * 1024 + (ob ^ (((ob >> 9) & 1) << 5)); }
__host__ __device__ __forceinline__ void stage_rc(int b, int& R, int& C) { const int st = b / 1024, sb = b % 1024, swz = sb ^ (((sb >> 9) & 1) << 5); R = (st >> 1) * 16 + swz / 64; C = (st & 1) * 32 + (swz % 64) / 2; }
__host__ __device__ __forceinline__ int perm32(int rho) { const int n = rho >> 4, i = rho & 15; return 8 * (i >> 2) + 4 * n + (i & 3); }

struct Unit { int pm, pn; };
struct Gemm { const bf16_t* A; const bf16_t* Bt; int M, N, K; };

struct StaticOrder {
    int nM, nN, nwg, G, c;
    __host__ __device__ void init(int M, int N, int G_, int c_) { nM = M / BM; nN = N / BM; nwg = nM * nN; G = G_; c = c_; }
    __host__ __device__ bool next(int i, Unit& u) const {
        const long L = (long)i * G + c; if (L >= nwg) return false;
        int wgid = (int)L; { const int q = nwg / NXCD, r = nwg % NXCD, xcd = wgid % NXCD, off = wgid / NXCD; wgid = (xcd < r ? xcd * (q + 1) : r * (q + 1) + (xcd - r) * q) + off; }
        const int nig = WGM * nN, gid = wgid / nig, fm = gid * WGM, gsz = (nM - fm) < WGM ? (nM - fm) : WGM;
        u.pm = fm + ((wgid % nig) % gsz); u.pn = (wgid % nig) / gsz; return true;
    }
    __device__ __forceinline__ void a_ready(const Unit&) const {}
    __device__ __forceinline__ void done(const Unit&) const {}
};

typedef unsigned u32x4 __attribute__((ext_vector_type(4)));
__device__ __forceinline__ unsigned f2bf_(float f) { unsigned u = __builtin_bit_cast(unsigned, f); return (u + 0x7fffu + ((u >> 16) & 1u)) >> 16; }
__device__ __forceinline__ unsigned pk2_(float lo, float hi) { return f2bf_(lo) | (f2bf_(hi) << 16); }
__device__ __forceinline__ float bflo_(unsigned w) { return __builtin_bit_cast(float, w << 16); }
__device__ __forceinline__ float bfhi_(unsigned w) { return __builtin_bit_cast(float, w & 0xffff0000u); }
__device__ __forceinline__ float rstd_of(const float* ss, int row) {
    const f32x4* p = (const f32x4*)(ss + (unsigned)row * 16u);
    const f32x4 a = p[0], b = p[1], c = p[2], d = p[3];
    const float s = ((a[0] + a[1]) + (a[2] + a[3])) + ((b[0] + b[1]) + (b[2] + b[3])) + ((c[0] + c[1]) + (c[2] + c[3])) + ((d[0] + d[1]) + (d[2] + d[3]));
    return 1.0f / sqrtf(s * (1.0f / 1024.0f) + 1e-6f);
}
__device__ __forceinline__ float sigmoidf_(float x) { return 1.0f / (1.0f + __expf(-x)); }

template <int ACT> struct EpiScale {
    static constexpr bool PERM = true, AFTER_DRAIN = false;
    bf16_t* O; int ldc; const float* ss; float* flog; int flog_tile; int store_tiles;
    __device__ __forceinline__ void operator()(const f32x4 (&acc)[2][2][4][2], const Unit& u, int wr, int wc, int fr, int fq) const {
        const int row0 = u.pm * BM + wr * 64 + fr, col0 = u.pn * BM + wc * 32 + 8 * fq;
#pragma unroll
        for (int ai = 0; ai < 2; ++ai)
#pragma unroll
            for (int m = 0; m < 4; ++m) { const int row = row0 + ai * HALF + m * 16; const float rs = rstd_of(ss, row);
#pragma unroll
                for (int bj = 0; bj < 2; ++bj) { f32x4 v0 = acc[ai][bj][m][0] * rs, v1 = acc[ai][bj][m][1] * rs;
                    if (ACT == 1) { v0 = (f32x4){sigmoidf_(v0[0]), sigmoidf_(v0[1]), sigmoidf_(v0[2]), sigmoidf_(v0[3])}; v1 = (f32x4){sigmoidf_(v1[0]), sigmoidf_(v1[1]), sigmoidf_(v1[2]), sigmoidf_(v1[3])}; }
                    if (u.pn < store_tiles) { u32x4 w; w.x = pk2_(v0[0], v0[1]); w.y = pk2_(v0[2], v0[3]); w.z = pk2_(v1[0], v1[1]); w.w = pk2_(v1[2], v1[3]);
                        *(u32x4*)(O + ((unsigned)row * (unsigned)ldc + (unsigned)(col0 + bj * HALF))) = w; }
                    if (u.pn == flog_tile && bj == 0 && wc == 0 && fq == 0) *(f32x4*)(flog + (unsigned)row * 4u) = v0; }
                asm volatile("" ::: "memory"); }
    }
};
template <int FIRST> struct EpiBranch {
    static constexpr bool PERM = true, AFTER_DRAIN = false;
    bf16_t* T; const bf16_t* gates; int gcol0;
    __device__ __forceinline__ void operator()(const f32x4 (&acc)[2][2][4][2], const Unit& u, int wr, int wc, int fr, int fq) const {
        const int row0 = u.pm * BM + wr * 64 + fr, col0 = u.pn * BM + wc * 32 + 8 * fq;
#pragma unroll
        for (int ai = 0; ai < 2; ++ai)
#pragma unroll
            for (int m = 0; m < 4; ++m) { const int row = row0 + ai * HALF + m * 16;
#pragma unroll
                for (int bj = 0; bj < 2; ++bj) { const int col = col0 + bj * HALF;
                    const unsigned toff = (unsigned)row * 1024u + (unsigned)col; const u32x4 g = *(const u32x4*)(gates + ((unsigned)row * 3072u + (unsigned)(gcol0 + col)));
                    u32x4 p = (u32x4){0u, 0u, 0u, 0u}; if (!FIRST) p = *(const u32x4*)(T + toff);
                    const f32x4 a0 = acc[ai][bj][m][0], a1 = acc[ai][bj][m][1];
                    u32x4 w;
                    w.x = pk2_(bflo_(p.x) + bflo_(g.x) * a0[0], bfhi_(p.x) + bfhi_(g.x) * a0[1]);
                    w.y = pk2_(bflo_(p.y) + bflo_(g.y) * a0[2], bfhi_(p.y) + bfhi_(g.y) * a0[3]);
                    w.z = pk2_(bflo_(p.z) + bflo_(g.z) * a1[0], bfhi_(p.z) + bfhi_(g.z) * a1[1]);
                    w.w = pk2_(bflo_(p.w) + bflo_(g.w) * a1[2], bfhi_(p.w) + bfhi_(g.w) * a1[3]);
                    *(u32x4*)(T + toff) = w; asm volatile("" ::: "memory"); } }
    }
};
struct EpiResid {
    static constexpr bool PERM = true, AFTER_DRAIN = false;
    float* X; bf16_t* XBo; float* ss;
    __device__ __forceinline__ void operator()(const f32x4 (&acc)[2][2][4][2], const Unit& u, int wr, int wc, int fr, int fq) const {
        const int row0 = u.pm * BM + wr * 64 + fr, col0 = u.pn * BM + wc * 32 + 8 * fq;
#pragma unroll
        for (int ai = 0; ai < 2; ++ai)
#pragma unroll
            for (int m = 0; m < 4; ++m) { const int row = row0 + ai * HALF + m * 16; float q = 0.f;
#pragma unroll
                for (int bj = 0; bj < 2; ++bj) { const int col = col0 + bj * HALF; const unsigned xoff = (unsigned)row * 1024u + (unsigned)col; float* xp = X + xoff;
                    const f32x4 v0 = *(const f32x4*)xp + acc[ai][bj][m][0], v1 = *(const f32x4*)(xp + 4) + acc[ai][bj][m][1];
                    *(f32x4*)xp = v0; *(f32x4*)(xp + 4) = v1;
                    u32x4 w; w.x = pk2_(v0[0], v0[1]); w.y = pk2_(v0[2], v0[3]); w.z = pk2_(v1[0], v1[1]); w.w = pk2_(v1[2], v1[3]);
                    *(u32x4*)(XBo + xoff) = w;
                    q += (v0[0] * v0[0] + v0[1] * v0[1]) + (v0[2] * v0[2] + v0[3] * v0[3]) + (v1[0] * v1[0] + v1[1] * v1[1]) + (v1[2] * v1[2] + v1[3] * v1[3]); }
                q += __shfl_xor(q, 16); q += __shfl_xor(q, 32);
                if (fq == 0) ss[(unsigned)row * 16u + (unsigned)(u.pn * 4 + wc)] = q; asm volatile("" ::: "memory"); }
    }
};
struct EpiSwiglu {
    static constexpr bool PERM = true, AFTER_DRAIN = false;
    bf16_t* H; const float* ss;
    __device__ __forceinline__ void operator()(const f32x4 (&acc)[2][2][4][2], const Unit& u, int wr, int wc, int fr, int fq) const {
        const int row0 = u.pm * BM + wr * 64 + fr, col0 = u.pn * HALF + wc * 32 + 8 * fq;
#pragma unroll
        for (int ai = 0; ai < 2; ++ai)
#pragma unroll
            for (int m = 0; m < 4; ++m) { const int row = row0 + ai * HALF + m * 16; const float rs = rstd_of(ss, row);
                float h[8];
#pragma unroll
                for (int n = 0; n < 2; ++n)
#pragma unroll
                    for (int i = 0; i < 4; ++i) { const float g = acc[ai][0][m][n][i] * rs, uu = acc[ai][1][m][n][i] * rs; h[4 * n + i] = g * sigmoidf_(g) * uu; }
                u32x4 w; w.x = pk2_(h[0], h[1]); w.y = pk2_(h[2], h[3]); w.z = pk2_(h[4], h[5]); w.w = pk2_(h[6], h[7]);
                *(u32x4*)(H + ((unsigned)row * 2816u + (unsigned)col0)) = w; asm volatile("" ::: "memory"); }
    }
};
template <class Epi, class Sched, bool ALIGN_EPI = false, bool SP2 = false>
__device__ __forceinline__ void gemm_phase(PG8_LAS unsigned char* lds, const Gemm g, const Sched& S, const Epi& E, const int tid) {
    const int wid = __builtin_amdgcn_readfirstlane(tid >> 6), lane = tid & 63, wr = wid >> 2, wc = wid & 3, fr = lane & 15, fq = lane >> 4;
    const int K = g.K, nt = K / BK;
    unsigned voffA[2], voffB[2];
#pragma unroll
    for (int i = 0; i < 2; ++i) { int R, C; stage_rc(tid * 16 + i * 8192, R, C); const int Rb = Epi::PERM ? ((R & ~31) + perm32(R & 31)) : R;
        voffA[i] = (unsigned)(R * K + C) * 2u; voffB[i] = (unsigned)(Rb * K + C) * 2u; }
    const size_t kstep = (size_t)(BK * 2);
    const size_t hstep = (size_t)HALF * K * 2;
    const size_t tstep = 2 * hstep;
    const unsigned ldsw = (unsigned)wid * 1024u;
    const int aoff = lds_byte(wr * 64 + fr, fq * 8), boff = lds_byte(wc * 32 + fr, fq * 8);
#define PG8_SA(b, h) (((b) * 2 + (h)) * HTB)
#define PG8_SB(b, h) ((4 + (b) * 2 + (h)) * HTB)
#define PG8_STAGE(bufoff, gbase, voff) do { _Pragma("unroll") for (int _i = 0; _i < 2; ++_i) \
        __builtin_amdgcn_global_load_lds((const unsigned*)((const char*)(gbase) + (voff)[_i]), (PG8_LAS unsigned*)(lds + (bufoff) + ldsw + _i * 8192), 16, 0, 0); } while (0)
#define PG8_LDA(dst, b, h) do { _Pragma("unroll") for (int m = 0; m < 4; ++m) _Pragma("unroll") for (int k = 0; k < 2; ++k) dst[m][k] = *(const PG8_LAS bf16x8*)(lds + PG8_SA(b, h) + aoff + m * 2048 + k * 1024); } while (0)
#define PG8_LDB(dst, b, h) do { _Pragma("unroll") for (int n = 0; n < 2; ++n) _Pragma("unroll") for (int k = 0; k < 2; ++k) dst[n][k] = *(const PG8_LAS bf16x8*)(lds + PG8_SB(b, h) + boff + n * 2048 + k * 1024); } while (0)
#define PG8_MMA(ai, bj, At, Bt) do { __builtin_amdgcn_s_setprio(1); _Pragma("unroll") for (int m = 0; m < 4; ++m) _Pragma("unroll") for (int n = 0; n < 2; ++n) _Pragma("unroll") for (int k = 0; k < 2; ++k) \
        acc[ai][bj][m][n] = __builtin_amdgcn_mfma_f32_16x16x32_bf16(Bt[n][k], At[m][k], acc[ai][bj][m][n], 0, 0, 0); __builtin_amdgcn_s_setprio(0); } while (0)
#define PG8_WAIT_V(n) asm volatile("s_waitcnt vmcnt(" #n ")" ::: "memory")
#define PG8_WAIT_L(n) asm volatile("s_waitcnt lgkmcnt(" #n ")" ::: "memory")
#define PG8_BAR __builtin_amdgcn_s_barrier()
#define PG8_SCHED __builtin_amdgcn_sched_barrier(0)
    Unit cur, nxt; int ui = 0;
    if (!S.next(0, cur)) return;
    f32x4 acc[2][2][4][2];
#pragma unroll
    for (int a = 0; a < 2; ++a)
#pragma unroll
        for (int b = 0; b < 2; ++b)
#pragma unroll
            for (int m = 0; m < 4; ++m)
#pragma unroll
                for (int n = 0; n < 2; ++n) acc[a][b][m][n] = (f32x4){0.f, 0.f, 0.f, 0.f};
    bf16x8 At[4][2], B0[2][2], B1[2][2];
    const char* cA = (const char*)g.A + (size_t)cur.pm * tstep; const char* cB = (const char*)g.Bt + (size_t)cur.pn * tstep;
    S.a_ready(cur);
    if constexpr (SP2) {
        PG8_STAGE(PG8_SB(0, 0), cB, voffB); PG8_STAGE(PG8_SB(0, 1), cB + hstep, voffB); PG8_STAGE(PG8_SA(0, 0), cA, voffA); PG8_STAGE(PG8_SA(0, 1), cA + hstep, voffA);
        if (wr == 1) PG8_BAR;
        PG8_WAIT_V(2); PG8_BAR;
        PG8_STAGE(PG8_SB(1, 0), cB + kstep, voffB); PG8_STAGE(PG8_SA(1, 0), cA + kstep, voffA); PG8_STAGE(PG8_SB(1, 1), cB + hstep + kstep, voffB);
        PG8_WAIT_V(6); PG8_BAR;
    } else {
        PG8_STAGE(PG8_SB(0, 0), cB, voffB); PG8_STAGE(PG8_SA(0, 0), cA, voffA); PG8_STAGE(PG8_SB(0, 1), cB + hstep, voffB); PG8_STAGE(PG8_SA(0, 1), cA + hstep, voffA);
        if (wr == 1) PG8_BAR;
        PG8_WAIT_V(4); PG8_BAR;
        PG8_STAGE(PG8_SB(1, 0), cB + kstep, voffB); PG8_STAGE(PG8_SA(1, 0), cA + kstep, voffA); PG8_STAGE(PG8_SB(1, 1), cB + hstep + kstep, voffB);
        PG8_WAIT_V(6); PG8_BAR;
    }
    for (;;) {
        const bool has_next = S.next(ui + 1, nxt);
        const char* nA = has_next ? (const char*)g.A + (size_t)nxt.pm * tstep : cA; const char* nB = has_next ? (const char*)g.Bt + (size_t)nxt.pn * tstep : cB;
        for (int t = 0; t < nt; t += 2) {
            const bool last = (t == nt - 2);
            const char* a1 = cA + (size_t)(t + 1) * kstep;
            const char* a2 = last ? nA : cA + (size_t)(t + 2) * kstep; const char* b2 = last ? nB : cB + (size_t)(t + 2) * kstep;
            const char* a3 = a2 + kstep; const char* b3 = b2 + kstep;
            if (last && has_next) S.a_ready(nxt);
            if constexpr (SP2) {
            PG8_LDB(B0, 0, 0); PG8_LDB(B1, 0, 1); PG8_SCHED; PG8_LDA(At, 0, 0); PG8_STAGE(PG8_SA(1, 1), a1 + hstep, voffA);
            PG8_WAIT_V(8); PG8_WAIT_L(0); PG8_BAR; PG8_MMA(0, 0, At, B0); PG8_MMA(0, 1, At, B1); PG8_BAR; PG8_SCHED;
            PG8_LDA(At, 0, 1); PG8_STAGE(PG8_SB(0, 0), b2, voffB); PG8_STAGE(PG8_SB(0, 1), b2 + hstep, voffB); PG8_STAGE(PG8_SA(0, 0), a2, voffA);
            PG8_WAIT_V(8); PG8_WAIT_L(0); PG8_BAR; PG8_MMA(1, 0, At, B0); PG8_MMA(1, 1, At, B1); PG8_BAR; PG8_SCHED;
            PG8_LDB(B0, 1, 0); PG8_LDB(B1, 1, 1); PG8_SCHED; PG8_LDA(At, 1, 0); PG8_STAGE(PG8_SA(0, 1), a2 + hstep, voffA);
            PG8_WAIT_V(8); PG8_WAIT_L(0); PG8_BAR; PG8_MMA(0, 0, At, B0); PG8_MMA(0, 1, At, B1); PG8_BAR; PG8_SCHED;
            PG8_LDA(At, 1, 1); PG8_STAGE(PG8_SB(1, 0), b3, voffB); PG8_STAGE(PG8_SB(1, 1), b3 + hstep, voffB); PG8_STAGE(PG8_SA(1, 0), a3, voffA);
            PG8_WAIT_V(8); PG8_WAIT_L(0); PG8_BAR; PG8_MMA(1, 0, At, B0); PG8_MMA(1, 1, At, B1); PG8_BAR; PG8_SCHED;
            } else {
            PG8_LDB(B0, 0, 0); PG8_SCHED; PG8_LDA(At, 0, 0); PG8_STAGE(PG8_SA(1, 1), a1 + hstep, voffA);
            PG8_WAIT_L(8); PG8_BAR; PG8_WAIT_L(0); PG8_MMA(0, 0, At, B0); PG8_BAR; PG8_SCHED;
            PG8_LDB(B1, 0, 1); PG8_STAGE(PG8_SB(0, 0), b2, voffB);
            PG8_BAR; PG8_WAIT_L(0); PG8_MMA(0, 1, At, B1); PG8_BAR;
            PG8_LDA(At, 0, 1); PG8_STAGE(PG8_SA(0, 0), a2, voffA);
            PG8_BAR; PG8_WAIT_L(0); PG8_MMA(1, 0, At, B0); PG8_BAR; PG8_SCHED;
            PG8_STAGE(PG8_SB(0, 1), b2 + hstep, voffB);
            PG8_WAIT_V(6); PG8_BAR; PG8_MMA(1, 1, At, B1); PG8_BAR;
            PG8_LDB(B0, 1, 0); PG8_SCHED; PG8_LDA(At, 1, 0); PG8_STAGE(PG8_SA(0, 1), a2 + hstep, voffA);
            PG8_WAIT_L(8); PG8_BAR; PG8_WAIT_L(0); PG8_MMA(0, 0, At, B0); PG8_BAR; PG8_SCHED;
            PG8_LDB(B1, 1, 1); PG8_STAGE(PG8_SB(1, 0), b3, voffB);
            PG8_BAR; PG8_WAIT_L(0); PG8_MMA(0, 1, At, B1); PG8_BAR;
            PG8_LDA(At, 1, 1); PG8_STAGE(PG8_SA(1, 0), a3, voffA);
            PG8_BAR; PG8_WAIT_L(0); PG8_MMA(1, 0, At, B0); PG8_BAR; PG8_SCHED;
            PG8_STAGE(PG8_SB(1, 1), b3 + hstep, voffB);
            PG8_WAIT_V(6); PG8_BAR; PG8_MMA(1, 1, At, B1); PG8_BAR;
            }
        }
        if constexpr (ALIGN_EPI) { if (wr == 0) PG8_BAR; }
        if constexpr (!Epi::AFTER_DRAIN) { E(acc, cur, wr, wc, fr, fq); S.done(cur); }
        if (!has_next) break;
#pragma unroll
        for (int a = 0; a < 2; ++a)
#pragma unroll
            for (int b = 0; b < 2; ++b)
#pragma unroll
                for (int m = 0; m < 4; ++m)
#pragma unroll
                    for (int n = 0; n < 2; ++n) acc[a][b][m][n] = (f32x4){0.f, 0.f, 0.f, 0.f};
        cur = nxt; cA = nA; cB = nB; ++ui;
        if constexpr (ALIGN_EPI) { if (wr == 1) PG8_BAR; }
    }
    PG8_WAIT_V(0);
    if constexpr (!ALIGN_EPI) { if (wr == 0) PG8_BAR; }
    PG8_BAR;
    if constexpr (Epi::AFTER_DRAIN) { E.fused(acc, cur, wr, wc, fr, fq, lds, wid, lane); S.done(cur); }
#undef PG8_SA
#undef PG8_SB
#undef PG8_STAGE
#undef PG8_LDA
#undef PG8_LDB
#undef PG8_MMA
#undef PG8_WAIT_V
#undef PG8_WAIT_L
#undef PG8_BAR
#undef PG8_SCHED
}
}
#ifndef PG8_SP2
#define PG8_SP2 true
#endif
#ifndef PG8_ALIGN
#define PG8_ALIGN true
#endif
constexpr int NWAVES = 8;
constexpr int BATCH = 2, SEQ = 8192, D = 1024, M = BATCH * SEQ, DEPTH = 2;
constexpr int IN_COLS = 5892, NMIX = 3072, MIXLD = 2816, NGATE = 3072, DFF = 2816, NGU = 2 * DFF;
constexpr int C_RETQ = 0, C_RETK = 256, C_RETV = 512, C_RETG = 768, C_FOXQ = 1024, C_FOXK = 1280, C_FOXV = 1536, C_RW = 1792;
constexpr size_t MiB = 1u << 20;
constexpr size_t WS_CTL = 0, CTL_ZERO_BYTES = 1 * MiB;
constexpr size_t WS_WIN = 1 * MiB, WS_WGATE = 7 * MiB, WS_PBR = 13 * MiB, WS_WOUT = 14 * MiB + 512 * 1024, WS_WGU = 16 * MiB + 512 * 1024, WS_WDOWN = 27 * MiB + 512 * 1024;
constexpr size_t WS_XB = 33 * MiB;
constexpr size_t WS_RB = 65 * MiB;
constexpr size_t WS_BIG = 97 * MiB;
constexpr size_t WS_SW = 193 * MiB, WS_SKK = 209 * MiB, WS_SA = 225 * MiB;
constexpr size_t WS_YW = 241 * MiB;
constexpr size_t WS_SS1 = 249 * MiB, WS_SS2 = 250 * MiB;
constexpr size_t WS_FLOG = 251 * MiB, WS_CUM = 251 * MiB + 256 * 1024;
constexpr size_t WS_ROPE = 252 * MiB;
constexpr size_t WS_END = 256 * MiB;
constexpr int CW_TMO = 0, CW_CODE = 1, CW_BAR = 4096;
constexpr int RING_OFF = 0, RING_BYTES = 131072;
constexpr int LDSCTL_OFF = RING_BYTES, MISC_OFF = LDSCTL_OFF + 320;
constexpr int LDS_BYTES = 147456;
#define GAS __attribute__((address_space(1)))
#define LAS __attribute__((address_space(3)))
typedef unsigned short bf16;
typedef unsigned v4u __attribute__((ext_vector_type(4)));
typedef float f32x4 __attribute__((ext_vector_type(4)));
typedef short bf16x8 __attribute__((ext_vector_type(8)));
typedef GAS unsigned gu32;
typedef GAS unsigned long long gu64;
#define RLX_AGENT __ATOMIC_RELAXED, __HIP_MEMORY_SCOPE_AGENT
#define LDS_WAIT() asm volatile("s_waitcnt lgkmcnt(0)" ::: "memory")
#define VM_WAIT() asm volatile("s_waitcnt vmcnt(0)" ::: "memory")
__device__ __forceinline__ unsigned long long rt() { return __builtin_amdgcn_s_memrealtime(); }
__device__ __forceinline__ unsigned f2bf(float f) { unsigned u = __builtin_bit_cast(unsigned, f); return (u + 0x7fffu + ((u >> 16) & 1u)) >> 16; }
__device__ __forceinline__ unsigned pk2(float lo, float hi) { return f2bf(lo) | (f2bf(hi) << 16); }

#define XB_TMO      128
#define XB_XCNT(j)  (256  + 64 * (j))
#define XB_XSUB(j)  (1280 + 64 * (j))
#define XB_XGEN(j)  (2304 + 64 * (j))
#define XB_TOP      3328
#define XB_TOPGEN   3392
#define XCD_BAR_WORDS 3456
#define XB_SPIN_CAP (1u << 18)

__device__ __forceinline__ unsigned xb_ld(unsigned* p)              { return __hip_atomic_load(p, __ATOMIC_RELAXED, __HIP_MEMORY_SCOPE_AGENT); }
__device__ __forceinline__ unsigned xb_add(unsigned* p, unsigned v) { return __hip_atomic_fetch_add(p, v, __ATOMIC_RELAXED, __HIP_MEMORY_SCOPE_AGENT); }
__device__ __forceinline__ unsigned xb_xcc_id() { return (unsigned)__builtin_amdgcn_s_getreg((3 << 11) | 20) & 0xFu; }
#define XB_SPIN(cond, bar) do { unsigned _sp = 0; while (cond) { __builtin_amdgcn_s_sleep(1); \
    if ((++_sp & 255u) == 0u) { if (xb_ld(&(bar)[XB_TMO])) break; if (_sp > XB_SPIN_CAP) { atomicAdd(&(bar)[XB_TMO], 1u); break; } } } } while (0)

struct XcdBarrier {
    unsigned* bar; unsigned x;
    volatile LAS unsigned* st;
};

__device__ __forceinline__ XcdBarrier xcd_barrier_post(unsigned* bar, volatile LAS unsigned* st) {
    XcdBarrier b; b.bar = bar; b.x = xb_xcc_id(); b.st = st;
    if (threadIdx.x == 0) (void)xb_add(&bar[XB_XCNT(b.x)], 1u);
    return b;
}
__device__ __forceinline__ void xcd_barrier_complete(unsigned* bar, unsigned x, unsigned& nloc, unsigned& nx) {
    const unsigned G = gridDim.x * gridDim.y * gridDim.z;
    unsigned sum, cnt, mine, sp = 0u;
    for (;;) {
        sum = 0u; cnt = 0u; mine = 0u;
#pragma unroll
        for (unsigned j = 0; j < 16; ++j) { const unsigned c = xb_ld(&bar[XB_XCNT(j)]); sum += c; cnt += (c > 0u) ? 1u : 0u; mine = (j == x) ? c : mine; }
        if (sum == G) break;
        __builtin_amdgcn_s_sleep(1);
        if ((++sp & 255u) == 0u) { if (xb_ld(&bar[XB_TMO])) break; if (sp > XB_SPIN_CAP) { atomicAdd(&bar[XB_TMO], 1u); break; } }
    }
    nloc = mine > 0u ? mine : 1u; nx = cnt > 0u ? cnt : 1u;
}

__device__ __forceinline__ void xcd_barrier(const XcdBarrier& b, const bool leader_thread) {
    asm volatile("s_waitcnt vmcnt(0)" ::: "memory");
    __syncthreads();
    if (leader_thread) {
        unsigned* bar = b.bar; asm volatile("" : "+s"(bar));
        __builtin_amdgcn_s_waitcnt(0);
        unsigned nloc = b.st[0], nx = b.st[1];
        if (nloc == 0u) { xcd_barrier_complete(bar, b.x, nloc, nx); b.st[0] = nloc; b.st[1] = nx; }
        const unsigned old = xb_add(&bar[XB_XSUB(b.x)], 1u);
        const unsigned gen = old / nloc;
        if (old + 1u == (gen + 1u) * nloc) {
            __builtin_amdgcn_fence(__ATOMIC_RELEASE, "agent");
            asm volatile("s_waitcnt vmcnt(0)" ::: "memory");
            const unsigned og = xb_add(&bar[XB_TOP], 1u);
            const unsigned tg = og / nx;
            if (og + 1u == (tg + 1u) * nx) xb_add(&bar[XB_TOPGEN], 1u);
            else XB_SPIN(xb_ld(&bar[XB_TOPGEN]) == tg, bar);
            __builtin_amdgcn_fence(__ATOMIC_ACQUIRE, "agent");
            xb_add(&bar[XB_XGEN(b.x)], 1u);
            asm volatile("s_waitcnt vmcnt(0)" ::: "memory");
        } else {
            XB_SPIN(xb_ld(&bar[XB_XGEN(b.x)]) == gen, bar);
            __builtin_amdgcn_fence(__ATOMIC_ACQUIRE, "agent");
            asm volatile("s_waitcnt vmcnt(0)" ::: "memory");
        }
    }
    __syncthreads();
}
struct Args { const float* in[24]; float* out; unsigned char* ws; int ph_lo, ph_hi; };
typedef const __attribute__((address_space(4))) Args* CArgs;
__device__ __forceinline__ CArgs get_args() { CArgs p = (CArgs)__builtin_amdgcn_kernarg_segment_ptr(); asm volatile("" : "+s"(p)); return p; }
struct Frame {
    LAS unsigned char* lds;
    volatile LAS unsigned* MISC;
    gu32* ctl;
    int tid, lane, wave;
    int vcu, G, bx;
};
__device__ __forceinline__ float bf2f(unsigned short b) { return __builtin_bit_cast(float, (unsigned)b << 16); }
__device__ __forceinline__ float bflo(unsigned w) { return __builtin_bit_cast(float, w << 16); }
__device__ __forceinline__ float bfhi(unsigned w) { return __builtin_bit_cast(float, w & 0xffff0000u); }
__device__ __forceinline__ float wave_sum(float v) {
#pragma unroll
    for (int o = 1; o < 64; o <<= 1) v += __shfl_xor(v, o);
    return v;
}
__device__ __forceinline__ float sigm(float x) { return 1.0f / (1.0f + __expf(-x)); }

template <class SRC>
__device__ __forceinline__ void conv_item(const float* W, int ldw, int K, bf16* WT, int dst0, int k0, const float* gain, LAS float* scr, int lane, SRC src) {
    const int sc = src(dst0 + (lane & 31));
#pragma unroll 8
    for (int i = 0; i < 32; ++i) { const int kk = 2 * i + (lane >> 5);
        float v = 0.f; if (sc >= 0) { v = W[(size_t)(k0 + kk) * ldw + sc]; if (gain) v *= gain[k0 + kk]; }
        scr[kk * 33 + (lane & 31)] = v; }
    LDS_WAIT(); asm volatile("" ::: "memory");
    const int c = lane & 7;
#pragma unroll
    for (int j = 0; j < 4; ++j) { const int n = (lane >> 3) + 8 * j; const LAS float* s = scr + (8 * c) * 33 + n;
        v4u o; o.x = pk2(s[0 * 33], s[1 * 33]); o.y = pk2(s[2 * 33], s[3 * 33]); o.z = pk2(s[4 * 33], s[5 * 33]); o.w = pk2(s[6 * 33], s[7 * 33]);
        *(GAS v4u*)(WT + (size_t)(dst0 + n) * K + k0 + 8 * c) = o; }
    LDS_WAIT(); asm volatile("" ::: "memory");
}
__device__ __forceinline__ void phase_weights(Frame& F, CArgs A, int l) {
    LAS float* scr = (LAS float*)(F.lds + RING_OFF + F.wave * 16384);
    const int gw = F.vcu * NWAVES + F.wave, NGW = F.G * NWAVES;
    const float* w_in = A->in[2] + (size_t)l * D * IN_COLS; const float* mixg = A->in[1] + (size_t)l * D;
    const float* p_ret = A->in[17] + (size_t)l * 256 * D; const float* p_fox = A->in[18] + (size_t)l * 256 * D; const float* p_rw = A->in[19] + (size_t)l * 256 * D;
    const float* w_out = A->in[20] + (size_t)l * D * D; const float* ffng = A->in[21] + (size_t)l * D;
    const float* w_gu = A->in[22] + (size_t)l * D * NGU; const float* w_down = A->in[23] + (size_t)l * DFF * D;
    bf16* Win_t = (bf16*)(A->ws + WS_WIN); bf16* Wgate_t = (bf16*)(A->ws + WS_WGATE); bf16* Pbr_t = (bf16*)(A->ws + WS_PBR);
    bf16* Wout_t = (bf16*)(A->ws + WS_WOUT); bf16* Wgu_t = (bf16*)(A->ws + WS_WGU); bf16* Wdown_t = (bf16*)(A->ws + WS_WDOWN);
    constexpr int I_IN = (NMIX / 32) * (D / 64), I_G = (NGATE / 32) * (D / 64), I_P = (D / 32) * (256 / 64), I_O = (D / 32) * (D / 64), I_GU = (NGU / 32) * (D / 64), I_DN = (D / 32) * (DFF / 64);
    constexpr int NITEMS = I_IN + I_G + 3 * I_P + I_O + I_GU + I_DN;
    for (int it = gw; it < NITEMS; it += NGW) {
        int r = it;
        if (r < I_IN) { const int nb = r % (NMIX / 32), kb = r / (NMIX / 32);
            conv_item(w_in, IN_COLS, D, Win_t, nb * 32, kb * 64, mixg, scr, F.lane, [](int d) { return d < 1792 ? d : (d < 2816 ? d + 4 : (d < 2820 ? d - 1024 : -1)); }); continue; } r -= I_IN;
        if (r < I_G) { const int nb = r % (NGATE / 32), kb = r / (NGATE / 32);
            conv_item(w_in, IN_COLS, D, Wgate_t, nb * 32, kb * 64, mixg, scr, F.lane, [](int d) { return d + 2820; }); continue; } r -= I_G;
        if (r < 3 * I_P) { const int b = r / I_P, q = r % I_P, nb = q % (D / 32), kb = q / (D / 32); const float* src = b == 0 ? p_ret : (b == 1 ? p_fox : p_rw);
            conv_item(src, D, 256, Pbr_t + (size_t)b * D * 256, nb * 32, kb * 64, nullptr, scr, F.lane, [](int d) { return d; }); continue; } r -= 3 * I_P;
        if (r < I_O) { const int nb = r % (D / 32), kb = r / (D / 32);
            conv_item(w_out, D, D, Wout_t, nb * 32, kb * 64, nullptr, scr, F.lane, [](int d) { return d; }); continue; } r -= I_O;
        if (r < I_GU) { const int nb = r % (NGU / 32), kb = r / (NGU / 32);
            conv_item(w_gu, NGU, D, Wgu_t, nb * 32, kb * 64, ffng, scr, F.lane, [](int d) { const int t = d >> 8, w = d & 255; return w < 128 ? 128 * t + w : DFF + 128 * t + (w - 128); }); continue; } r -= I_GU;
        { const int nb = r % (D / 32), kb = r / (D / 32);
            conv_item(w_down, D, DFF, Wdown_t, nb * 32, kb * 64, nullptr, scr, F.lane, [](int d) { return d; }); }
    }
}
__device__ __forceinline__ void phase_prologue(Frame& F, CArgs A) {
    const int gw = F.vcu * NWAVES + F.wave, NGW = F.G * NWAVES;
    const float* x = A->in[0]; bf16* XB = (bf16*)(A->ws + WS_XB); float* SS1 = (float*)(A->ws + WS_SS1);
    for (int m = gw; m < M; m += NGW) {
        const GAS f32x4* xr = (const GAS f32x4*)(x + (size_t)m * D) + F.lane; GAS f32x4* orow = (GAS f32x4*)(A->out + (size_t)m * D) + F.lane;
        GAS unsigned long long* o8 = (GAS unsigned long long*)(XB + (size_t)m * D) + F.lane; float s = 0.f;
#pragma unroll
        for (int j = 0; j < 4; ++j) { const f32x4 v = xr[64 * j]; orow[64 * j] = v; s += (v.x * v.x + v.y * v.y) + (v.z * v.z + v.w * v.w);
            o8[64 * j] = (unsigned long long)pk2(v.x, v.y) | ((unsigned long long)pk2(v.z, v.w) << 32); }
        s = wave_sum(s);
        if (F.lane < 16) SS1[(size_t)m * 16 + F.lane] = F.lane == 0 ? s : 0.f;
    }
    float* rope = (float*)(A->ws + WS_ROPE);
    for (int e = (F.vcu * NWAVES + F.wave) * 64 + F.lane; e < SEQ * 32; e += NGW * 64) { const int t = e >> 5, i = e & 31;
        const float inv = exp2f(-(float)i * (13.287712379549449f / 32.0f)); const float ang = (float)t * inv;
        double rev = (double)ang * 0.15915494309189535; rev -= rint(rev); const float rv = (float)rev;
        rope[2 * e] = __builtin_amdgcn_cosf(rv); rope[2 * e + 1] = __builtin_amdgcn_sinf(rv); }
}
__device__ __forceinline__ float log_sigmoid(float z) { return fminf(z, 0.f) - log1pf(__expf(-fabsf(z))); }
__device__ __forceinline__ void phase_cumsum(Frame& F, CArgs A, int l) {
    const int gw = F.vcu * NWAVES + F.wave;
    if (gw >= 8) return;
    const int b = gw >> 2, h = gw & 3; const float bias = A->in[6][l * 4 + h];
    const float* fl = (const float*)(A->ws + WS_FLOG) + (size_t)b * SEQ * 4 + h; float* cum = (float*)(A->ws + WS_CUM) + (size_t)gw * SEQ;
    const int t0 = F.lane * 128; double s = 0.0;
    for (int i = 0; i < 128; ++i) s += (double)log_sigmoid(fl[(size_t)(t0 + i) * 4] + bias);
    double incl = s;
#pragma unroll
    for (int o = 1; o < 64; o <<= 1) { const double t = __shfl_up(incl, o); if (F.lane >= o) incl += t; }
    double run = incl - s;
    for (int i = 0; i < 128; ++i) { run += (double)log_sigmoid(fl[(size_t)(t0 + i) * 4] + bias); cum[t0 + i] = (float)run; }
}
constexpr int STG_OFF = 132096;
__device__ __forceinline__ float lerp_col(const bf16* MIXIN, int m, int t, int col, float mu) {
    const float cur = bf2f(MIXIN[(size_t)m * MIXLD + C_RW + col]); const float prev = t > 0 ? bf2f(MIXIN[(size_t)(m - 1) * MIXLD + C_RW + col]) : 0.f;
    return cur + (prev - cur) * mu;
}
__device__ __forceinline__ void phase_rwkv_prep(Frame& F, CArgs A, int l) {
    LAS float* w2s = (LAS float*)(F.lds); LAS float* a2s = (LAS float*)(F.lds + 65536); LAS float* stg = (LAS float*)(F.lds + STG_OFF);
    const float* w2 = A->in[9] + (size_t)l * 64 * 256; const float* a2 = A->in[11] + (size_t)l * 64 * 256;
    const float* mu = A->in[7] + (size_t)l * 1024; const float* w0 = A->in[8] + l * 256; const float* a0 = A->in[10] + l * 256; const float* k_k = A->in[13] + l * 256;
    const bf16* MIXIN = (const bf16*)(A->ws + WS_BIG);
    float* SW = (float*)(A->ws + WS_SW); float* SKK = (float*)(A->ws + WS_SKK); float* SA = (float*)(A->ws + WS_SA);
    for (int i = F.tid; i < 64 * 256; i += NWAVES * 64) { w2s[i] = w2[i]; a2s[i] = a2[i]; }
    __syncthreads();
    const int tok = F.tid >> 8, ch = F.tid & 255;
    for (int item = F.vcu; item < M / 2; item += F.G) {
        const int m = item * 2 + tok, t = m & (SEQ - 1);
        if (ch < 128) { float v = lerp_col(MIXIN, m, t, 768 + ch, mu[768 + ch]); if (ch < 64) v = tanhf(v); stg[tok * 128 + ch] = v; }
        __syncthreads();
        float wz = w0[ch], az = a0[ch];
#pragma unroll 8
        for (int i = 0; i < 64; ++i) { wz += stg[tok * 128 + i] * w2s[i * 256 + ch]; az += stg[tok * 128 + 64 + i] * a2s[i * 256 + ch]; }
        const float nz = -wz; const float sp = fmaxf(nz, 0.f) + log1pf(__expf(-fabsf(nz)));
        const float decay = __expf(-__expf(-sp - 0.5f));
        const float a = sigm(az);
        const float k = lerp_col(MIXIN, m, t, 256 + ch, mu[256 + ch]);
        float kk = k * k_k[ch]; const float n2 = wave_sum(kk * kk); kk = kk / fmaxf(sqrtf(n2), 1e-12f);
        SW[(size_t)m * 256 + ch] = decay; SKK[(size_t)m * 256 + ch] = kk; SA[(size_t)m * 256 + ch] = a;
        __syncthreads();
    }
}
__device__ __forceinline__ void phase_rwkv_scan(Frame& F, CArgs A, int l) {
    const int gw = F.vcu * NWAVES + F.wave;
    if (gw >= 512) return;
    const int bh = gw >> 6, vrow = gw & 63, b = bh >> 2, h = bh & 3, lane = F.lane;
    const float* mu = A->in[7] + (size_t)l * 1024; const float ka = A->in[14][l * 256 + h * 64 + lane];
    const float mur = mu[h * 64 + lane], muk = mu[256 + h * 64 + lane], muv = mu[512 + h * 64 + vrow];
    const bf16* MIXIN = (const bf16*)(A->ws + WS_BIG);
    const float* SW = (const float*)(A->ws + WS_SW); const float* SKK = (const float*)(A->ws + WS_SKK); const float* SA = (const float*)(A->ws + WS_SA);
    float* YRW = (float*)(A->ws + WS_RB);
    const int cr = C_RW + h * 64 + lane, ck = C_RW + 256 + h * 64 + lane, cv = C_RW + 512 + h * 64 + vrow, cs = h * 64 + lane;
    float S = 0.f, pr = 0.f, pk = 0.f, pv = 0.f;
    for (int t0 = 0; t0 < SEQ; t0 += 8) {
        float rr[8], kr[8], vr[8], w[8], kk[8], a[8];
#pragma unroll
        for (int j = 0; j < 8; ++j) { const size_t m = (size_t)b * SEQ + t0 + j;
            rr[j] = bf2f(MIXIN[m * MIXLD + cr]); kr[j] = bf2f(MIXIN[m * MIXLD + ck]); vr[j] = bf2f(MIXIN[m * MIXLD + cv]);
            w[j] = SW[m * 256 + cs]; kk[j] = SKK[m * 256 + cs]; a[j] = SA[m * 256 + cs]; }
#pragma unroll
        for (int j = 0; j < 8; ++j) { const size_t m = (size_t)b * SEQ + t0 + j;
            const float r = rr[j] + (pr - rr[j]) * mur, k = kr[j] + (pk - kr[j]) * muk, v = vr[j] + (pv - vr[j]) * muv; pr = rr[j]; pk = kr[j]; pv = vr[j];
            const float b_ = kk[j] * a[j], kp = k * (1.f + (a[j] - 1.f) * ka);
            const float sa = wave_sum(S * (-kk[j]));
            S = S * w[j] + sa * b_ + v * kp;
            const float y = wave_sum(S * r);
            if (lane == 0) YRW[m * 256 + h * 64 + vrow] = y; }
    }
}
__device__ __forceinline__ void phase_rwkv_post(Frame& F, CArgs A, int l) {
    LAS float* g2s = (LAS float*)(F.lds); LAS float* stg = (LAS float*)(F.lds + STG_OFF);
    const float* g2 = A->in[12] + (size_t)l * 128 * 256; const float* mu = A->in[7] + (size_t)l * 1024;
    const float* k_a = A->in[14] + l * 256; const float* r_k = A->in[15] + l * 256; const float* gn = A->in[16] + l * 256;
    const bf16* MIXIN = (const bf16*)(A->ws + WS_BIG); const float* SA = (const float*)(A->ws + WS_SA); const float* YRW = (const float*)(A->ws + WS_RB);
    bf16* YW = (bf16*)(A->ws + WS_YW);
    for (int i = F.tid; i < 128 * 256; i += NWAVES * 64) g2s[i] = g2[i];
    __syncthreads();
    const int tok = F.tid >> 8, ch = F.tid & 255;
    for (int item = F.vcu; item < M / 2; item += F.G) {
        const int m = item * 2 + tok, t = m & (SEQ - 1);
        if (ch < 128) stg[tok * 128 + ch] = sigm(lerp_col(MIXIN, m, t, 896 + ch, mu[896 + ch]));
        __syncthreads();
        float g = 0.f;
#pragma unroll 8
        for (int i = 0; i < 128; ++i) g += stg[tok * 128 + i] * g2s[i * 256 + ch];
        const float y = YRW[(size_t)m * 256 + ch]; const float mean = wave_sum(y) * (1.f / 64.f); const float d = y - mean;
        const float var = wave_sum(d * d) * (1.f / 64.f); const float yn = d * (1.0f / sqrtf(var + 64e-5f)) * gn[ch];
        const float r = lerp_col(MIXIN, m, t, ch, mu[ch]), k = lerp_col(MIXIN, m, t, 256 + ch, mu[256 + ch]), v = lerp_col(MIXIN, m, t, 512 + ch, mu[512 + ch]);
        const float a = SA[(size_t)m * 256 + ch]; const float kp = k * (1.f + (a - 1.f) * k_a[ch]);
        const float bonus = wave_sum(r * kp * r_k[ch]) * v;
        YW[(size_t)m * 256 + ch] = (bf16)f2bf((yn + bonus) * g);
        __syncthreads();
    }
}
template <int MODE>
__device__ __forceinline__ void phase_attn_valu(Frame& F, CArgs A, int l) {
    LAS float* Ks = (LAS float*)(F.lds); LAS float* Vs = (LAS float*)(F.lds + 17408); LAS float* cks = (LAS float*)(F.lds + 34816);
    const bf16* MIXIN = (const bf16*)(A->ws + WS_BIG); const float* CUM = (const float*)(A->ws + WS_CUM); const float* rope = (const float*)(A->ws + WS_ROPE);
    const float* qgain = A->in[4] + l * 64; const float* kgain = A->in[5] + l * 64; const float* rgn = A->in[3] + l * 256;
    bf16* YO = (bf16*)(A->ws + WS_RB + (MODE == 0 ? 24 : 16) * MiB);
    const int qc = MODE == 0 ? C_FOXQ : C_RETQ, kc = MODE == 0 ? C_FOXK : C_RETK, vc = MODE == 0 ? C_FOXV : C_RETV;
    const int tid = F.tid, qi = tid >> 2, part = tid & 3, key = tid >> 3, c8 = tid & 7;
#pragma unroll 1
    for (int it = F.vcu; it < 256; it += F.G)
#pragma unroll 1
    for (int pass = 0; pass < 2; ++pass) {
        const int bh = it >> 5, s = it & 31, qblk = pass == 0 ? s : 63 - s, b = bh >> 2, h = bh & 3, q0 = qblk * 128, ipos = q0 + qi;
        const size_t m = (size_t)b * SEQ + ipos;
        float q[16];
        { const v4u* qp = (const v4u*)(MIXIN + m * MIXLD + qc + h * 64 + 16 * part); const v4u a = qp[0], c = qp[1];
          q[0] = bflo(a.x); q[1] = bfhi(a.x); q[2] = bflo(a.y); q[3] = bfhi(a.y); q[4] = bflo(a.z); q[5] = bfhi(a.z); q[6] = bflo(a.w); q[7] = bfhi(a.w);
          q[8] = bflo(c.x); q[9] = bfhi(c.x); q[10] = bflo(c.y); q[11] = bfhi(c.y); q[12] = bflo(c.z); q[13] = bfhi(c.z); q[14] = bflo(c.w); q[15] = bfhi(c.w); }
        float ci = 0.f, lg2g = 0.f;
        if (MODE == 0) { float ss = 0.f;
#pragma unroll
            for (int e = 0; e < 16; ++e) ss += q[e] * q[e];
            ss += __shfl_xor(ss, 1); ss += __shfl_xor(ss, 2); const float rs = 1.0f / sqrtf(ss * (1.f / 64.f) + 1e-6f);
#pragma unroll
            for (int e = 0; e < 16; ++e) q[e] = q[e] * rs * qgain[16 * part + e] * 0.125f;
            ci = CUM[(size_t)bh * SEQ + ipos];
        } else {
#pragma unroll
            for (int e = 0; e < 16; ++e) { const float p = __shfl_xor(q[e], 2); const int idx = 16 * (part & 1) + e; const float cs = rope[((size_t)ipos * 32 + idx) * 2], sn = rope[((size_t)ipos * 32 + idx) * 2 + 1];
                q[e] = (part < 2 ? q[e] * cs - p * sn : p * sn + q[e] * cs) * 0.125f; }
            lg2g = log2f(1.0f - exp2f(-5.0f - (float)h));
        }
        float o[16]; float mrun = -INFINITY, lsum = 0.f;
#pragma unroll
        for (int e = 0; e < 16; ++e) o[e] = 0.f;
        const int ntiles = q0 / 64 + 2;
#pragma unroll 1
        for (int kt = 0; kt < ntiles; ++kt) {
            __syncthreads();
            { const int j = kt * 64 + key; const size_t mk = (size_t)b * SEQ + j;
              const v4u kw = *(const v4u*)(MIXIN + mk * MIXLD + kc + h * 64 + 8 * c8), vw = *(const v4u*)(MIXIN + mk * MIXLD + vc + h * 64 + 8 * c8);
              float kf[8] = {bflo(kw.x), bfhi(kw.x), bflo(kw.y), bfhi(kw.y), bflo(kw.z), bfhi(kw.z), bflo(kw.w), bfhi(kw.w)};
              const float vf[8] = {bflo(vw.x), bfhi(vw.x), bflo(vw.y), bfhi(vw.y), bflo(vw.z), bfhi(vw.z), bflo(vw.w), bfhi(vw.w)};
              if (MODE == 0) { float ss = 0.f;
#pragma unroll
                  for (int e = 0; e < 8; ++e) ss += kf[e] * kf[e];
                  ss += __shfl_xor(ss, 1); ss += __shfl_xor(ss, 2); ss += __shfl_xor(ss, 4); const float rs = 1.0f / sqrtf(ss * (1.f / 64.f) + 1e-6f);
#pragma unroll
                  for (int e = 0; e < 8; ++e) kf[e] = kf[e] * rs * kgain[8 * c8 + e];
                  if (c8 == 0) cks[key] = CUM[(size_t)bh * SEQ + j];
              } else {
#pragma unroll
                  for (int e = 0; e < 8; ++e) { const float p = __shfl_xor(kf[e], 4); const int idx = 8 * (c8 & 3) + e; const float cs = rope[((size_t)j * 32 + idx) * 2], sn = rope[((size_t)j * 32 + idx) * 2 + 1];
                      kf[e] = c8 < 4 ? kf[e] * cs - p * sn : p * sn + kf[e] * cs; }
              }
              *(LAS f32x4*)(Ks + key * 68 + 8 * c8) = (f32x4){kf[0], kf[1], kf[2], kf[3]}; *(LAS f32x4*)(Ks + key * 68 + 8 * c8 + 4) = (f32x4){kf[4], kf[5], kf[6], kf[7]};
              *(LAS f32x4*)(Vs + key * 68 + 8 * c8) = (f32x4){vf[0], vf[1], vf[2], vf[3]}; *(LAS f32x4*)(Vs + key * 68 + 8 * c8 + 4) = (f32x4){vf[4], vf[5], vf[6], vf[7]};
            }
            __syncthreads();
#pragma unroll 1
            for (int sub = 0; sub < 4; ++sub) {
                float lg[16];
#pragma unroll
                for (int jj = 0; jj < 16; ++jj) { const LAS f32x4* kr = (const LAS f32x4*)(Ks + (sub * 16 + jj) * 68 + 16 * part);
                    const f32x4 k0 = kr[0], k1 = kr[1], k2 = kr[2], k3 = kr[3];
                    float sdot = (q[0] * k0[0] + q[1] * k0[1] + q[2] * k0[2] + q[3] * k0[3]) + (q[4] * k1[0] + q[5] * k1[1] + q[6] * k1[2] + q[7] * k1[3])
                               + (q[8] * k2[0] + q[9] * k2[1] + q[10] * k2[2] + q[11] * k2[3]) + (q[12] * k3[0] + q[13] * k3[1] + q[14] * k3[2] + q[15] * k3[3]);
                    sdot += __shfl_xor(sdot, 1); sdot += __shfl_xor(sdot, 2);
                    const int j = kt * 64 + sub * 16 + jj;
                    if (MODE == 0) lg[jj] = (j <= ipos) ? sdot + ci - cks[sub * 16 + jj] : -INFINITY;
                    else lg[jj] = (j <= ipos) ? sdot * exp2f((float)(ipos - j) * lg2g) : 0.f; }
                if (MODE == 0) { float tmax = lg[0];
#pragma unroll
                    for (int jj = 1; jj < 16; ++jj) tmax = fmaxf(tmax, lg[jj]);
                    const float mnew = fmaxf(mrun, tmax); const float sc = __expf(mrun - mnew); lsum *= sc;
#pragma unroll
                    for (int e = 0; e < 16; ++e) o[e] *= sc;
#pragma unroll
                    for (int jj = 0; jj < 16; ++jj) { lg[jj] = __expf(lg[jj] - mnew); lsum += lg[jj]; }
                    mrun = mnew; }
#pragma unroll
                for (int jj = 0; jj < 16; ++jj) { const LAS f32x4* vr = (const LAS f32x4*)(Vs + (sub * 16 + jj) * 68 + 16 * part); const float p = lg[jj];
#pragma unroll
                    for (int v4 = 0; v4 < 4; ++v4) { const f32x4 vv = vr[v4]; o[4 * v4] += p * vv[0]; o[4 * v4 + 1] += p * vv[1]; o[4 * v4 + 2] += p * vv[2]; o[4 * v4 + 3] += p * vv[3]; } }
            }
        }
        if (MODE == 0) { const float il = 1.0f / lsum;
#pragma unroll
            for (int e = 0; e < 16; ++e) o[e] *= il;
        } else { float sm = 0.f;
#pragma unroll
            for (int e = 0; e < 16; ++e) sm += o[e];
            sm += __shfl_xor(sm, 1); sm += __shfl_xor(sm, 2); const float mean = sm * (1.f / 64.f); float vs = 0.f;
#pragma unroll
            for (int e = 0; e < 16; ++e) { o[e] -= mean; vs += o[e] * o[e]; }
            vs += __shfl_xor(vs, 1); vs += __shfl_xor(vs, 2); const float rs = 1.0f / sqrtf(vs * (1.f / 64.f) + 1e-5f);
            const v4u* gp = (const v4u*)(MIXIN + m * MIXLD + C_RETG + h * 64 + 16 * part); const v4u ga = gp[0], gb = gp[1];
            const float gg[16] = {bflo(ga.x), bfhi(ga.x), bflo(ga.y), bfhi(ga.y), bflo(ga.z), bfhi(ga.z), bflo(ga.w), bfhi(ga.w), bflo(gb.x), bfhi(gb.x), bflo(gb.y), bfhi(gb.y), bflo(gb.z), bfhi(gb.z), bflo(gb.w), bfhi(gb.w)};
#pragma unroll
            for (int e = 0; e < 16; ++e) o[e] = o[e] * rs * rgn[h * 64 + 16 * part + e] * (gg[e] * sigm(gg[e]));
        }
        v4u w0, w1; w0.x = pk2(o[0], o[1]); w0.y = pk2(o[2], o[3]); w0.z = pk2(o[4], o[5]); w0.w = pk2(o[6], o[7]); w1.x = pk2(o[8], o[9]); w1.y = pk2(o[10], o[11]); w1.z = pk2(o[12], o[13]); w1.w = pk2(o[14], o[15]);
        v4u* op = (v4u*)(YO + m * 256 + h * 64 + 16 * part); op[0] = w0; op[1] = w1;
    }
}
constexpr int PH_PER_LAYER = 11, N_PHASES = 1 + DEPTH * PH_PER_LAYER;
#ifndef MK_ONE_LAUNCH
#define MK_ONE_LAUNCH 0
#endif
__device__ __forceinline__ Frame make_frame(unsigned char* lds_generic, int wave_s) {
    Frame F;
    asm volatile("" : "+s"(wave_s));
    int lane_v; asm volatile("v_mbcnt_lo_u32_b32 %0, -1, 0\n\tv_mbcnt_hi_u32_b32 %0, -1, %0" : "=v"(lane_v));
    int tid = wave_s * 64 + lane_v;
    int bx = blockIdx.x, G = gridDim.x; asm volatile("" : "+s"(bx), "+s"(G));
    F.lds = (LAS unsigned char*)lds_generic;
    F.MISC = (volatile LAS unsigned*)(F.lds + MISC_OFF);
    F.tid = tid; F.lane = tid & 63; F.wave = __builtin_amdgcn_readfirstlane(tid >> 6);
    F.G = G; F.vcu = (G % 8 == 0) ? (bx % 8) * (G / 8) + bx / 8 : bx; F.bx = bx;
    F.ctl = nullptr;
    return F;
}
#define IN(k) (lo <= (k) && (k) < hi)
#define SEAM(k) do { if (IN(k) && IN((k) + 1)) { int w_ = wave0; asm volatile("" : "+s"(w_)); int l_; asm volatile("v_mbcnt_lo_u32_b32 %0, -1, 0\n\tv_mbcnt_hi_u32_b32 %0, -1, %0" : "=v"(l_)); xcd_barrier(bar, w_ == 0 && l_ == 0); } } while (0)
#define WSP(T, off) ((T*)(A->ws + (off)))
template <int l> __device__ __forceinline__ void run_layer(unsigned char* lds, const XcdBarrier& bar, const int lo, const int hi, const int wave0) {
        const int pb = 1 + l * PH_PER_LAYER;
        if (IN(pb + 0)) { CArgs A = get_args(); Frame F = make_frame(lds, wave0); phase_weights(F, A, l); SEAM(pb + 0); }
        if (IN(pb + 1)) { CArgs A = get_args(); Frame F = make_frame(lds, wave0); pg8::Gemm g{WSP(bf16, WS_XB), WSP(bf16, WS_WIN), M, NMIX, D}; pg8::StaticOrder S; S.init(M, NMIX, F.G, F.bx);
                  pg8::EpiScale<0> E{WSP(bf16, WS_BIG), MIXLD, WSP(float, WS_SS1), WSP(float, WS_FLOG), 11, 11};
                  pg8::gemm_phase<pg8::EpiScale<0>, pg8::StaticOrder, PG8_ALIGN, PG8_SP2>(F.lds + RING_OFF, g, S, E, F.tid); SEAM(pb + 1); }
        if (IN(pb + 2)) { CArgs A = get_args(); Frame F = make_frame(lds, wave0); phase_cumsum(F, A, l); phase_rwkv_prep(F, A, l); SEAM(pb + 2); }
        if (IN(pb + 3)) { { CArgs A = get_args(); Frame F = make_frame(lds, wave0); phase_attn_valu<0>(F, A, l); } __syncthreads(); { CArgs A = get_args(); Frame F = make_frame(lds, wave0); phase_attn_valu<1>(F, A, l); } SEAM(pb + 3); }
        if (IN(pb + 4)) { CArgs A = get_args(); Frame F = make_frame(lds, wave0); phase_rwkv_scan(F, A, l); SEAM(pb + 4); }
        if (IN(pb + 5)) { CArgs A = get_args(); Frame F = make_frame(lds, wave0); phase_rwkv_post(F, A, l); SEAM(pb + 5); }
        if (IN(pb + 6)) { CArgs A = get_args(); Frame F = make_frame(lds, wave0); pg8::Gemm g{WSP(bf16, WS_XB), WSP(bf16, WS_WGATE), M, NGATE, D}; pg8::StaticOrder S; S.init(M, NGATE, F.G, F.bx);
                  pg8::EpiScale<1> E{WSP(bf16, WS_BIG), NGATE, WSP(float, WS_SS1), nullptr, -1, 12};
                  pg8::gemm_phase<pg8::EpiScale<1>, pg8::StaticOrder, PG8_ALIGN, PG8_SP2>(F.lds + RING_OFF, g, S, E, F.tid); SEAM(pb + 6); }
        if (IN(pb + 7)) {
                  { CArgs A = get_args(); Frame F = make_frame(lds, wave0); pg8::StaticOrder S; S.init(M, D, F.G, F.bx); pg8::Gemm g{WSP(bf16, WS_RB + 16 * MiB), WSP(bf16, WS_PBR), M, D, 256}; pg8::EpiBranch<1> E{WSP(bf16, WS_XB), WSP(bf16, WS_BIG), 0};
                    pg8::gemm_phase<pg8::EpiBranch<1>, pg8::StaticOrder, PG8_ALIGN, PG8_SP2>(F.lds + RING_OFF, g, S, E, F.tid); }
                  { CArgs A = get_args(); Frame F = make_frame(lds, wave0); pg8::StaticOrder S; S.init(M, D, F.G, F.bx); pg8::Gemm g{WSP(bf16, WS_RB + 24 * MiB), WSP(bf16, WS_PBR) + (size_t)D * 256, M, D, 256}; pg8::EpiBranch<0> E{WSP(bf16, WS_XB), WSP(bf16, WS_BIG), 1024};
                    pg8::gemm_phase<pg8::EpiBranch<0>, pg8::StaticOrder, PG8_ALIGN, PG8_SP2>(F.lds + RING_OFF, g, S, E, F.tid); }
                  { CArgs A = get_args(); Frame F = make_frame(lds, wave0); pg8::StaticOrder S; S.init(M, D, F.G, F.bx); pg8::Gemm g{WSP(bf16, WS_YW), WSP(bf16, WS_PBR) + (size_t)2 * D * 256, M, D, 256}; pg8::EpiBranch<0> E{WSP(bf16, WS_XB), WSP(bf16, WS_BIG), 2048};
                    pg8::gemm_phase<pg8::EpiBranch<0>, pg8::StaticOrder, PG8_ALIGN, PG8_SP2>(F.lds + RING_OFF, g, S, E, F.tid); }
                  SEAM(pb + 7); }
        if (IN(pb + 8)) { CArgs A = get_args(); Frame F = make_frame(lds, wave0); pg8::Gemm g{WSP(bf16, WS_XB), WSP(bf16, WS_WOUT), M, D, D}; pg8::StaticOrder S; S.init(M, D, F.G, F.bx);
                  pg8::EpiResid E{A->out, WSP(bf16, WS_RB), WSP(float, WS_SS2)};
                  pg8::gemm_phase<pg8::EpiResid, pg8::StaticOrder, PG8_ALIGN, PG8_SP2>(F.lds + RING_OFF, g, S, E, F.tid); SEAM(pb + 8); }
        if (IN(pb + 9)) { CArgs A = get_args(); Frame F = make_frame(lds, wave0); pg8::Gemm g{WSP(bf16, WS_RB), WSP(bf16, WS_WGU), M, NGU, D}; pg8::StaticOrder S; S.init(M, NGU, F.G, F.bx);
                  pg8::EpiSwiglu E{WSP(bf16, WS_BIG), WSP(float, WS_SS2)};
                  pg8::gemm_phase<pg8::EpiSwiglu, pg8::StaticOrder, PG8_ALIGN, PG8_SP2>(F.lds + RING_OFF, g, S, E, F.tid); SEAM(pb + 9); }
        if (IN(pb + 10)) { CArgs A = get_args(); Frame F = make_frame(lds, wave0); pg8::Gemm g{WSP(bf16, WS_BIG), WSP(bf16, WS_WDOWN), M, D, DFF}; pg8::StaticOrder S; S.init(M, D, F.G, F.bx);
                  pg8::EpiResid E{A->out, WSP(bf16, WS_XB), WSP(float, WS_SS1)};
                  pg8::gemm_phase<pg8::EpiResid, pg8::StaticOrder, PG8_ALIGN, PG8_SP2>(F.lds + RING_OFF, g, S, E, F.tid); SEAM(pb + 10); }
    }
__global__ void __launch_bounds__(NWAVES * 64, 2) mega_fwd(Args args) {
    extern __shared__ __attribute__((aligned(16))) unsigned char lds[];
    const int wave0 = __builtin_amdgcn_readfirstlane((int)threadIdx.x >> 6);
    { const int tid0 = threadIdx.x;
      for (int u = tid0; u < (LDS_BYTES - LDSCTL_OFF) / 4; u += NWAVES * 64) ((LAS unsigned*)((LAS unsigned char*)lds + LDSCTL_OFF))[u] = 0u; }
    __syncthreads();
    XcdBarrier bar = xcd_barrier_post((unsigned*)((gu32*)(args.ws + WS_CTL) + CW_BAR), (volatile LAS unsigned*)((LAS unsigned char*)lds + MISC_OFF) + 8);
    const int lo = args.ph_lo, hi = args.ph_hi;
    if (IN(0)) { CArgs A = get_args(); Frame F = make_frame(lds, wave0); phase_prologue(F, A); SEAM(0); }
    run_layer<0>(lds, bar, lo, hi, wave0);
    run_layer<1>(lds, bar, lo, hi, wave0);
}

#undef IN
#undef SEAM
#undef WSP
extern "C" void kernel_launch(void* const* d_in, const int* in_sizes, int n_in, void* d_out, int out_size, void* d_ws, size_t ws_size, hipStream_t stream) {
    static int grid = 0;
    if (grid == 0) {
        if (n_in != 24 || in_sizes[0] != M * D || out_size != M * D || ws_size < WS_END) { fprintf(stderr, "kernel_launch: unexpected shapes (n_in %d, in0 %d, out %d, ws %zu); nothing launched\n", n_in, n_in > 0 ? in_sizes[0] : -1, out_size, ws_size); grid = -1; return; }
        int dev = 0, cus = 0;
        if (hipGetDevice(&dev) != hipSuccess || hipDeviceGetAttribute(&cus, hipDeviceAttributeMultiprocessorCount, dev) != hipSuccess) { grid = -1; return; }
        if (hipFuncSetAttribute((const void*)mega_fwd, hipFuncAttributeMaxDynamicSharedMemorySize, LDS_BYTES) != hipSuccess) { fprintf(stderr, "kernel_launch: hipFuncSetAttribute failed\n"); grid = -1; return; }
        (void)hipGetLastError();
        grid = cus;
    }
    if (grid < 0) return;
    if (hipMemsetAsync((char*)d_ws + WS_CTL, 0, CTL_ZERO_BYTES, stream) != hipSuccess) return;
    Args a{};
    for (int i = 0; i < 24; ++i) a.in[i] = (const float*)d_in[i];
    a.out = (float*)d_out; a.ws = (unsigned char*)d_ws;
#if MK_ONE_LAUNCH
    a.ph_lo = 0; a.ph_hi = N_PHASES;
    hipLaunchKernelGGL(mega_fwd, dim3(grid), dim3(NWAVES * 64), LDS_BYTES, stream, a);
#else
    for (int ph = 0; ph < N_PHASES; ++ph) { a.ph_lo = ph; a.ph_hi = ph + 1;
        hipLaunchKernelGGL(mega_fwd, dim3(grid), dim3(NWAVES * 64), LDS_BYTES, stream, a); }
#endif
}
```

```cpp
#include <hip/hip_runtime.h>
#include <cstdio>
#include <cstdint>
#include <cmath>
namespace pg8 {
#define PG8_LAS __attribute__((address_space(3)))
typedef unsigned short bf16_t;
typedef short bf16x8 __attribute__((ext_vector_type(8)));
typedef float f32x4 __attribute__((ext_vector_type(4)));
typedef unsigned u32x4 __attribute__((ext_vector_type(4)));
constexpr int BM = 256, BK = 64, HALF = 128, HTB = HALF * BK * 2  , STAGE_BYTES = 8 * HTB, NXCD = 8, WGM = 4;

__host__ __device__ __forceinline__ int lds_byte(int r, int c) { const int st = (r >> 4) * 2 + (c >> 5), rr = r & 15, cc = c & 31, ob = rr * 64 + cc * 2; return st * 1024 + (ob ^ (((ob >> 9) & 1) << 5)); }
__host__ __device__ __forceinline__ void stage_rc(int b, int& R, int& C) { const int st = b / 1024, sb = b % 1024, swz = sb ^ (((sb >> 9) & 1) << 5); R = (st >> 1) * 16 + swz / 64; C = (st & 1) * 32 + (swz % 64) / 2; }
__host__ __device__ __forceinline__ int perm32(int rho) { const int n = rho >> 4, i = rho & 15; return 8 * (i >> 2) + 4 * n + (i & 3); }

struct Unit { int pm, pn, half; };
struct Gemm { const bf16_t* A; const bf16_t* Bt; int M, N, K, lda; };

struct StaticOrder {
    static constexpr bool HALVES = false;
    int nM, nN, nwg, G, c;
    __host__ __device__ void init(int M, int N, int G_, int c_) { nM = M / BM; nN = N / BM; nwg = nM * nN; G = G_; c = c_; }
    __host__ __device__ bool next(int i, Unit& u) const {
        const long L = (long)i * G + c; if (L >= nwg) return false;
        int wgid = (int)L; { const int q = nwg / NXCD, r = nwg % NXCD, xcd = wgid % NXCD, off = wgid / NXCD; wgid = (xcd < r ? xcd * (q + 1) : r * (q + 1) + (xcd - r) * q) + off; }
        const int nig = WGM * nN, gid = wgid / nig, fm = gid * WGM, gsz = (nM - fm) < WGM ? (nM - fm) : WGM;
        u.pm = fm + ((wgid % nig) % gsz); u.pn = (wgid % nig) / gsz; u.half = 0; return true;
    }
    __device__ __forceinline__ void a_ready(const Unit&) const {}
    __device__ __forceinline__ void done(const Unit&) const {}
};
struct GateOrder {
    static constexpr bool HALVES = false;
    StaticOrder base;
    __host__ __device__ void init(int M, int G_, int c_) { base.init(M, 1024, G_, c_); }
    __host__ __device__ bool next(int i, Unit& u) const { Unit b; if (!base.next(i / 3, b)) return false; u.pm = b.pm; u.pn = b.pn + 4 * (i % 3); u.half = 0; return true; }
    __device__ __forceinline__ void a_ready(const Unit&) const {}
    __device__ __forceinline__ void done(const Unit&) const {}
};
struct HalfTailOrder : StaticOrder {
    static constexpr bool HALVES = true;
    __host__ __device__ bool next(int i, Unit& u) const {
        const int full = (nwg / G) * G, rem = nwg - full;
        if ((long)i * G + c < full || rem * 2 != G) return StaticOrder::next(i, u);
        if ((long)i * G != full) return false;
        StaticOrder t = *this; t.c = 0; t.G = 1; if (!t.next(full + (c >> 1), u)) return false;
        u.half = 1 + (c & 1); return true;
    }
};

typedef unsigned u32x4 __attribute__((ext_vector_type(4)));
typedef float f32x2e __attribute__((ext_vector_type(2))); typedef __bf16 bf16x2e __attribute__((ext_vector_type(2)));
__device__ __forceinline__ unsigned pk2_(float lo, float hi) { const f32x2e v = {lo, hi}; return __builtin_bit_cast(unsigned, __builtin_convertvector(v, bf16x2e)); }
__device__ __forceinline__ float bflo_(unsigned w) { return __builtin_bit_cast(float, w << 16); }
__device__ __forceinline__ float bfhi_(unsigned w) { return __builtin_bit_cast(float, w & 0xffff0000u); }
__device__ __forceinline__ float sigmoidf_(float x) { return __builtin_amdgcn_rcpf(1.0f + __expf(-x)); }
__device__ __forceinline__ void rstd8(const float* ss, int row0, float (&rs)[8]) {
    f32x4 v[8];
#pragma unroll
    for (int i = 0; i < 8; ++i) v[i] = *(const f32x4*)(ss + (unsigned)(row0 + (i >> 2) * HALF + (i & 3) * 16) * 4u);
#pragma unroll
    for (int i = 0; i < 8; ++i) rs[i] = __builtin_amdgcn_rsqf(((v[i][0] + v[i][1]) + (v[i][2] + v[i][3])) * (1.0f / 1024.0f) + 1e-6f);
}

template <int ACT> struct EpiScale {
    static constexpr bool PERM = true, AFTER_DRAIN = false;
    bf16_t* O; int ldc; const float* ss; float* flog; int flog_tile; int store_tiles;
    __device__ __forceinline__ void operator()(const f32x4 (&acc)[2][2][4][2], const Unit& u, int wr, int wc, int fr, int fq) const {
        const int row0 = u.pm * BM + wr * 64 + fr, col0 = u.pn * BM + wc * 32 + 8 * fq;
        float rs[8]; rstd8(ss, row0, rs);
#pragma unroll
        for (int ai = 0; ai < 2; ++ai)
#pragma unroll
            for (int m = 0; m < 4; ++m) { const int row = row0 + ai * HALF + m * 16; const float r_ = rs[ai * 4 + m];
#pragma unroll
                for (int bj = 0; bj < 2; ++bj) { f32x4 v0 = acc[ai][bj][m][0] * r_, v1 = acc[ai][bj][m][1] * r_;
                    if (ACT == 1) { v0 = (f32x4){sigmoidf_(v0[0]), sigmoidf_(v0[1]), sigmoidf_(v0[2]), sigmoidf_(v0[3])}; v1 = (f32x4){sigmoidf_(v1[0]), sigmoidf_(v1[1]), sigmoidf_(v1[2]), sigmoidf_(v1[3])}; }
                    if (u.pn < store_tiles) { u32x4 w; w.x = pk2_(v0[0], v0[1]); w.y = pk2_(v0[2], v0[3]); w.z = pk2_(v1[0], v1[1]); w.w = pk2_(v1[2], v1[3]);
                        *(u32x4*)(O + ((unsigned)row * (unsigned)ldc + (unsigned)(col0 + bj * HALF))) = w; }
                    if (u.pn == flog_tile && bj == 0 && wc == 0 && fq == 0) *(f32x4*)(flog + (unsigned)row * 4u) = v0; } }
    }
};
template <int FIRST> struct EpiBranch {
    static constexpr bool PERM = true, AFTER_DRAIN = false;
    bf16_t* T; const bf16_t* gates; int gcol0;
    __device__ __forceinline__ void operator()(const f32x4 (&acc)[2][2][4][2], const Unit& u, int wr, int wc, int fr, int fq) const {
        const int row0 = u.pm * BM + wr * 64 + fr, col0 = u.pn * BM + wc * 32 + 8 * fq;
#pragma unroll
        for (int ai = 0; ai < 2; ++ai)
#pragma unroll
        for (int mh = 0; mh < 2; ++mh) { u32x4 g[2][2], p[2][2];
#pragma unroll
            for (int mm = 0; mm < 2; ++mm)
#pragma unroll
                for (int bj = 0; bj < 2; ++bj) { const int row = row0 + ai * HALF + (2 * mh + mm) * 16, col = col0 + bj * HALF;
                    g[mm][bj] = *(const u32x4*)(gates + ((unsigned)row * 3072u + (unsigned)(gcol0 + col)));
                    if (!FIRST) p[mm][bj] = *(const u32x4*)(T + ((unsigned)row * 1024u + (unsigned)col)); else p[mm][bj] = (u32x4){0u, 0u, 0u, 0u}; }
#pragma unroll
            for (int mm = 0; mm < 2; ++mm)
#pragma unroll
                for (int bj = 0; bj < 2; ++bj) { const int m = 2 * mh + mm, row = row0 + ai * HALF + m * 16, col = col0 + bj * HALF;
                    const f32x4 a0 = acc[ai][bj][m][0], a1 = acc[ai][bj][m][1]; const u32x4 gg = g[mm][bj], pp = p[mm][bj]; u32x4 w;
                    w.x = pk2_(bflo_(pp.x) + bflo_(gg.x) * a0[0], bfhi_(pp.x) + bfhi_(gg.x) * a0[1]);
                    w.y = pk2_(bflo_(pp.y) + bflo_(gg.y) * a0[2], bfhi_(pp.y) + bfhi_(gg.y) * a0[3]);
                    w.z = pk2_(bflo_(pp.z) + bflo_(gg.z) * a1[0], bfhi_(pp.z) + bfhi_(gg.z) * a1[1]);
                    w.w = pk2_(bflo_(pp.w) + bflo_(gg.w) * a1[2], bfhi_(pp.w) + bfhi_(gg.w) * a1[3]);
                    *(u32x4*)(T + ((unsigned)row * 1024u + (unsigned)col)) = w; }
            asm volatile("" ::: "memory"); }
    }
};
template <bool IN_F32, bool OUT_F32> struct EpiResid {
    static constexpr bool PERM = true, AFTER_DRAIN = true;
    const float* Xin; const bf16_t* Hin; const bf16_t* Lin; float* X; bf16_t* Hout; bf16_t* Lout; float* ss;
    __device__ __forceinline__ void ldx(u32x4 (&x)[2][2][2], int row0, int col0, int b) const {
#pragma unroll
        for (int mm = 0; mm < 2; ++mm)
#pragma unroll
            for (int bj = 0; bj < 2; ++bj) { const unsigned xoff = (unsigned)(row0 + (b >> 1) * HALF + ((b & 1) * 2 + mm) * 16) * 1024u + (unsigned)(col0 + bj * HALF);
                if (IN_F32) { x[mm][bj][0] = *(const u32x4*)(Xin + xoff); x[mm][bj][1] = *(const u32x4*)(Xin + xoff + 4); }
                else { x[mm][bj][0] = *(const u32x4*)(Hin + xoff); x[mm][bj][1] = *(const u32x4*)(Lin + xoff); } }
    }
    __device__ __forceinline__ void fused(f32x4 (&acc)[2][2][4][2], const Unit& u, int wr, int wc, int fr, int fq, PG8_LAS unsigned char* lds, int wid, int lane) const {
        const int row0 = u.pm * BM + wr * 64 + fr, col0 = u.pn * BM + wc * 32 + 8 * fq;
        PG8_LAS float* P = (PG8_LAS float*)lds;
        u32x4 x[2][2][2][2];
        ldx(x[0], row0, col0, 0);
#pragma unroll
        for (int b = 0; b < 4; ++b) { const int ai = b >> 1;
            if (b + 1 < 4) ldx(x[(b + 1) & 1], row0, col0, b + 1);
#pragma unroll
            for (int mm = 0; mm < 2; ++mm) { const int m = (b & 1) * 2 + mm; const int row = row0 + ai * HALF + m * 16; float q = 0.f;
#pragma unroll
                for (int bj = 0; bj < 2; ++bj) { const unsigned xoff = (unsigned)row * 1024u + (unsigned)(col0 + bj * HALF);
                    const u32x4 r0 = x[b & 1][mm][bj][0], r1 = x[b & 1][mm][bj][1]; f32x4 x0, x1;
                    if (IN_F32) { x0 = __builtin_bit_cast(f32x4, r0); x1 = __builtin_bit_cast(f32x4, r1); }
                    else { x0 = (f32x4){bflo_(r0.x) + bflo_(r1.x), bfhi_(r0.x) + bfhi_(r1.x), bflo_(r0.y) + bflo_(r1.y), bfhi_(r0.y) + bfhi_(r1.y)};
                           x1 = (f32x4){bflo_(r0.z) + bflo_(r1.z), bfhi_(r0.z) + bfhi_(r1.z), bflo_(r0.w) + bflo_(r1.w), bfhi_(r0.w) + bfhi_(r1.w)}; }
                    const f32x4 v0 = x0 + acc[ai][bj][m][0], v1 = x1 + acc[ai][bj][m][1];
                    if (OUT_F32) { *(f32x4*)(X + xoff) = v0; *(f32x4*)(X + xoff + 4) = v1; }
                    else { u32x4 w; w.x = pk2_(v0[0], v0[1]); w.y = pk2_(v0[2], v0[3]); w.z = pk2_(v1[0], v1[1]); w.w = pk2_(v1[2], v1[3]);
                        u32x4 e; e.x = pk2_(v0[0] - bflo_(w.x), v0[1] - bfhi_(w.x)); e.y = pk2_(v0[2] - bflo_(w.y), v0[3] - bfhi_(w.y)); e.z = pk2_(v1[0] - bflo_(w.z), v1[1] - bfhi_(w.z)); e.w = pk2_(v1[2] - bflo_(w.w), v1[3] - bfhi_(w.w));
                        *(u32x4*)(Hout + xoff) = w; *(u32x4*)(Lout + xoff) = e;
                        q += (v0[0] * v0[0] + v0[1] * v0[1]) + (v0[2] * v0[2] + v0[3] * v0[3]) + (v1[0] * v1[0] + v1[1] * v1[1]) + (v1[2] * v1[2] + v1[3] * v1[3]); } }
                if (!OUT_F32) { q += __shfl_xor(q, 16); q += __shfl_xor(q, 32);
                    if (fq == 0) P[(ai * HALF + wr * 64 + m * 16 + fr) * 4 + wc] = q; } }
            asm volatile("" ::: "memory"); }
        if (OUT_F32) return;
        asm volatile("s_waitcnt lgkmcnt(0)" ::: "memory"); __builtin_amdgcn_s_barrier(); asm volatile("" ::: "memory");
        if (lane < 32) { const int row = wid * 32 + lane; const f32x4 pv = *(const PG8_LAS f32x4*)(P + row * 4);
            ss[(unsigned)(u.pm * BM + row) * 4u + (unsigned)u.pn] = (pv[0] + pv[1]) + (pv[2] + pv[3]); }
    }
};
struct EpiSwiglu {
    static constexpr bool PERM = true, AFTER_DRAIN = false;
    bf16_t* H; const float* ss;
    __device__ __forceinline__ void operator()(const f32x4 (&acc)[2][2][4][2], const Unit& u, int wr, int wc, int fr, int fq) const {
        const int row0 = u.pm * BM + wr * 64 + fr, col0 = u.pn * HALF + wc * 32 + 8 * fq;
        float rs[8]; rstd8(ss, row0, rs);
#pragma unroll
        for (int ai = 0; ai < 2; ++ai) { if (u.half == 2 - ai) continue;
#pragma unroll
            for (int m = 0; m < 4; ++m) { const int row = row0 + ai * HALF + m * 16; const float r_ = rs[ai * 4 + m];
                float h[8];
#pragma unroll
                for (int n = 0; n < 2; ++n)
#pragma unroll
                    for (int i = 0; i < 4; ++i) { const float g = acc[ai][0][m][n][i] * r_, uu = acc[ai][1][m][n][i] * r_; h[4 * n + i] = g * sigmoidf_(g) * uu; }
                u32x4 w; w.x = pk2_(h[0], h[1]); w.y = pk2_(h[2], h[3]); w.z = pk2_(h[4], h[5]); w.w = pk2_(h[6], h[7]);
                *(u32x4*)(H + ((unsigned)row * 2816u + (unsigned)col0)) = w; } }
    }
};
struct EpiProbe {
    static constexpr bool PERM = true, AFTER_DRAIN = false;
    float* sink; int flag;
    __device__ __forceinline__ void operator()(const f32x4 (&acc)[2][2][4][2], const Unit& u, int wr, int wc, int fr, int fq) const {
        if (flag) {
#pragma unroll
            for (int ai = 0; ai < 2; ++ai)
#pragma unroll
                for (int bj = 0; bj < 2; ++bj)
#pragma unroll
                    for (int m = 0; m < 4; ++m)
#pragma unroll
                        for (int n = 0; n < 2; ++n) *(f32x4*)(sink + (((u.pm * 4 + u.pn) * 512 + wr * 256 + wc * 64 + fq * 16 + fr) * 16 + ai * 8 + bj * 4 + m) * 8 + n * 4) = acc[ai][bj][m][n]; }
    }
};
template <class Epi, class Sched, bool ALIGN_EPI = false, bool SP2 = false>
__device__ __forceinline__ void gemm_phase(PG8_LAS unsigned char* lds, const Gemm g, const Sched& S, const Epi& E, const int tid) {
    const int wid = __builtin_amdgcn_readfirstlane(tid >> 6), lane = tid & 63, wr = wid >> 2, wc = wid & 3, fr = lane & 15, fq = lane >> 4;
    const int K = g.K, nt = K / BK, lda = g.lda ? g.lda : g.K;
    unsigned voffA[2], voffB[2];
#pragma unroll
    for (int i = 0; i < 2; ++i) { int R, C; stage_rc(tid * 16 + i * 8192, R, C); const int Rb = Epi::PERM ? ((R & ~31) + perm32(R & 31)) : R;
        voffA[i] = (unsigned)(R * lda + C) * 2u; voffB[i] = (unsigned)(Rb * K + C) * 2u; }
    const size_t kstep = (size_t)(BK * 2);
    const size_t hstep = (size_t)HALF * K * 2;
    const size_t tstep = 2 * hstep;
    const size_t hstepA = (size_t)HALF * lda * 2, tstepA = 2 * hstepA;
    const unsigned ldsw = (unsigned)wid * 1024u;
    const int aoff = lds_byte(wr * 64 + fr, fq * 8), boff = lds_byte(wc * 32 + fr, fq * 8);
#define PG8_SA(b, h) (((b) * 2 + (h)) * HTB)
#define PG8_SB(b, h) ((4 + (b) * 2 + (h)) * HTB)
#define PG8_STAGE(bufoff, gbase, voff) do { _Pragma("unroll") for (int _i = 0; _i < 2; ++_i) \
        __builtin_amdgcn_global_load_lds((const unsigned*)((const char*)(gbase) + (voff)[_i]), (PG8_LAS unsigned*)(lds + (bufoff) + ldsw + _i * 8192), 16, 0, 0); } while (0)
#define PG8_LDA(dst, b, h) do { _Pragma("unroll") for (int m = 0; m < 4; ++m) _Pragma("unroll") for (int k = 0; k < 2; ++k) dst[m][k] = *(const PG8_LAS bf16x8*)(lds + PG8_SA(b, h) + aoff + m * 2048 + k * 1024); } while (0)
#define PG8_LDB(dst, b, h) do { _Pragma("unroll") for (int n = 0; n < 2; ++n) _Pragma("unroll") for (int k = 0; k < 2; ++k) dst[n][k] = *(const PG8_LAS bf16x8*)(lds + PG8_SB(b, h) + boff + n * 2048 + k * 1024); } while (0)
#define PG8_MMA(ai, bj, At, Bt) do { __builtin_amdgcn_s_setprio(1); _Pragma("unroll") for (int m = 0; m < 4; ++m) _Pragma("unroll") for (int n = 0; n < 2; ++n) _Pragma("unroll") for (int k = 0; k < 2; ++k) \
        acc[ai][bj][m][n] = __builtin_amdgcn_mfma_f32_16x16x32_bf16(Bt[n][k], At[m][k], acc[ai][bj][m][n], 0, 0, 0); __builtin_amdgcn_s_setprio(0); } while (0)
#define PG8_WAIT_V(n) asm volatile("s_waitcnt vmcnt(" #n ")" ::: "memory")
#define PG8_WAIT_L(n) asm volatile("s_waitcnt lgkmcnt(" #n ")" ::: "memory")
#define PG8_BAR __builtin_amdgcn_s_barrier()
#define PG8_SCHED __builtin_amdgcn_sched_barrier(0)
    Unit cur, nxt; int ui = 0;
    if (!S.next(0, cur)) return;
    f32x4 acc[2][2][4][2];
#pragma unroll
    for (int a = 0; a < 2; ++a)
#pragma unroll
        for (int b = 0; b < 2; ++b)
#pragma unroll
            for (int m = 0; m < 4; ++m)
#pragma unroll
                for (int n = 0; n < 2; ++n) acc[a][b][m][n] = (f32x4){0.f, 0.f, 0.f, 0.f};
    bf16x8 At[4][2], B0[2][2], B1[2][2];
    const char* cA = (const char*)g.A + (size_t)cur.pm * tstepA; const char* cB = (const char*)g.Bt + (size_t)cur.pn * tstep;
    S.a_ready(cur);
    if constexpr (SP2) {
        PG8_STAGE(PG8_SB(0, 0), cB, voffB); PG8_STAGE(PG8_SB(0, 1), cB + hstep, voffB); PG8_STAGE(PG8_SA(0, 0), cA, voffA); PG8_STAGE(PG8_SA(0, 1), cA + hstepA, voffA);
        if (wr == 1) PG8_BAR;
        PG8_WAIT_V(2); PG8_BAR;
        PG8_STAGE(PG8_SB(1, 0), cB + kstep, voffB); PG8_STAGE(PG8_SA(1, 0), cA + kstep, voffA); PG8_STAGE(PG8_SB(1, 1), cB + hstep + kstep, voffB);
        PG8_WAIT_V(6); PG8_BAR;
    } else {
        PG8_STAGE(PG8_SB(0, 0), cB, voffB); PG8_STAGE(PG8_SA(0, 0), cA, voffA); PG8_STAGE(PG8_SB(0, 1), cB + hstep, voffB); PG8_STAGE(PG8_SA(0, 1), cA + hstepA, voffA);
        if (wr == 1) PG8_BAR;
        PG8_WAIT_V(4); PG8_BAR;
        PG8_STAGE(PG8_SB(1, 0), cB + kstep, voffB); PG8_STAGE(PG8_SA(1, 0), cA + kstep, voffA); PG8_STAGE(PG8_SB(1, 1), cB + hstep + kstep, voffB);
        PG8_WAIT_V(6); PG8_BAR;
    }
    for (;;) {
        const bool has_next = S.next(ui + 1, nxt);
        const char* nA = has_next ? (const char*)g.A + (size_t)nxt.pm * tstepA : cA; const char* nB = has_next ? (const char*)g.Bt + (size_t)nxt.pn * tstep : cB;
        for (int t = 0; t < nt; t += 2) {
            const bool last = (t == nt - 2);
            const char* a1 = cA + (size_t)(t + 1) * kstep;
            const char* a2 = last ? nA : cA + (size_t)(t + 2) * kstep; const char* b2 = last ? nB : cB + (size_t)(t + 2) * kstep;
            const char* a3 = a2 + kstep; const char* b3 = b2 + kstep;
            if (last && has_next) S.a_ready(nxt);
            if constexpr (SP2) {
            PG8_LDB(B0, 0, 0); PG8_LDB(B1, 0, 1); PG8_SCHED; PG8_LDA(At, 0, 0); PG8_STAGE(PG8_SA(1, 1), a1 + hstepA, voffA);
            PG8_WAIT_V(8); PG8_WAIT_L(0); PG8_BAR; if (!Sched::HALVES || cur.half != 2) { PG8_MMA(0, 0, At, B0); PG8_MMA(0, 1, At, B1); } PG8_BAR; PG8_SCHED;
            PG8_LDA(At, 0, 1); PG8_STAGE(PG8_SB(0, 0), b2, voffB); PG8_STAGE(PG8_SB(0, 1), b2 + hstep, voffB); PG8_STAGE(PG8_SA(0, 0), a2, voffA);
            PG8_WAIT_V(8); PG8_WAIT_L(0); PG8_BAR; if (!Sched::HALVES || cur.half != 1) { PG8_MMA(1, 0, At, B0); PG8_MMA(1, 1, At, B1); } PG8_BAR; PG8_SCHED;
            PG8_LDB(B0, 1, 0); PG8_LDB(B1, 1, 1); PG8_SCHED; PG8_LDA(At, 1, 0); PG8_STAGE(PG8_SA(0, 1), a2 + hstepA, voffA);
            PG8_WAIT_V(8); PG8_WAIT_L(0); PG8_BAR; if (!Sched::HALVES || cur.half != 2) { PG8_MMA(0, 0, At, B0); PG8_MMA(0, 1, At, B1); } PG8_BAR; PG8_SCHED;
            PG8_LDA(At, 1, 1); PG8_STAGE(PG8_SB(1, 0), b3, voffB); PG8_STAGE(PG8_SB(1, 1), b3 + hstep, voffB); PG8_STAGE(PG8_SA(1, 0), a3, voffA);
            PG8_WAIT_V(8); PG8_WAIT_L(0); PG8_BAR; if (!Sched::HALVES || cur.half != 1) { PG8_MMA(1, 0, At, B0); PG8_MMA(1, 1, At, B1); } PG8_BAR; PG8_SCHED;
            } else {
            PG8_LDB(B0, 0, 0); PG8_SCHED; PG8_LDA(At, 0, 0); PG8_STAGE(PG8_SA(1, 1), a1 + hstepA, voffA);
            PG8_WAIT_L(8); PG8_BAR; PG8_WAIT_L(0); PG8_MMA(0, 0, At, B0); PG8_BAR; PG8_SCHED;
            PG8_LDB(B1, 0, 1); PG8_STAGE(PG8_SB(0, 0), b2, voffB);
            PG8_BAR; PG8_WAIT_L(0); PG8_MMA(0, 1, At, B1); PG8_BAR;
            PG8_LDA(At, 0, 1); PG8_STAGE(PG8_SA(0, 0), a2, voffA);
            PG8_BAR; PG8_WAIT_L(0); PG8_MMA(1, 0, At, B0); PG8_BAR; PG8_SCHED;
            PG8_STAGE(PG8_SB(0, 1), b2 + hstep, voffB);
            PG8_WAIT_V(6); PG8_BAR; PG8_MMA(1, 1, At, B1); PG8_BAR;
            PG8_LDB(B0, 1, 0); PG8_SCHED; PG8_LDA(At, 1, 0); PG8_STAGE(PG8_SA(0, 1), a2 + hstepA, voffA);
            PG8_WAIT_L(8); PG8_BAR; PG8_WAIT_L(0); PG8_MMA(0, 0, At, B0); PG8_BAR; PG8_SCHED;
            PG8_LDB(B1, 1, 1); PG8_STAGE(PG8_SB(1, 0), b3, voffB);
            PG8_BAR; PG8_WAIT_L(0); PG8_MMA(0, 1, At, B1); PG8_BAR;
            PG8_LDA(At, 1, 1); PG8_STAGE(PG8_SA(1, 0), a3, voffA);
            PG8_BAR; PG8_WAIT_L(0); PG8_MMA(1, 0, At, B0); PG8_BAR; PG8_SCHED;
            PG8_STAGE(PG8_SB(1, 1), b3 + hstep, voffB);
            PG8_WAIT_V(6); PG8_BAR; PG8_MMA(1, 1, At, B1); PG8_BAR;
            }
        }
        if constexpr (ALIGN_EPI) { if (wr == 0) PG8_BAR; }
        if constexpr (!Epi::AFTER_DRAIN) { E(acc, cur, wr, wc, fr, fq); S.done(cur); }
        if (!has_next) break;
#pragma unroll
        for (int a = 0; a < 2; ++a)
#pragma unroll
            for (int b = 0; b < 2; ++b)
#pragma unroll
                for (int m = 0; m < 4; ++m)
#pragma unroll
                    for (int n = 0; n < 2; ++n) acc[a][b][m][n] = (f32x4){0.f, 0.f, 0.f, 0.f};
        cur = nxt; cA = nA; cB = nB; ++ui;
        if constexpr (ALIGN_EPI) { if (wr == 1) PG8_BAR; }
    }
    PG8_WAIT_V(0);
    if constexpr (!ALIGN_EPI) { if (wr == 0) PG8_BAR; }
    PG8_BAR;
    if constexpr (Epi::AFTER_DRAIN) { E.fused(acc, cur, wr, wc, fr, fq, lds, wid, lane); S.done(cur); }
}
template <class Sched>
__device__ __forceinline__ void gemm_phase_seg(PG8_LAS unsigned char* lds, const bf16_t* A0, const bf16_t* A1, const bf16_t* A2, const bf16_t* Bt0, const bf16_t* gates, bf16_t* T, const Sched& S, const int tid) {
    const int wid = __builtin_amdgcn_readfirstlane(tid >> 6), lane = tid & 63, wr = wid >> 2, wc = wid & 3, fr = lane & 15, fq = lane >> 4;
    constexpr int K = 256, nt = 12;
    unsigned voffA[2], voffB[2];
#pragma unroll
    for (int i = 0; i < 2; ++i) { int R, C; stage_rc(tid * 16 + i * 8192, R, C); const int Rb = (R & ~31) + perm32(R & 31);
        voffA[i] = (unsigned)(R * K + C) * 2u; voffB[i] = (unsigned)(Rb * K + C) * 2u; }
    const size_t kstep = (size_t)(BK * 2), hstep = (size_t)HALF * K * 2, tstep = 2 * hstep, tstepA = hstep, hstepA = 0, sstepB = (size_t)1024 * K * 2;
    const unsigned ldsw = (unsigned)wid * 1024u;
    const int aoff = lds_byte(wr * 64 + fr, fq * 8), boff = lds_byte(wc * 32 + fr, fq * 8);
#define PG8_SEGA(off, t) ((const char*)((t) < 4 ? A0 : (t) < 8 ? A1 : A2) + (off) + (size_t)((t) & 3) * kstep)
#define PG8_SEGB(off, t) ((const char*)Bt0 + (size_t)((t) >> 2) * sstepB + (off) + (size_t)((t) & 3) * kstep)
    Unit cur, nxt; int ui = 0;
    if (!S.next(0, cur)) return;
    f32x4 acc[2][2][4][2];
#pragma unroll
    for (int a = 0; a < 2; ++a)
#pragma unroll
        for (int b = 0; b < 2; ++b)
#pragma unroll
            for (int m = 0; m < 4; ++m)
#pragma unroll
                for (int n = 0; n < 2; ++n) acc[a][b][m][n] = (f32x4){0.f, 0.f, 0.f, 0.f};
    bf16x8 At[4][2], B0[2][2], B1[2][2];
    size_t cAo = (size_t)cur.pm * tstepA, cBo = (size_t)cur.pn * tstep;
    { const char* cA = PG8_SEGA(cAo, 0); const char* cB = PG8_SEGB(cBo, 0);
      PG8_STAGE(PG8_SB(0, 0), cB, voffB); PG8_STAGE(PG8_SB(0, 1), cB + hstep, voffB); PG8_STAGE(PG8_SA(0, 0), cA, voffA); PG8_STAGE(PG8_SA(0, 1), cA + hstepA, voffA);
      if (wr == 1) PG8_BAR;
      PG8_WAIT_V(2); PG8_BAR;
      PG8_STAGE(PG8_SB(1, 0), cB + kstep, voffB); PG8_STAGE(PG8_SA(1, 0), cA + kstep, voffA); PG8_STAGE(PG8_SB(1, 1), cB + hstep + kstep, voffB);
      PG8_WAIT_V(6); PG8_BAR; }
    for (;;) {
        const bool has_next = S.next(ui + 1, nxt);
        const size_t nAo = has_next ? (size_t)nxt.pm * tstepA : cAo, nBo = has_next ? (size_t)nxt.pn * tstep : cBo;
        for (int t = 0; t < nt; t += 2) {
            const bool last = (t == nt - 2);
            const char* a1 = PG8_SEGA(cAo, t + 1);
            const char* a2 = last ? PG8_SEGA(nAo, 0) : PG8_SEGA(cAo, t + 2); const char* b2 = last ? PG8_SEGB(nBo, 0) : PG8_SEGB(cBo, t + 2);
            const char* a3 = a2 + kstep; const char* b3 = b2 + kstep;
            PG8_LDB(B0, 0, 0); PG8_LDB(B1, 0, 1); PG8_SCHED; PG8_LDA(At, 0, 0); PG8_STAGE(PG8_SA(1, 1), a1 + hstepA, voffA);
            PG8_WAIT_V(8); PG8_WAIT_L(0); PG8_BAR; PG8_MMA(0, 0, At, B0); PG8_MMA(0, 1, At, B1); PG8_BAR; PG8_SCHED;
            PG8_STAGE(PG8_SB(0, 0), b2, voffB); PG8_STAGE(PG8_SB(0, 1), b2 + hstep, voffB); PG8_STAGE(PG8_SA(0, 0), a2, voffA);
            PG8_WAIT_V(8); PG8_WAIT_L(0); PG8_BAR; PG8_BAR; PG8_SCHED;
            PG8_LDB(B0, 1, 0); PG8_LDB(B1, 1, 1); PG8_SCHED; PG8_LDA(At, 1, 0); PG8_STAGE(PG8_SA(0, 1), a2 + hstepA, voffA);
            PG8_WAIT_V(8); PG8_WAIT_L(0); PG8_BAR; PG8_MMA(0, 0, At, B0); PG8_MMA(0, 1, At, B1); PG8_BAR; PG8_SCHED;
            PG8_STAGE(PG8_SB(1, 0), b3, voffB); PG8_STAGE(PG8_SB(1, 1), b3 + hstep, voffB); PG8_STAGE(PG8_SA(1, 0), a3, voffA);
            PG8_WAIT_V(8); PG8_WAIT_L(0); PG8_BAR; PG8_BAR; PG8_SCHED;
            if ((t & 3) == 2) {
                const int seg = t >> 2; unsigned row0 = (unsigned)(cur.pm * HALF + wr * 64 + fr), col0 = (unsigned)(cur.pn * BM + wc * 32 + 8 * fq); asm volatile("" : "+v"(row0), "+v"(col0));
#pragma unroll
                for (int bj = 0; bj < 2; ++bj) { u32x4 gg[4];
#pragma unroll
                    for (int m = 0; m < 4; ++m) gg[m] = *(const u32x4*)(gates + ((row0 + m * 16) * 3072u + ((unsigned)(seg * 1024 + bj * HALF) + col0)));
#pragma unroll
                    for (int m = 0; m < 4; ++m) { const u32x4 g_ = gg[m]; f32x4 a0 = acc[0][bj][m][0], a1 = acc[0][bj][m][1], t0 = acc[1][bj][m][0], t1 = acc[1][bj][m][1];
                        { float q0 = t0[0], q1 = t0[1], q2 = t0[2], q3 = t0[3], q4 = t1[0], q5 = t1[1], q6 = t1[2], q7 = t1[3];
#define PG8_FMAC(t, g, a) asm("v_fmac_f32 %0, %1, %2" : "+v"(t) : "v"(g), "v"(a))
                          PG8_FMAC(q0, bflo_(g_.x), a0[0]); PG8_FMAC(q1, bfhi_(g_.x), a0[1]); PG8_FMAC(q2, bflo_(g_.y), a0[2]); PG8_FMAC(q3, bfhi_(g_.y), a0[3]);
                          PG8_FMAC(q4, bflo_(g_.z), a1[0]); PG8_FMAC(q5, bfhi_(g_.z), a1[1]); PG8_FMAC(q6, bflo_(g_.w), a1[2]); PG8_FMAC(q7, bfhi_(g_.w), a1[3]);
#undef PG8_FMAC
                          t0 = (f32x4){q0, q1, q2, q3}; t1 = (f32x4){q4, q5, q6, q7}; }
                        acc[1][bj][m][0] = t0; acc[1][bj][m][1] = t1; acc[0][bj][m][0] = (f32x4){0.f, 0.f, 0.f, 0.f}; acc[0][bj][m][1] = (f32x4){0.f, 0.f, 0.f, 0.f};
                        if (seg == 2) { u32x4 w; w.x = pk2_(t0[0], t0[1]); w.y = pk2_(t0[2], t0[3]); w.z = pk2_(t1[0], t1[1]); w.w = pk2_(t1[2], t1[3]);
                            *(u32x4*)(T + ((row0 + m * 16) * 1024u + (col0 + bj * HALF))) = w; } }
                    asm volatile("" ::: "memory"); }
            }
        }
        if (wr == 0) PG8_BAR;
        if (!has_next) break;
#pragma unroll
        for (int b = 0; b < 2; ++b)
#pragma unroll
            for (int m = 0; m < 4; ++m)
#pragma unroll
                for (int n = 0; n < 2; ++n) acc[1][b][m][n] = (f32x4){0.f, 0.f, 0.f, 0.f};
        cur = nxt; cAo = nAo; cBo = nBo; ++ui;
        if (wr == 1) PG8_BAR;
    }
    PG8_WAIT_V(0);
    PG8_BAR;
#undef PG8_SEGA
#undef PG8_SEGB
#undef PG8_SA
#undef PG8_SB
#undef PG8_STAGE
#undef PG8_LDA
#undef PG8_LDB
#undef PG8_MMA
#undef PG8_WAIT_V
#undef PG8_WAIT_L
#undef PG8_BAR
#undef PG8_SCHED
}
}
#ifndef PG8_SP2
#define PG8_SP2 true
#endif
#ifndef PG8_ALIGN
#define PG8_ALIGN true
#endif
constexpr int NWAVES = 8;
constexpr int BATCH = 2, SEQ = 8192, D = 1024, M = BATCH * SEQ, DEPTH = 2;
constexpr int IN_COLS = 5892, NMIX = 3072, MIXLD = 2816, NGATE = 3072, DFF = 2816, NGU = 2 * DFF;
constexpr int C_RETQ = 0, C_RETK = 256, C_RETV = 512, C_RETG = 768, C_FOXQ = 1024, C_FOXK = 1280, C_FOXV = 1536, C_RW = 1792;
constexpr size_t MiB = 1u << 20;
constexpr size_t WS_CTL = 0, CTL_ZERO_BYTES = 64 * 1024;
constexpr size_t WS_WIN = 1 * MiB, WS_WGATE = 7 * MiB, WS_PBR = 13 * MiB, WS_WOUT = 14 * MiB + 512 * 1024, WS_WGU = 16 * MiB + 512 * 1024, WS_WDOWN = 27 * MiB + 512 * 1024;
constexpr size_t WS_XB = 33 * MiB;
constexpr size_t WS_RB = 65 * MiB;
constexpr size_t WS_BIG = 97 * MiB;
constexpr size_t WS_SW = 193 * MiB, WS_REC = 209 * MiB, WS_SA = 225 * MiB;
constexpr size_t WS_TT = 241 * MiB;
constexpr size_t WS_YL = WS_RB;
constexpr size_t WS_LS = WS_RB + 16 * MiB;
constexpr size_t WS_U = WS_BIG + 88 * MiB;
constexpr size_t WS_BS = 251 * MiB + 512 * 1024;
constexpr size_t WS_XLO = WS_SW;
constexpr size_t WS_SIN = WS_SW;
constexpr size_t WS_FO0 = WS_SA + 4 * MiB;
constexpr size_t WS_FL0 = WS_SA + 12 * MiB, WS_FL1 = WS_SA + 12 * MiB + 512 * 1024;
constexpr size_t WS_RP = 1 * MiB;
constexpr size_t WS_SEGT = 254 * MiB + 512 * 1024;
constexpr size_t WS_G2T = 254 * MiB;
constexpr size_t WS_YR = WS_REC, WS_YF = WS_REC + 8 * MiB, WS_YW = WS_TT;
constexpr size_t WS_SS1 = 249 * MiB, WS_SS2 = 250 * MiB;
constexpr size_t WS_FLOG = 251 * MiB, WS_CUM = 251 * MiB + 256 * 1024;
constexpr size_t WS_ROPE = 252 * MiB;
constexpr size_t WS_END = 256 * MiB;
constexpr int CW_TMO = 0, CW_CODE = 1, CW_BAR = 4096, CW_QUEUE = 8192;
constexpr int RING_OFF = 0, RING_BYTES = 131072;
constexpr int LDSCTL_OFF = RING_BYTES, MISC_OFF = LDSCTL_OFF + 320;
constexpr int LDS_BYTES = 147456;
#define GAS __attribute__((address_space(1)))
#define LAS __attribute__((address_space(3)))
typedef unsigned short bf16;
typedef unsigned v4u __attribute__((ext_vector_type(4)));
typedef float f32x4 __attribute__((ext_vector_type(4)));
typedef short bf16x8 __attribute__((ext_vector_type(8)));
typedef GAS unsigned gu32;
typedef GAS unsigned long long gu64;
#define RLX_AGENT __ATOMIC_RELAXED, __HIP_MEMORY_SCOPE_AGENT
#define LDS_WAIT() asm volatile("s_waitcnt lgkmcnt(0)" ::: "memory")
#define VM_WAIT() asm volatile("s_waitcnt vmcnt(0)" ::: "memory")
__device__ __forceinline__ unsigned long long rt() { return __builtin_amdgcn_s_memrealtime(); }
typedef float f32x2h __attribute__((ext_vector_type(2))); typedef __bf16 bf16x2h __attribute__((ext_vector_type(2)));
__device__ __forceinline__ unsigned f2bf(float f) { const f32x2h v = {f, f}; return __builtin_bit_cast(unsigned, __builtin_convertvector(v, bf16x2h)) & 0xffffu; }
typedef float f32x2g __attribute__((ext_vector_type(2))); typedef __bf16 bf16x2g __attribute__((ext_vector_type(2)));
__device__ __forceinline__ unsigned pk2(float lo, float hi) { const f32x2g v = {lo, hi}; return __builtin_bit_cast(unsigned, __builtin_convertvector(v, bf16x2g)); }

#define XB_TMO      128
#define XB_XCNT(j)  (256  + 64 * (j))
#define XB_XSUB(j)  (1280 + 64 * (j))
#define XB_XGEN(j)  (2304 + 64 * (j))
#define XB_TOP      3328
#define XB_TOPGEN   3392
#define XCD_BAR_WORDS 3456
#define XB_SPIN_CAP (1u << 18)

__device__ __forceinline__ unsigned xb_ld(unsigned* p)              { return __hip_atomic_load(p, __ATOMIC_RELAXED, __HIP_MEMORY_SCOPE_AGENT); }
__device__ __forceinline__ unsigned xb_add(unsigned* p, unsigned v) { return __hip_atomic_fetch_add(p, v, __ATOMIC_RELAXED, __HIP_MEMORY_SCOPE_AGENT); }
__device__ __forceinline__ unsigned xb_xcc_id() { return (unsigned)__builtin_amdgcn_s_getreg((3 << 11) | 20) & 0xFu; }
#define XB_SPIN(cond, bar) do { unsigned _sp = 0; while (cond) { __builtin_amdgcn_s_sleep(1); \
    if ((++_sp & 255u) == 0u) { if (xb_ld(&(bar)[XB_TMO])) break; if (_sp > XB_SPIN_CAP) { atomicAdd(&(bar)[XB_TMO], 1u); break; } } } } while (0)

struct XcdBarrier {
    unsigned* bar; unsigned x;
    volatile LAS unsigned* st;
};

__device__ __forceinline__ XcdBarrier xcd_barrier_post(unsigned* bar, volatile LAS unsigned* st) {
    XcdBarrier b; b.bar = bar; b.x = xb_xcc_id(); b.st = st;
    if (threadIdx.x == 0) (void)xb_add(&bar[XB_XCNT(b.x)], 1u);
    return b;
}
__device__ __forceinline__ void xcd_barrier_complete(unsigned* bar, unsigned x, unsigned& nloc, unsigned& nx) {
    const unsigned G = gridDim.x * gridDim.y * gridDim.z;
    unsigned sum, cnt, mine, sp = 0u;
    for (;;) {
        sum = 0u; cnt = 0u; mine = 0u;
#pragma unroll
        for (unsigned j = 0; j < 16; ++j) { const unsigned c = xb_ld(&bar[XB_XCNT(j)]); sum += c; cnt += (c > 0u) ? 1u : 0u; mine = (j == x) ? c : mine; }
        if (sum == G) break;
        __builtin_amdgcn_s_sleep(1);
        if ((++sp & 255u) == 0u) { if (xb_ld(&bar[XB_TMO])) break; if (sp > XB_SPIN_CAP) { atomicAdd(&bar[XB_TMO], 1u); break; } }
    }
    nloc = mine > 0u ? mine : 1u; nx = cnt > 0u ? cnt : 1u;
}

__device__ __forceinline__ void xcd_barrier(const XcdBarrier& b, const bool leader_thread) {
    asm volatile("s_waitcnt vmcnt(0)" ::: "memory");
    __syncthreads();
    if (leader_thread) {
        unsigned* bar = b.bar; asm volatile("" : "+s"(bar));
        __builtin_amdgcn_s_waitcnt(0);
        unsigned nloc = b.st[0], nx = b.st[1];
        if (nloc == 0u) { xcd_barrier_complete(bar, b.x, nloc, nx); b.st[0] = nloc; b.st[1] = nx; }
        const unsigned old = xb_add(&bar[XB_XSUB(b.x)], 1u);
        const unsigned gen = old / nloc;
        if (old + 1u == (gen + 1u) * nloc) {
            __builtin_amdgcn_fence(__ATOMIC_RELEASE, "agent");
            asm volatile("s_waitcnt vmcnt(0)" ::: "memory");
            const unsigned og = xb_add(&bar[XB_TOP], 1u);
            const unsigned tg = og / nx;
            if (og + 1u == (tg + 1u) * nx) xb_add(&bar[XB_TOPGEN], 1u);
            else XB_SPIN(xb_ld(&bar[XB_TOPGEN]) == tg, bar);
            __builtin_amdgcn_fence(__ATOMIC_ACQUIRE, "agent");
            xb_add(&bar[XB_XGEN(b.x)], 1u);
            asm volatile("s_waitcnt vmcnt(0)" ::: "memory");
        } else {
            XB_SPIN(xb_ld(&bar[XB_XGEN(b.x)]) == gen, bar);
            __builtin_amdgcn_fence(__ATOMIC_ACQUIRE, "agent");
            asm volatile("s_waitcnt vmcnt(0)" ::: "memory");
        }
    }
    __syncthreads();
}
#include <hip/hip_bf16.h>
#include <cmath>
namespace attn_body {
using bf16=__hip_bfloat16;
using bf16x8=__attribute__((ext_vector_type(8)))short;
using s16x4=__attribute__((ext_vector_type(4)))short;
using f32x16=__attribute__((ext_vector_type(16)))float;
using u32x4=__attribute__((ext_vector_type(4)))unsigned;
using f32x4v=__attribute__((ext_vector_type(4)))float;
constexpr int BATCH=2,NHEAD=4,SEQ=8192,D=64,DM=2816,OP=256;
constexpr int NW=8,QBLK=32,QB=QBLK*NW,KVBLK=64,NQB=SEQ/QB;
constexpr int ATTN_PITCH=DM, ATTN_UNIT_ROWS=QB;
__device__ __forceinline__ int crow(int r,int hi){return (r&3)+8*(r>>2)+4*hi;}
#define SBAR() __builtin_amdgcn_sched_barrier(0)
__device__ __forceinline__ void cmask(f32x16&p0,f32x16&p1,int jb,int qrel,int hi){
  const float NEG=-INFINITY; int kb=64*jb+4*hi;
  #pragma unroll
  for(int r=0;r<16;++r){int kv=kb+(r&3)+8*(r>>2); if(kv>qrel)p0[r]=NEG; if(kv+32>qrel)p1[r]=NEG;}
}

constexpr int NSLOT=3, SLOTB=8192;
constexpr int LDS_K=0, LDS_V=NSLOT*SLOTB, LDS_WS=2*NSLOT*SLOTB, LDS_OST=LDS_WS+NW*64*4, LDS_BIAS=LDS_OST+NW*4096, LDS_BYTES=LDS_BIAS+SEQ*4;
constexpr float C2=0.125f*1.4426950408889634f;
__device__ __forceinline__ void glds16(const void*gsrc,unsigned lds_dst){unsigned keep;
  asm volatile("s_mov_b32 %0, m0\n\ts_mov_b32 m0, %2\n\ts_nop 0\n\tglobal_load_lds_dwordx4 %1, off\n\ts_mov_b32 m0, %0":"=&s"(keep):"v"(gsrc),"s"(lds_dst):"memory");}
__device__ __forceinline__ float max3f(float a,float b,float c){float r;asm("v_max3_f32 %0, %1, %2, %3":"=v"(r):"v"(a),"v"(b),"v"(c));return r;}
__device__ __forceinline__ float max2f(float a,float b){float r;asm("v_max_f32_e32 %0, %1, %2":"=v"(r):"v"(a),"v"(b));return r;}
__device__ __forceinline__ float fadd_s(float a,float b){float r;asm("v_add_f32_e32 %0, %1, %2":"=v"(r):"v"(a),"v"(b));return r;}
__device__ __forceinline__ float fsub_s(float a,float b){float r;asm("v_sub_f32_e32 %0, %1, %2":"=v"(r):"v"(a),"v"(b));return r;}
typedef float f32x2_t __attribute__((ext_vector_type(2))); typedef __bf16 bf16x2_t __attribute__((ext_vector_type(2)));
__device__ __forceinline__ unsigned cvtpk_s(float lo,float hi){f32x2_t v={lo,hi};bf16x2_t b=__builtin_convertvector(v,bf16x2_t);return __builtin_bit_cast(unsigned,b);}
#define WAIT_BAR(N) asm volatile("s_waitcnt vmcnt(" #N ") lgkmcnt(0)\n\ts_barrier":::"memory")

__device__ __forceinline__ void qkt(f32x16&p0,f32x16&p1,const char*Kslot,const bf16x8*qr,int r32,int hi){
  const char*kb=Kslot+hi*1024+r32*16;
  #pragma unroll
  for(int d0=0;d0<4;++d0){
    const bf16x8 b0=*reinterpret_cast<const bf16x8*>(kb+d0*2048);
    const bf16x8 b1=*reinterpret_cast<const bf16x8*>(kb+d0*2048+512);
    p0=__builtin_amdgcn_mfma_f32_32x32x16_bf16(b0,qr[d0],p0,0,0,0);p1=__builtin_amdgcn_mfma_f32_32x32x16_bf16(b1,qr[d0],p1,0,0,0);}
}
typedef __attribute__((address_space(3))) const char* lds_cptr;
typedef short v4i16_t __attribute__((ext_vector_type(4)));
__device__ __forceinline__ void kload8(bf16x8*kf,lds_cptr kp){
  kf[0]=*(const __attribute__((address_space(3))) bf16x8*)(kp);      kf[1]=*(const __attribute__((address_space(3))) bf16x8*)(kp+512);
  kf[2]=*(const __attribute__((address_space(3))) bf16x8*)(kp+2048); kf[3]=*(const __attribute__((address_space(3))) bf16x8*)(kp+2560);
  kf[4]=*(const __attribute__((address_space(3))) bf16x8*)(kp+4096); kf[5]=*(const __attribute__((address_space(3))) bf16x8*)(kp+4608);
  kf[6]=*(const __attribute__((address_space(3))) bf16x8*)(kp+6144); kf[7]=*(const __attribute__((address_space(3))) bf16x8*)(kp+6656);
}
__device__ __forceinline__ void kload2(bf16x8*kf,lds_cptr kp,int j){ kf[2*j]=*(const __attribute__((address_space(3))) bf16x8*)(kp+j*2048); kf[2*j+1]=*(const __attribute__((address_space(3))) bf16x8*)(kp+j*2048+512); }
__device__ __forceinline__ s16x4 vtr(lds_cptr p){ return __builtin_bit_cast(s16x4,__builtin_amdgcn_ds_read_tr16_b64_v4i16((__attribute__((address_space(3))) v4i16_t*)p)); }
__device__ __forceinline__ float rowmax(const f32x16&p0,const f32x16&p1){
  float a=max3f(p0[0],p0[1],p1[0]),b=max3f(p0[2],p0[3],p1[1]);a=max3f(a,p1[2],p1[3]);
  #pragma unroll
  for(int r=4;r<16;r+=4){a=max3f(a,p0[r],p0[r+1]);b=max3f(b,p0[r+2],p0[r+3]);a=max3f(a,p1[r],p1[r+1]);b=max3f(b,p1[r+2],p1[r+3]);}
  const float m=max2f(a,b);
  auto rr=__builtin_amdgcn_permlane32_swap(__float_as_uint(m),__float_as_uint(m),false,false);
  return max2f(__uint_as_float(rr[0]),__uint_as_float(rr[1]));
}
__device__ __forceinline__ void pv(f32x16*o,int vb,bf16x8 pa0,bf16x8 pa1,bf16x8 pa2,bf16x8 pa3){
  #pragma unroll
  for(int d0=0;d0<2;++d0){s16x4 lo[4],hi[4];
    #pragma unroll
    for(int ks=0;ks<4;++ks){
      asm volatile("ds_read_b64_tr_b16 %0,%1 offset:%c2":"=&v"(lo[ks]):"v"(vb),"i"(d0*4096+ks*1024):"memory");
      asm volatile("ds_read_b64_tr_b16 %0,%1 offset:%c2":"=&v"(hi[ks]):"v"(vb),"i"(d0*4096+ks*1024+512):"memory");}
    asm volatile("s_waitcnt lgkmcnt(0)":::"memory");SBAR();
    #define PK(k) (bf16x8){lo[k][0],lo[k][1],lo[k][2],lo[k][3],hi[k][0],hi[k][1],hi[k][2],hi[k][3]}
    o[d0]=__builtin_amdgcn_mfma_f32_32x32x16_bf16(pa0,PK(0),o[d0],0,0,0);
    o[d0]=__builtin_amdgcn_mfma_f32_32x32x16_bf16(pa1,PK(1),o[d0],0,0,0);
    o[d0]=__builtin_amdgcn_mfma_f32_32x32x16_bf16(pa2,PK(2),o[d0],0,0,0);
    o[d0]=__builtin_amdgcn_mfma_f32_32x32x16_bf16(pa3,PK(3),o[d0],0,0,0);
    #undef PK
  }
}

#ifndef ATTN_STORE16
#define ATTN_STORE16(p,v) (*(u32x4*)(p)=(v))
#endif
template<int THRL,int NB=0> __device__ __forceinline__ void attn_unit(int b,int h,int qb,int T0in,int T1,bool mband,float skipthr,const bf16*Q,const bf16*__restrict__ K,const bf16*__restrict__ V,bf16*O,float*lse_out,float*lse_neg,const float*cum,const float*segt,char*shm,int tid){
  const int lane=tid&63,r32=lane&31,hi=lane>>5; const int wid=__builtin_amdgcn_readfirstlane(tid>>6);
  const long rowbase=(long)b*SEQ; const int q0=qb*QB;
  float off[8]; { float r_=0.f; _Pragma("unroll") for(int s_=0;s_<8;++s_){ off[s_]=r_; r_+=segt[s_]; } }
  float cref=cum[q0]; { const int sq=q0>>10; _Pragma("unroll") for(int s_=0;s_<8;++s_) if(s_==sq)cref+=off[s_]; }
  int T0=T0in;
  { int flag=0;
    if(tid<128){ const int jl=64*tid+63; float cj=cum[jl]; { const int sj=jl>>10; _Pragma("unroll") for(int s_=0;s_<8;++s_) if(s_==sj)cj+=off[s_]; } flag=((cref-cj)*1.4426950408889634f< -skipthr)?1:0; }
    const unsigned long long bal=__ballot(flag); int*cnt=(int*)(shm+LDS_WS);
    if(lane==0&&wid<2)cnt[wid]=__builtin_popcountll(bal);
    __syncthreads();
    const int nskip=cnt[0]+cnt[1];
    __syncthreads();
    if(!mband&&nskip>=T1){ if(hi==0)lse_out[(rowbase+q0+wid*QBLK+r32)*4+h]=-INFINITY; return; }
    int t0n=nskip<T1-4?nskip:T1-4; if(t0n>T0){ if((T1-t0n)&1)t0n-=1; T0=t0n; } }
  const bf16*Qw=Q+(rowbase+q0+wid*QBLK)*DM+h*D;
  const bf16*Kh=K+rowbase*DM+h*D,*Vh=V+rowbase*DM+h*D;
  const unsigned lds0=(unsigned)(uintptr_t)shm;
  float*wsf=(float*)(shm+LDS_WS)+wid*64;
  const bf16*ksrc=Kh+(long)(T0*KVBLK+lane)*DM+wid*8;
  const bf16*vsrc=Vh+(long)(T0*KVBLK+16*(wid&3)+(lane>>2))*DM+(wid>>2)*32+(lane&3)*8;
  const unsigned kdst=lds0+LDS_K+wid*1024, vdst=lds0+LDS_V+wid*1024;
  #define DMA_K(t,slot) glds16(ksrc+(long)(t)*KVBLK*DM,(unsigned)__builtin_amdgcn_readfirstlane(kdst+(slot)))
  #define DMA_V(t,slot) glds16(vsrc+(long)(t)*KVBLK*DM,(unsigned)__builtin_amdgcn_readfirstlane(vdst+(slot)))
  const int vb0=(int)(lds0+LDS_V)+((lane>>4)&1)*32+(lane&3)*8+(4*hi+((lane&15)>>2))*64;
  const char*Kbase=shm+LDS_K; bf16x8 kf[8];
  const lds_cptr shm3=(lds_cptr)shm; const lds_cptr kp0=shm3+LDS_K+hi*1024+r32*16; const lds_cptr vp0=shm3+LDS_V+((lane>>4)&1)*32+(lane&3)*8+(4*hi+((lane&15)>>2))*64;
  const int NT=T1-T0;
  {
    float*bl=(float*)(shm+LDS_BIAS);
    _Pragma("clang loop unroll(disable) vectorize(disable)") for(int j=tid*4;j<NT*KVBLK;j+=NW*64*4){ const int ja=T0*KVBLK+j; const float4 c4=*reinterpret_cast<const float4*>(cum+ja);
      float oj=0.f; { const int sj=ja>>10; _Pragma("unroll") for(int s_=0;s_<8;++s_) if(s_==sj)oj=off[s_]; } const float cr=cref-oj;
      float4 o4; o4.x=(cr-c4.x)*1.4426950408889634f;o4.y=(cr-c4.y)*1.4426950408889634f;o4.z=(cr-c4.z)*1.4426950408889634f;o4.w=(cr-c4.w)*1.4426950408889634f; *reinterpret_cast<float4*>(bl+j)=o4; }
    asm volatile("s_waitcnt vmcnt(0) lgkmcnt(0)":::"memory"); }
  const lds_cptr bp0=(lds_cptr)shm+LDS_BIAS+hi*16;
  #define LDBIAS(P0,P1,t) do{ if(NB){ _Pragma("unroll") for(int r_=0;r_<16;++r_){P0[r_]=0.f;P1[r_]=0.f;} break; } const lds_cptr bp_=bp0+(t)*256; _Pragma("unroll") for(int g_=0;g_<4;++g_){ const f32x4v a_=*(const __attribute__((address_space(3))) f32x4v*)(bp_+32*g_); const f32x4v c_=*(const __attribute__((address_space(3))) f32x4v*)(bp_+128+32*g_); \
      P0[4*g_]=a_[0];P0[4*g_+1]=a_[1];P0[4*g_+2]=a_[2];P0[4*g_+3]=a_[3]; P1[4*g_]=c_[0];P1[4*g_+1]=c_[1];P1[4*g_+2]=c_[2];P1[4*g_+3]=c_[3]; } }while(0)
  DMA_K(0,0);DMA_V(0,0);DMA_K(1,SLOTB);
  bf16x8 qr[4];
  #pragma unroll
  for(int d0=0;d0<4;++d0)qr[d0]=*reinterpret_cast<const bf16x8*>(&Qw[(long)r32*DM+d0*16+hi*8]);
  float mhat=0.f,l_reg=0.f;f32x16 o[2];o[0]=f32x16{};o[1]=f32x16{};
  const int qrel=wid*QBLK+r32;
  #define CMASK(P0,P1,t) do{int jb_=(t)-(NT-4); if(mband&&jb_>=0)cmask(P0,P1,jb_,qrel,hi);}while(0)
  bool resc=false;
  #define START(P0,P1) do{ const float rm=rowmax(P0,P1); resc=false; \
    { const float dl=rm; mhat=fadd_s(mhat,dl); \
      _Pragma("unroll") for(int r=0;r<16;++r){P0[r]=fsub_s(P0[r],dl);P1[r]=fsub_s(P1[r],dl);} } \
    _Pragma("unroll") for(int r=0;r<16;++r)P0[r]=__builtin_amdgcn_exp2f(P0[r]); }while(0)
  #define RESC() do{ if(resc){ asm volatile("s_waitcnt lgkmcnt(0)":::"memory"); \
      _Pragma("unroll") for(int d_=0;d_<2;++d_) _Pragma("unroll") for(int r=0;r<16;++r)o[d_][r]*=wsf[crow(r,hi)]; } }while(0)
  f32x16 pA0,pA1,pB0,pB1;
  int sl_prev=0,sl_cur=0,sl_next=SLOTB;
  #define ROT() do{sl_prev=sl_cur;sl_cur=sl_next;sl_next=(sl_next==(NSLOT-1)*SLOTB)?0:sl_next+SLOTB;}while(0)
  DMA_K(2,2*SLOTB);
  WAIT_BAR(3);
  LDBIAS(pA0,pA1,0); qkt(pA0,pA1,Kbase,qr,r32,hi);asm volatile("s_nop 15\n\ts_nop 7":"+v"(pA0),"+v"(pA1));CMASK(pA0,pA1,0);
  START(pA0,pA1);
  _Pragma("unroll") for(int r=0;r<16;++r)pA1[r]=__builtin_amdgcn_exp2f(pA1[r]);
  LDBIAS(pB0,pB1,1); _Pragma("unroll") for(int r=0;r<16;++r){pB0[r]-=mhat;pB1[r]-=mhat;}
  WAIT_BAR(0);
  DMA_K(3,0);DMA_V(1,SLOTB);
  ROT();
  kload8(kf,kp0+sl_cur);
  WAIT_BAR(2);
  s16x4 vlo[8],vhi[8]; u32x4 pw0,pw1,pw2,pw3;
  #define PKW(P,B) cvtpk_s(P[B],P[B+1])
  #define PAF(k) __builtin_bit_cast(bf16x8,pw##k)
  #define VFR(i) (bf16x8){vlo[i][0],vlo[i][1],vlo[i][2],vlo[i][3],vhi[i][0],vhi[i][1],vhi[i][2],vhi[i][3]}
  #define PIN(x) asm volatile("":"+v"(x))
  #define MX3(a,b,c) __builtin_fmaxf(__builtin_fmaxf((a),(b)),(c))
  #define GAPA(MF,A0,A1,A2,A3,W0,W1,PW) do{ MF; sacc+=A0; sacc+=A1; sacc+=A2; sacc+=A3; PIN(sacc); W0; W1; PIN(PW); SBAR(); }while(0)
  #define EX(v) __builtin_amdgcn_exp2f(v)
  #define GAPB(MF,X,B) do{ MF; X[B]=EX(X[B]); X[B+1]=EX(X[B+1]); X[B+2]=EX(X[B+2]); X[B+3]=EX(X[B+3]); PIN(X); SBAR(); }while(0)
  #define VRD(i) do{ vlo[i]=vtr(vp_+(((i)>>2)*4096+((i)&3)*1024)); vhi[i]=vtr(vp_+(((i)>>2)*4096+((i)&3)*1024+512)); }while(0)
  #define KRD(G,j) do{ if(G){ kload2(kf,kp0+sl_next,j); SBAR(); } }while(0)
  #define STEP(C0,C1,P0,P1,t,GK,GV,GL) do{ SBAR(); \
    const lds_cptr vp_=vp0+sl_prev; \
    VRD(0); SBAR(); float sacc=(P0[0]+P0[1]); \
    GAPA(C0=__builtin_amdgcn_mfma_f32_32x32x16_bf16(kf[0],qr[0],C0,0,0,0), P0[2],P0[3],P0[4],P0[5],     pw0[0]=PKW(P0,0), pw0[1]=PKW(P0,2), pw0); \
    VRD(4); SBAR(); GAPA(C1=__builtin_amdgcn_mfma_f32_32x32x16_bf16(kf[1],qr[0],C1,0,0,0), P0[6],P0[7],P0[8],P0[9],     pw0[2]=PKW(P0,4), pw0[3]=PKW(P0,6), pw0); \
    VRD(1); SBAR(); GAPA(C0=__builtin_amdgcn_mfma_f32_32x32x16_bf16(kf[2],qr[1],C0,0,0,0),   P0[10],P0[11],P0[12],P0[13], pw1[0]=PKW(P0,8), pw1[1]=PKW(P0,10), pw1); \
    VRD(5); SBAR(); GAPA(C1=__builtin_amdgcn_mfma_f32_32x32x16_bf16(kf[3],qr[1],C1,0,0,0),   P0[14],P0[15],P1[0],P1[1],   pw1[2]=PKW(P0,12),pw1[3]=PKW(P0,14), pw1); \
    VRD(2); SBAR(); GAPA(C0=__builtin_amdgcn_mfma_f32_32x32x16_bf16(kf[4],qr[2],C0,0,0,0),   P1[2],P1[3],P1[4],P1[5],     pw2[0]=PKW(P1,0), pw2[1]=PKW(P1,2), pw2); \
    VRD(6); SBAR(); GAPA(C1=__builtin_amdgcn_mfma_f32_32x32x16_bf16(kf[5],qr[2],C1,0,0,0),   P1[6],P1[7],P1[8],P1[9],     pw2[2]=PKW(P1,4), pw2[3]=PKW(P1,6), pw2); \
    VRD(3); SBAR(); GAPA(C0=__builtin_amdgcn_mfma_f32_32x32x16_bf16(kf[6],qr[3],C0,0,0,0),   P1[10],P1[11],P1[12],P1[13], pw3[0]=PKW(P1,8), pw3[1]=PKW(P1,10), pw3); \
    VRD(7); SBAR(); GAPA(C1=__builtin_amdgcn_mfma_f32_32x32x16_bf16(kf[7],qr[3],C1,0,0,0),   P1[14],P1[15],0.f,0.f,       pw3[2]=PKW(P1,12),pw3[3]=PKW(P1,14), pw3); \
    l_reg+=sacc; \
    if(GK){DMA_K((t)+3,sl_cur);} if(GV){DMA_V((t)+1,sl_next);} \
    CMASK(C0,C1,t); \
    { float a=MX3(C0[0],C0[1],C1[0]),b=MX3(C0[2],C0[3],C1[1]); a=MX3(a,C1[2],C1[3]); \
      _Pragma("unroll") for(int r=4;r<16;r+=4){a=MX3(a,C0[r],C0[r+1]);b=MX3(b,C0[r+2],C0[r+3]);a=MX3(a,C1[r],C1[r+1]);b=MX3(b,C1[r+2],C1[r+3]);} \
      float rm=__builtin_fmaxf(a,b); { auto rr=__builtin_amdgcn_permlane32_swap(__float_as_uint(rm),__float_as_uint(rm),false,false); rm=__builtin_fmaxf(__uint_as_float(rr[0]),__uint_as_float(rr[1])); } \
      resc=false; \
      if(__builtin_expect(__any(rm>(float)THRL),0)){ const float dl=__builtin_fmaxf(rm,0.f); mhat+=dl; \
        _Pragma("unroll") for(int r=0;r<16;++r){C0[r]-=dl;C1[r]-=dl;} \
        const float f=__builtin_amdgcn_exp2f(-dl); l_reg*=f; if(hi==0)wsf[r32]=f; resc=true; } } \
    SBAR(); \
    if(GL){ LDBIAS(P0,P1,(t)+1); SBAR(); } \
    GAPB(o[0]=__builtin_amdgcn_mfma_f32_32x32x16_bf16(PAF(0),VFR(0),o[0],0,0,0), C0,0); \
    GAPB(o[1]=__builtin_amdgcn_mfma_f32_32x32x16_bf16(PAF(0),VFR(4),o[1],0,0,0), C0,4); \
    KRD(GL,0); GAPB(o[0]=__builtin_amdgcn_mfma_f32_32x32x16_bf16(PAF(1),VFR(1),o[0],0,0,0), C0,8); \
    KRD(GL,1); GAPB(o[1]=__builtin_amdgcn_mfma_f32_32x32x16_bf16(PAF(1),VFR(5),o[1],0,0,0), C0,12); \
    KRD(GL,2); GAPB(o[0]=__builtin_amdgcn_mfma_f32_32x32x16_bf16(PAF(2),VFR(2),o[0],0,0,0), C1,0); \
    KRD(GL,3); GAPB(o[1]=__builtin_amdgcn_mfma_f32_32x32x16_bf16(PAF(2),VFR(6),o[1],0,0,0), C1,4); \
    GAPB(o[0]=__builtin_amdgcn_mfma_f32_32x32x16_bf16(PAF(3),VFR(3),o[0],0,0,0), C1,8); \
    GAPB(o[1]=__builtin_amdgcn_mfma_f32_32x32x16_bf16(PAF(3),VFR(7),o[1],0,0,0), C1,12); \
    if(GL&&NB!=2){ _Pragma("unroll") for(int r=0;r<16;++r){P0[r]-=mhat;P1[r]-=mhat;} PIN(P0); PIN(P1); SBAR(); } \
    }while(0)
  int t=1;
  #undef CMASK
  #define CMASK(P0,P1,t) do{}while(0)
  for(;t+5<NT;t+=2){
    STEP(pB0,pB1,pA0,pA1,t,true,true,true);     WAIT_BAR(2); RESC(); ROT();
    STEP(pA0,pA1,pB0,pB1,t+1,true,true,true);   WAIT_BAR(2); RESC(); ROT();
  }
  #undef CMASK
  #define CMASK(P0,P1,t) do{int jb_=(t)-(NT-4); if(mband&&jb_>=0)cmask(P0,P1,jb_,qrel,hi);}while(0)
  #define ENDW(tt) do{ if((tt)+3<NT){WAIT_BAR(2);} else if((tt)+2<NT){WAIT_BAR(1);} else {WAIT_BAR(0);} }while(0)
  for(;t+1<NT;t+=2){
    STEP(pB0,pB1,pA0,pA1,t,(t+3<NT),(t+1<NT),(t+1<NT));       ENDW(t);   RESC(); ROT();
    STEP(pA0,pA1,pB0,pB1,t+1,(t+4<NT),(t+2<NT),(t+2<NT));     ENDW(t+1); RESC(); ROT();
  }
  STEP(pB0,pB1,pA0,pA1,NT-1,false,false,false); RESC();
  { float sacc=pB0[0]+pB0[1]; _Pragma("unroll") for(int r=2;r<16;++r)sacc+=pB0[r]; _Pragma("unroll") for(int r=0;r<16;++r)sacc+=pB1[r]; l_reg+=sacc;
    pw0=(u32x4){PKW(pB0,0),PKW(pB0,2),PKW(pB0,4),PKW(pB0,6)};pw1=(u32x4){PKW(pB0,8),PKW(pB0,10),PKW(pB0,12),PKW(pB0,14)};pw2=(u32x4){PKW(pB1,0),PKW(pB1,2),PKW(pB1,4),PKW(pB1,6)};pw3=(u32x4){PKW(pB1,8),PKW(pB1,10),PKW(pB1,12),PKW(pB1,14)};
    SBAR(); pv(o,vb0+sl_cur,PAF(0),PAF(1),PAF(2),PAF(3)); }
  #undef PKW
  #undef PAF
  #undef VFR
  #undef PIN
  #undef MX3
  #undef GAPA
  #undef GAPB
  #undef EX
  #undef VRD
  #undef KRD
  #undef STEP
  #undef ENDW
  {auto rr=__builtin_amdgcn_permlane32_swap(__float_as_uint(l_reg),__float_as_uint(l_reg),false,false);l_reg=__uint_as_float(rr[0])+__uint_as_float(rr[1]);}
  if(hi==0){ wsf[32+r32]=l_reg; const long lrow=(rowbase+q0+wid*QBLK+r32)*4+h; lse_out[lrow]=mhat+__log2f(l_reg); if(lse_neg)lse_neg[lrow]=-INFINITY; } asm volatile("s_waitcnt lgkmcnt(0)":::"memory");
  float rli[16];
  #pragma unroll
  for(int r=0;r<16;++r)rli[r]=__builtin_amdgcn_rcpf(wsf[32+crow(r,hi)]);
  bf16*Ow=O+(rowbase+q0+wid*QBLK)*OP+h*D;
  { bf16*stg=(bf16*)(shm+LDS_OST)+wid*2048;
    #pragma unroll
    for(int r=0;r<16;++r){const int orow=crow(r,hi);
      #pragma unroll
      for(int d0=0;d0<2;++d0)stg[orow*64+d0*32+r32]=__float2bfloat16(o[d0][r]*rli[r]);}
    asm volatile("s_waitcnt lgkmcnt(0)":::"memory");
    #pragma unroll
    for(int i=0;i<4;++i){const int row=i*8+(lane>>3),ch=lane&7; const u32x4 v=*(const u32x4*)(stg+row*64+ch*8); ATTN_STORE16(Ow+(long)row*OP+ch*8,v);} }
  asm volatile("s_waitcnt lgkmcnt(0)\n\ts_barrier":::"memory");
  #undef DMA_K
  #undef DMA_V
  #undef CMASK
  #undef START
  #undef RESC
  #undef ROT
  #undef LDBIAS
}
constexpr int ATTN_LDS_BYTES=LDS_BYTES;
struct AttnTensors { const bf16* Q; const bf16* K; const bf16* V; bf16* O0; bf16* O1; float* L0; float* L1; const float* cum; const float* segt; };
constexpr int N_ITEMS=28*16+32;
template<int THRL=8,int NB=0> __device__ __forceinline__ void attn_phase_queue(char*lds,const AttnTensors&T,float skipthr,unsigned*ctr,volatile __attribute__((address_space(3))) unsigned*slot,int tid){
  unsigned nxt=0u; if(tid==0)nxt=__hip_atomic_fetch_add(ctr,1u,__ATOMIC_RELAXED,__HIP_MEMORY_SCOPE_AGENT);
  for(;;){
    if(tid==0)slot[0]=nxt;
    __syncthreads();
    const int idx=(int)__builtin_amdgcn_readfirstlane(slot[0]);
    __syncthreads();
    if(idx>=N_ITEMS)break;
    if(tid==0)nxt=__hip_atomic_fetch_add(ctr,1u,__ATOMIC_RELAXED,__HIP_MEMORY_SCOPE_AGENT);
    int qb,bh,part;
    if(idx<448){ qb=31-(idx>>4); bh=(idx&15)>>1; part=idx&1; } else { const int r=idx-448; qb=3-(r>>3); bh=r&7; part=2; }
    const int T0=(part==1)?2*qb+2:0, T1=(part==0)?2*qb+2:4*qb+4;
    attn_unit<THRL,NB>(bh/NHEAD,bh%NHEAD,qb,T0,T1,part!=0,skipthr,T.Q,T.K,T.V,part==0?T.O0:T.O1,part==0?T.L0:T.L1,part==2?T.L0:nullptr,T.cum+(long)bh*SEQ,T.segt+bh*8,lds,tid);
  }
}
#undef SBAR
#undef WAIT_BAR
}
struct Args { const float* in[24]; float* out; unsigned char* ws; int ph_lo, ph_hi; };
typedef const __attribute__((address_space(4))) Args* CArgs;
__device__ __forceinline__ CArgs get_args() { CArgs p = (CArgs)__builtin_amdgcn_kernarg_segment_ptr(); asm volatile("" : "+s"(p)); return p; }
struct Frame {
    LAS unsigned char* lds;
    volatile LAS unsigned* MISC;
    gu32* ctl;
    int tid, lane, wave;
    int vcu, G, bx;
};
__device__ __forceinline__ float bf2f(unsigned short b) { return __builtin_bit_cast(float, (unsigned)b << 16); }
__device__ __forceinline__ float bflo(unsigned w) { return __builtin_bit_cast(float, w << 16); }
__device__ __forceinline__ float bfhi(unsigned w) { return __builtin_bit_cast(float, w & 0xffff0000u); }
template <int CTRL> __device__ __forceinline__ float dppf(float x) { return __builtin_bit_cast(float, __builtin_amdgcn_mov_dpp(__builtin_bit_cast(int, x), CTRL, 0xf, 0xf, true)); }
__device__ __forceinline__ float row_sum16(float x) { x += dppf<0xB1>(x); x += dppf<0x4E>(x); x += dppf<0x141>(x); x += dppf<0x128>(x); return x; }
__device__ __forceinline__ float half_sum(float x) { auto rr = __builtin_amdgcn_permlane32_swap(__float_as_uint(x), __float_as_uint(x), false, false); return __uint_as_float(rr[0]) + __uint_as_float(rr[1]); }
__device__ __forceinline__ float pair16_sum(float x) { auto rr = __builtin_amdgcn_permlane16_swap(__float_as_uint(x), __float_as_uint(x), false, false); return __uint_as_float(rr[0]) + __uint_as_float(rr[1]); }
__device__ __forceinline__ float wave_sum_fast(float x) { return half_sum(pair16_sum(row_sum16(x))); }
__device__ __forceinline__ float wave_sum(float v) { return wave_sum_fast(v); }
__device__ __forceinline__ float sigm(float x) { return __builtin_amdgcn_rcpf(1.0f + __expf(-x)); }

template <class SRC>
__device__ __forceinline__ void conv_item(const float* W, int ldw, int K, bf16* WT, int dst0, int k0, const float* gain, LAS float* scr, int lane, SRC src) {
    const int cg = lane & 7, r8 = lane >> 3; const int sc = src(dst0 + 4 * cg); const int scc = sc < 0 ? 0 : sc;
#pragma unroll
    for (int i = 0; i < 8; ++i) { const int kk = 8 * i + r8;
        f32x4 v = *(const f32x4*)(W + (size_t)(k0 + kk) * ldw + scc); const float g = gain ? gain[k0 + kk] : 1.0f;
        if (sc < 0) v = (f32x4){0.f, 0.f, 0.f, 0.f};
        LAS float* d = scr + kk * 33 + 4 * cg; d[0] = v[0] * g; d[1] = v[1] * g; d[2] = v[2] * g; d[3] = v[3] * g; }
    LDS_WAIT(); asm volatile("" ::: "memory");
    const int c = lane & 7;
#pragma unroll
    for (int j = 0; j < 4; ++j) { const int n = (lane >> 3) + 8 * j; const LAS float* s = scr + (8 * c) * 33 + n;
        v4u o; o.x = pk2(s[0 * 33], s[1 * 33]); o.y = pk2(s[2 * 33], s[3 * 33]); o.z = pk2(s[4 * 33], s[5 * 33]); o.w = pk2(s[6 * 33], s[7 * 33]);
        *(GAS v4u*)(WT + (size_t)(dst0 + n) * K + k0 + 8 * c) = o; }
    LDS_WAIT(); asm volatile("" ::: "memory");
}
__device__ __forceinline__ void phase_weights(Frame& F, CArgs A, int l) {
    LAS float* scr = (LAS float*)(F.lds + RING_OFF + F.wave * 16384);
    const int gw = F.vcu * NWAVES + F.wave, NGW = F.G * NWAVES;
    const float* w_in = A->in[2] + (size_t)l * D * IN_COLS; const float* mixg = A->in[1] + (size_t)l * D;
    const float* p_ret = A->in[17] + (size_t)l * 256 * D; const float* p_fox = A->in[18] + (size_t)l * 256 * D; const float* p_rw = A->in[19] + (size_t)l * 256 * D;
    const float* w_out = A->in[20] + (size_t)l * D * D; const float* ffng = A->in[21] + (size_t)l * D;
    const float* w_gu = A->in[22] + (size_t)l * D * NGU; const float* w_down = A->in[23] + (size_t)l * DFF * D;
    bf16* Win_t = (bf16*)(A->ws + WS_WIN); bf16* Wgate_t = (bf16*)(A->ws + WS_WGATE); bf16* Pbr_t = (bf16*)(A->ws + WS_PBR);
    bf16* Wout_t = (bf16*)(A->ws + WS_WOUT); bf16* Wgu_t = (bf16*)(A->ws + WS_WGU); bf16* Wdown_t = (bf16*)(A->ws + WS_WDOWN);
    constexpr int I_IN = (NMIX / 32) * (D / 64), I_G = (NGATE / 32) * (D / 64), I_P = (D / 32) * (256 / 64), I_O = (D / 32) * (D / 64), I_GU = (NGU / 32) * (D / 64), I_DN = (D / 32) * (DFF / 64);
    constexpr int I_G2 = (256 / 32) * (128 / 64);
    constexpr int NITEMS = I_IN + I_G + 3 * I_P + I_O + I_GU + I_DN + I_G2;
    for (int it = gw; it < NITEMS; it += NGW) {
        int r = it;
        if (r < I_IN) { const int nb = r % (NMIX / 32), kb = r / (NMIX / 32);
            conv_item(w_in, IN_COLS, D, Win_t, nb * 32, kb * 64, mixg, scr, F.lane, [](int d) { return d < 1792 ? d : (d < 2816 ? d + 4 : (d < 2820 ? d - 1024 : -1)); }); continue; } r -= I_IN;
        if (r < I_G) { const int nb = r % (NGATE / 32), kb = r / (NGATE / 32);
            conv_item(w_in, IN_COLS, D, Wgate_t, nb * 32, kb * 64, mixg, scr, F.lane, [](int d) { return d + 2820; }); continue; } r -= I_G;
        if (r < 3 * I_P) { const int b = r / I_P, q = r % I_P, nb = q % (D / 32), kb = q / (D / 32); const float* src = b == 0 ? p_ret : (b == 1 ? p_fox : p_rw);
            conv_item(src, D, 256, Pbr_t + (size_t)b * D * 256, nb * 32, kb * 64, nullptr, scr, F.lane, [](int d) { return d; }); continue; } r -= 3 * I_P;
        if (r < I_O) { const int nb = r % (D / 32), kb = r / (D / 32);
            conv_item(w_out, D, D, Wout_t, nb * 32, kb * 64, nullptr, scr, F.lane, [](int d) { return d; }); continue; } r -= I_O;
        if (r < I_GU) { const int nb = r % (NGU / 32), kb = r / (NGU / 32);
            conv_item(w_gu, NGU, D, Wgu_t, nb * 32, kb * 64, ffng, scr, F.lane, [](int d) { const int t = d >> 8, w = d & 255; return w < 128 ? 128 * t + w : DFF + 128 * t + (w - 128); }); continue; } r -= I_GU;
        if (r < I_DN) { const int nb = r % (D / 32), kb = r / (D / 32);
            conv_item(w_down, D, DFF, Wdown_t, nb * 32, kb * 64, nullptr, scr, F.lane, [](int d) { return d; }); continue; } r -= I_DN;
        { const int nb = r % 8, kb = r / 8;
            conv_item(A->in[12] + (size_t)l * 128 * 256, 256, 128, (bf16*)(A->ws + WS_G2T), nb * 32, kb * 64, nullptr, scr, F.lane, [](int d) { return d; }); }
    }
}
__device__ __forceinline__ void phase_prologue(Frame& F, CArgs A) {
    const int gw = F.vcu * NWAVES + F.wave, NGW = F.G * NWAVES;
    const float* x = A->in[0]; bf16* XB = (bf16*)(A->ws + WS_XB); float* SS1 = (float*)(A->ws + WS_SS1);
    for (int m = gw; m < M; m += NGW) {
        const GAS f32x4* xr = (const GAS f32x4*)(x + (size_t)m * D) + F.lane; GAS f32x4* orow = (GAS f32x4*)(A->out + (size_t)m * D) + F.lane;
        GAS unsigned long long* o8 = (GAS unsigned long long*)(XB + (size_t)m * D) + F.lane; float s = 0.f;
#pragma unroll
        for (int j = 0; j < 4; ++j) { const f32x4 v = xr[64 * j]; s += (v.x * v.x + v.y * v.y) + (v.z * v.z + v.w * v.w);
            o8[64 * j] = (unsigned long long)pk2(v.x, v.y) | ((unsigned long long)pk2(v.z, v.w) << 32); }
        s = wave_sum(s);
        if (F.lane < 4) SS1[(size_t)m * 4 + F.lane] = F.lane == 0 ? s : 0.f;
    }
    float* rope = (float*)(A->ws + WS_ROPE);
    for (int e = (F.vcu * NWAVES + F.wave) * 64 + F.lane; e < SEQ * 32; e += NGW * 64) { const int t = e >> 5, i = e & 31;
        const float inv = exp2f(-(float)i * (13.287712379549449f / 32.0f)); const float ang = (float)t * inv;
        double rev = (double)ang * 0.15915494309189535; rev -= rint(rev); const float rv = (float)rev;
        rope[2 * e] = __builtin_amdgcn_cosf(rv); rope[2 * e + 1] = __builtin_amdgcn_sinf(rv); }
}
__device__ __forceinline__ void unpack8(const v4u w, float* f) { f[0] = bflo(w.x); f[1] = bfhi(w.x); f[2] = bflo(w.y); f[3] = bfhi(w.y); f[4] = bflo(w.z); f[5] = bfhi(w.z); f[6] = bflo(w.w); f[7] = bfhi(w.w); }
__device__ __forceinline__ float log_sigmoid(float z) { return fminf(z, 0.f) - __logf(1.0f + __expf(-fabsf(z))); }
__device__ __forceinline__ void phase_cumsum(Frame& F, CArgs A, int l) {
    LAS float* part = (LAS float*)(F.lds);
#pragma unroll 1
    for (int item = F.vcu; item < 64; item += F.G) {
        const int bh = item >> 3, seg = item & 7, b = bh >> 2, h = bh & 3; const float bias = A->in[6][l * 4 + h];
        const int t0 = seg * 1024 + F.tid * 2;
        const float* fl = (const float*)(A->ws + WS_FLOG) + ((size_t)b * SEQ + t0) * 4 + h; float* cum = (float*)(A->ws + WS_CUM) + (size_t)bh * SEQ + t0;
        const float lf0 = log_sigmoid(fl[0] + bias), lf1 = log_sigmoid(fl[4] + bias); const float s = lf0 + lf1;
        float incl = s;
#pragma unroll
        for (int o = 1; o < 64; o <<= 1) { const float t = __shfl_up(incl, o); if (F.lane >= o) incl += t; }
        __syncthreads();
        if (F.lane == 63) part[F.wave] = incl;
        __syncthreads();
        float run = incl - s;
        for (int w = 0; w < F.wave; ++w) run += part[w];
        cum[0] = run + lf0; cum[1] = run + s;
        if (F.tid == NWAVES * 64 - 1) ((float*)(A->ws + WS_SEGT))[bh * 8 + seg] = run + s;
    }
}
__device__ __forceinline__ float fox_skip_threshold(Frame& F, CArgs A, int l) {
    float gq = fabsf(A->in[4][l * 64 + F.lane]), gk = fabsf(A->in[5][l * 64 + F.lane]);
#pragma unroll
    for (int o = 1; o < 64; o <<= 1) { gq = fmaxf(gq, __shfl_xor(gq, o)); gk = fmaxf(gk, __shfl_xor(gk, o)); }
    const float bound = 0.125f * 1.4426950408889634f * 64.0f * gq * gk * 1.03f;
    return 160.0f + 2.0f * bound;
}
__device__ __forceinline__ void phase_fox_prep(Frame& F, CArgs A, int l) {
    const int gw = F.vcu * NWAVES + F.wave, NGW = F.G * NWAVES, lane = F.lane;
    bf16* MIXIN = (bf16*)(A->ws + WS_BIG); const float* gain = (lane < 32 ? A->in[4] : A->in[5]) + l * 64 + (lane & 7) * 8;
    const float sc = lane < 32 ? 0.125f * 1.4426950408889634f : 1.0f;
    float gv[8];
#pragma unroll
    for (int e = 0; e < 8; ++e) gv[e] = gain[e] * sc;
    for (int m = gw; m < M; m += NGW) {
        v4u* p = (v4u*)(MIXIN + (size_t)m * MIXLD + C_FOXQ + 8 * lane); const v4u w = *p;
        float f[8] = {bflo(w.x), bfhi(w.x), bflo(w.y), bfhi(w.y), bflo(w.z), bfhi(w.z), bflo(w.w), bfhi(w.w)};
        float ss = 0.f;
#pragma unroll
        for (int e = 0; e < 8; ++e) ss += f[e] * f[e];
        ss += dppf<0xB1>(ss); ss += dppf<0x4E>(ss); ss += dppf<0x141>(ss);
        const float rs = __builtin_amdgcn_rsqf(ss * (1.f / 64.f) + 1e-6f);
        v4u o; o.x = pk2(f[0] * rs * gv[0], f[1] * rs * gv[1]); o.y = pk2(f[2] * rs * gv[2], f[3] * rs * gv[3]); o.z = pk2(f[4] * rs * gv[4], f[5] * rs * gv[5]); o.w = pk2(f[6] * rs * gv[6], f[7] * rs * gv[7]);
        *p = o;
    }
}
constexpr int STG_OFF = 132096;
__device__ __forceinline__ float lerp_col(const bf16* MIXIN, int m, int t, int col, float mu) {
    const float cur = bf2f(MIXIN[(size_t)m * MIXLD + C_RW + col]); const float prev = t > 0 ? bf2f(MIXIN[(size_t)(m - 1) * MIXLD + C_RW + col]) : 0.f;
    return cur + (prev - cur) * mu;
}
typedef short pbf16x8 __attribute__((ext_vector_type(8)));
__device__ __forceinline__ void phase_rwkv_prep(Frame& F, CArgs A, int l) {
    const float* w2 = A->in[9] + (size_t)l * 64 * 256; const float* a2 = A->in[11] + (size_t)l * 64 * 256;
    const float* mu = A->in[7] + (size_t)l * 1024; const float* w0 = A->in[8] + l * 256; const float* a0 = A->in[10] + l * 256;
    const bf16* MIXIN = (const bf16*)(A->ws + WS_BIG); float* SW = (float*)(A->ws + WS_SW); float* SA = (float*)(A->ws + WS_SA);
    const int lane = F.lane, fr = lane & 15, fq = lane >> 4, w = F.wave;
    pbf16x8 bh_[2][2][2], bl_[2][2][2];
#pragma unroll
    for (int mt = 0; mt < 2; ++mt)
#pragma unroll
        for (int nt = 0; nt < 2; ++nt)
#pragma unroll
            for (int ks = 0; ks < 2; ++ks) { const float* W = (mt ? a2 : w2) + (size_t)(32 * ks + 8 * fq) * 256 + 32 * w + 16 * nt + fr; unsigned hw[4], lw[4];
#pragma unroll
                for (int j = 0; j < 4; ++j) { const float x0 = W[(2 * j) * 256], x1 = W[(2 * j + 1) * 256]; const unsigned h0 = f2bf(x0), h1 = f2bf(x1);
                    hw[j] = h0 | (h1 << 16); lw[j] = pk2(x0 - bf2f((unsigned short)h0), x1 - bf2f((unsigned short)h1)); }
                bh_[mt][nt][ks] = __builtin_bit_cast(pbf16x8, (v4u){hw[0], hw[1], hw[2], hw[3]}); bl_[mt][nt][ks] = __builtin_bit_cast(pbf16x8, (v4u){lw[0], lw[1], lw[2], lw[3]}); }
#pragma unroll 1
    for (int item = F.vcu; item < M / 64; item += F.G) {
        const size_t mb = (size_t)item * 64;
        __syncthreads();
        { const int tok = F.tid >> 3, c = F.tid & 7; const size_t m = mb + tok; const int t = (int)(m & (SEQ - 1));
          const v4u* cp = (const v4u*)(MIXIN + m * MIXLD + C_RW + 768 + 16 * c); const v4u* pp = (const v4u*)(MIXIN + (m > 0 ? m - 1 : 0) * MIXLD + C_RW + 768 + 16 * c);
          float cur[16], prv[16]; unpack8(cp[0], cur); unpack8(cp[1], cur + 8);
          unpack8(pp[0], prv); unpack8(pp[1], prv + 8);
          if (t == 0) {
#pragma unroll
              for (int e = 0; e < 16; ++e) prv[e] = 0.f; }
          const float* mup = mu + 768 + 16 * c; unsigned hw[8], lw[8];
#pragma unroll
          for (int e = 0; e < 8; ++e) { float x0 = cur[2 * e] + (prv[2 * e] - cur[2 * e]) * mup[2 * e], x1 = cur[2 * e + 1] + (prv[2 * e + 1] - cur[2 * e + 1]) * mup[2 * e + 1];
              if (c < 4) { x0 = 1.0f - 2.0f * __builtin_amdgcn_rcpf(1.0f + __expf(2.0f * x0)); x1 = 1.0f - 2.0f * __builtin_amdgcn_rcpf(1.0f + __expf(2.0f * x1)); }
              const unsigned h0 = f2bf(x0), h1 = f2bf(x1); hw[e] = h0 | (h1 << 16); lw[e] = pk2(x0 - bf2f((unsigned short)h0), x1 - bf2f((unsigned short)h1)); }
          LAS unsigned char* xh = F.lds + (((c >> 2) * 2 + 0) * 64 + tok) * 144 + 32 * (c & 3); LAS unsigned char* xl = F.lds + (((c >> 2) * 2 + 1) * 64 + tok) * 144 + 32 * (c & 3);
          *(LAS v4u*)xh = (v4u){hw[0], hw[1], hw[2], hw[3]}; *(LAS v4u*)(xh + 16) = (v4u){hw[4], hw[5], hw[6], hw[7]};
          *(LAS v4u*)xl = (v4u){lw[0], lw[1], lw[2], lw[3]}; *(LAS v4u*)(xl + 16) = (v4u){lw[4], lw[5], lw[6], lw[7]}; }
        __syncthreads();
#pragma unroll
        for (int mt = 0; mt < 4; ++mt)
#pragma unroll
            for (int mat = 0; mat < 2; ++mat) { f32x4 acc[2] = {(f32x4){0.f, 0.f, 0.f, 0.f}, (f32x4){0.f, 0.f, 0.f, 0.f}};
#pragma unroll
                for (int ks = 0; ks < 2; ++ks) { const pbf16x8 ah = *(const LAS pbf16x8*)(F.lds + ((mat * 2 + 0) * 64 + 16 * mt + fr) * 144 + (32 * ks + 8 * fq) * 2);
                    const pbf16x8 al = *(const LAS pbf16x8*)(F.lds + ((mat * 2 + 1) * 64 + 16 * mt + fr) * 144 + (32 * ks + 8 * fq) * 2);
#pragma unroll
                    for (int nt = 0; nt < 2; ++nt) { acc[nt] = __builtin_amdgcn_mfma_f32_16x16x32_bf16(ah, bh_[mat][nt][ks], acc[nt], 0, 0, 0);
                        acc[nt] = __builtin_amdgcn_mfma_f32_16x16x32_bf16(ah, bl_[mat][nt][ks], acc[nt], 0, 0, 0); acc[nt] = __builtin_amdgcn_mfma_f32_16x16x32_bf16(al, bh_[mat][nt][ks], acc[nt], 0, 0, 0); } }
#pragma unroll
                for (int nt = 0; nt < 2; ++nt) { const int ch = 32 * w + 16 * nt + fr; const float bias = mat ? a0[ch] : w0[ch];
#pragma unroll
                    for (int r = 0; r < 4; ++r) { const size_t m = mb + 16 * mt + 4 * fq + r; const float z = acc[nt][r] + bias;
                        if (mat == 0) { const float nz = -z; const float sp = fmaxf(nz, 0.f) + __logf(1.0f + __expf(-fabsf(nz))); SW[m * 256 + ch] = __expf(-__expf(-sp - 0.5f)); }
                        else SA[m * 256 + ch] = sigm(z); } } }
    }
}
template <int VAR> __device__ __forceinline__ void phase_rwkv_scan1(Frame& F, CArgs A, int l) {
    const int w2 = F.wave >> 2, p = F.wave & 3, lane = F.lane, kh = lane >> 5, row = 32 * w2 + (lane & 31);
    const bf16* MIXIN = (const bf16*)(A->ws + WS_BIG); const float* SW = (const float*)(A->ws + WS_SW); const float* SA = (const float*)(A->ws + WS_SA);
    float* YL = (float*)(A->ws + WS_YL); bf16* U = (bf16*)(A->ws + WS_U); float* LS = (float*)(A->ws + WS_LS); bf16* TT = (bf16*)(A->ws + WS_TT); float* BS = (float*)(A->ws + WS_BS);
    LAS float* ops_u = (LAS float*)(F.lds) + p * 4096;
    LAS float* gfin = (LAS float*)(F.lds + 65536) + p * 64;
    LAS float* vst = (LAS float*)(F.lds + 66560) + F.wave * 1024;
    const float* mu = A->in[7] + (size_t)l * 1024;
#pragma unroll 1
    for (int wg = F.vcu; wg < 256; wg += F.G) {
        const int bh = wg >> 5, b = bh >> 2, h = bh & 3, chunk = 4 * (wg & 31) + p, t0 = chunk * 64, hk = h * 64 + lane, hr = h * 64 + row;
        const size_t m0 = (size_t)b * SEQ + t0;
        const float mur = mu[hk], muk = mu[256 + hk], muv = mu[512 + hr], kkp = A->in[13][l * 256 + hk], kap = A->in[14][l * 256 + hk], rkp = A->in[15][l * 256 + hk];
        float Sl[32], Si[32];
#pragma unroll
        for (int k = 0; k < 32; ++k) { Sl[k] = 0.f; Si[k] = (32 * kh + k == row) ? 1.f : 0.f; }
        float vprev = 0.f, gam = 1.f;
        { const size_t mp = m0 > 0 ? m0 - 1 : 0; const float v_ = bf2f(MIXIN[mp * MIXLD + C_RW + 512 + hr]); if (t0 > 0) vprev = v_; }
        float kc[4], xr[4], xw[8], aa[4], kp0_, rp0_, vn[8];
#define RW_LOAD(sb_, VD) do { const size_t mf_ = m0 + 8 * (sb_) + 4 * w2; const size_t mp_ = mf_ > 0 ? mf_ - 1 : 0; const bool z_ = (t0 + 8 * (sb_) + 4 * w2) == 0; \
            { const float k_ = bf2f(MIXIN[mp_ * MIXLD + C_RW + 256 + hk]), r_ = bf2f(MIXIN[mp_ * MIXLD + C_RW + hk]); kp0_ = z_ ? 0.f : k_; rp0_ = z_ ? 0.f : r_; } \
            _Pragma("unroll") for (int j = 0; j < 4; ++j) { const size_t m = mf_ + j; \
            kc[j] = bf2f(MIXIN[m * MIXLD + C_RW + 256 + hk]); aa[j] = SA[m * 256 + hk]; xr[j] = bf2f(MIXIN[m * MIXLD + C_RW + hk]); } \
            _Pragma("unroll") for (int j = 0; j < 8; ++j) { xw[j] = SW[(m0 + 8 * (sb_) + j) * 256 + hk]; VD[j] = bf2f(MIXIN[(m0 + 8 * (sb_) + j) * MIXLD + C_RW + 512 + hr]); } } while (0)
#define RW_COMP(sb_) do { LAS float* ob_ = ops_u + ((sb_) & 1) * 2048 + (4 * w2) * 256; float kprev = kp0_, rprev = rp0_; \
            _Pragma("unroll") for (int j = 0; j < 8; ++j) vst[(((sb_) & 1) * 8 + j) * 64 + lane] = vn[j]; \
            _Pragma("unroll") for (int jj = 0; jj < 8; ++jj) { const float gprev = gam; gam = gam * xw[jj]; \
              if ((jj >> 2) == w2) { const int j = jj & 3; const float kl = kc[j] + (kprev - kc[j]) * muk; kprev = kc[j]; const float a = aa[j]; \
                float kk = kl * kkp; const float n2 = wave_sum_fast(kk * kk); kk = kk * __builtin_amdgcn_rsqf(fmaxf(n2, 1e-24f)); \
                const float kp = kl * (1.f + (a - 1.f) * kap); const float r = xr[j] + (rprev - xr[j]) * mur; rprev = xr[j]; const float ginv = __builtin_amdgcn_rcpf(gam); \
                ob_[j * 256 + lane] = kk * gprev; ob_[j * 256 + 64 + lane] = -kk * a * ginv; ob_[j * 256 + 128 + lane] = kp * ginv; ob_[j * 256 + 192 + lane] = r * gam; \
                const float bs = wave_sum_fast(r * kp * rkp); if (lane == 0) BS[(m0 + 8 * (sb_) + jj) * 4 + h] = bs; } } } while (0)
        __syncthreads();
        RW_LOAD(0, vn); RW_COMP(0);
#pragma unroll 1
        for (int sb = 0; sb < 8; ++sb) {
            __syncthreads();
            if (sb < 7 && VAR != 2) RW_LOAD(sb + 1, vn);
            const LAS float* ob = ops_u + (sb & 1) * 2048 + 32 * kh;
#pragma unroll 1
            for (int j = 0; j < (VAR == 1 ? 0 : 8); ++j) { const size_t m = m0 + 8 * sb + j; const LAS f32x4* o4 = (const LAS f32x4*)(ob + j * 256); const float vraw = vst[((sb & 1) * 8 + j) * 64 + lane];
                f32x4 kkc[8];
#pragma unroll
                for (int q = 0; q < 8; ++q) kkc[q] = o4[q];
                f32x4 rg[3][3];
#pragma unroll
                for (int g = 0; g < 3; ++g) { rg[g][0] = o4[16 + g]; rg[g][1] = o4[32 + g]; rg[g][2] = o4[48 + g]; }
                asm volatile("" ::: "memory");
                float sl0 = 0.f, sl1 = 0.f, si0 = 0.f, si1 = 0.f;
#pragma unroll
                for (int q = 0; q < 8; ++q) { const f32x4 kk4 = kkc[q];
                    sl0 = fmaf(Sl[4 * q], kk4[0], sl0); sl1 = fmaf(Sl[4 * q + 1], kk4[1], sl1); sl0 = fmaf(Sl[4 * q + 2], kk4[2], sl0); sl1 = fmaf(Sl[4 * q + 3], kk4[3], sl1);
                    si0 = fmaf(Si[4 * q], kk4[0], si0); si1 = fmaf(Si[4 * q + 1], kk4[1], si1); si0 = fmaf(Si[4 * q + 2], kk4[2], si0); si1 = fmaf(Si[4 * q + 3], kk4[3], si1); }
                const float sal = half_sum(sl0 + sl1), sai = half_sum(si0 + si1);
                const float v = vraw + (vprev - vraw) * muv; vprev = vraw;
                float yl0 = 0.f, yl1 = 0.f, yi0 = 0.f, yi1 = 0.f;
#pragma unroll
                for (int q = 0; q < 8; ++q) {
                    const f32x4 nb4 = rg[q % 3][0], kp4 = rg[q % 3][1], r4 = rg[q % 3][2];
#pragma unroll
                    for (int e = 0; e < 4; ++e) { const int k = 4 * q + e;
                        Sl[k] = fmaf(sal, nb4[e], fmaf(v, kp4[e], Sl[k])); Si[k] = fmaf(sai, nb4[e], Si[k]);
                        if (e & 1) { yl1 = fmaf(Sl[k], r4[e], yl1); yi1 = fmaf(Si[k], r4[e], yi1); } else { yl0 = fmaf(Sl[k], r4[e], yl0); yi0 = fmaf(Si[k], r4[e], yi0); } }
                    if (q < 5) { rg[q % 3][0] = o4[16 + q + 3]; rg[q % 3][1] = o4[32 + q + 3]; rg[q % 3][2] = o4[48 + q + 3]; }
                    asm volatile("" ::: "memory"); }
                const float yl = half_sum(yl0 + yl1), yi = half_sum(yi0 + yi1);
                if (kh == 0) { YL[m * 256 + hr] = yl; U[m * 256 + hr] = (bf16)f2bf(yi); }
                }
            if (sb < 7 && VAR != 2) { RW_COMP(sb + 1); }
            if (sb == 6 && w2 == 0) gfin[lane] = gam;
        }
#undef RW_LOAD
#undef RW_COMP
        { f32x4 gf[8];
#pragma unroll
          for (int q = 0; q < 8; ++q) gf[q] = ((const LAS f32x4*)(gfin + 32 * kh))[q];
          f32x4* lp = (f32x4*)(LS + (((size_t)bh * 128 + chunk) * 64 + row) * 64 + 32 * kh);
#pragma unroll
          for (int q = 0; q < 8; ++q) lp[q] = (f32x4){Sl[4 * q] * gf[q][0], Sl[4 * q + 1] * gf[q][1], Sl[4 * q + 2] * gf[q][2], Sl[4 * q + 3] * gf[q][3]};
          bf16* tp = TT + ((size_t)bh * 128 + chunk) * 4096 + (size_t)(32 * kh) * 64 + row;
#pragma unroll
          for (int k = 0; k < 32; ++k) tp[k * 64] = (bf16)f2bf(Si[k] * gf[k >> 2][k & 3]); }
    }
}
typedef __bf16 bf16x2_t __attribute__((ext_vector_type(2)));
__device__ __forceinline__ float dot2bf(unsigned a, unsigned b, float c) { return __builtin_amdgcn_fdot2_f32_bf16(__builtin_bit_cast(bf16x2_t, a), __builtin_bit_cast(bf16x2_t, b), c, false); }
__device__ __forceinline__ void phase_rwkv_carry(Frame& F, CArgs A, int l) {
    const float* LS = (const float*)(A->ws + WS_LS); float* SIN = (float*)(A->ws + WS_SIN); const bf16* TT = (const bf16*)(A->ws + WS_TT);
    const int lane = F.lane, tid = F.tid, wv = F.wave;
    constexpr int STG = 11264;
#pragma unroll 1
    for (int g = F.vcu >> 2; g < 64; g += (F.G + 3) / 4) {
        const int bh = g >> 3, rbase = 8 * (g & 7);
        const bf16* tsrc = TT + ((size_t)bh * 128 * 64 + (tid >> 3)) * 64 + 8 * (tid & 7);
        const float* lsrc = LS + ((size_t)bh * 128 * 64 + rbase + ((tid & 127) >> 4)) * 64 + 4 * (tid & 15);
        const int tdst = (tid >> 3) * 144 + (tid & 7) * 16, ldst = 9216 + ((tid & 127) >> 4) * 256 + (tid & 15) * 16;
        float* sp = SIN + ((size_t)bh * 128 * 64 + rbase + wv) * 64 + lane;
        v4u rt[8]; f32x4 rl[8];
#define CL_LOAD(slot, n_) do { rt[slot] = *(const v4u*)(tsrc + (size_t)(n_) * 4096); if (tid < 128) rl[slot] = *(const f32x4*)(lsrc + (size_t)(n_) * 4096); } while (0)
#define CL_WRITE(slot, n_) do { LAS unsigned char* st_ = F.lds + ((n_) & 1) * STG; *(LAS v4u*)(st_ + tdst) = rt[slot]; if (tid < 128) *(LAS f32x4*)(st_ + ldst) = rl[slot]; } while (0)
        __syncthreads();
#pragma unroll
        for (int i = 0; i < 8; ++i) CL_LOAD(i, i);
        CL_WRITE(0, 0); CL_LOAD(0, 8);
        __syncthreads();
        float s0 = 0.f;
#define CL_STEP(n_, slot) do { if ((n_) < 127) { \
            if ((n_) + 1 < 127) { CL_WRITE(((slot) + 1) & 7, (n_) + 1); if ((n_) + 9 < 127) CL_LOAD(((slot) + 1) & 7, (n_) + 9); } \
            const LAS unsigned char* st_ = F.lds + ((n_) & 1) * STG; v4u tq[8]; \
            _Pragma("unroll") for (int q = 0; q < 8; ++q) tq[q] = *(const LAS v4u*)(st_ + lane * 144 + q * 16); \
            float a0 = *(const LAS float*)(st_ + 9216 + (wv * 64 + lane) * 4), c0 = 0.f, a1 = 0.f, c1 = 0.f; \
            const unsigned p0 = pk2(s0, __shfl_down(s0, 1)); \
            _Pragma("unroll") for (int j = 0; j < 32; ++j) { const unsigned x0 = (unsigned)__builtin_amdgcn_readlane((int)p0, 2 * j); \
                const unsigned tw = (j & 3) == 0 ? tq[j >> 2].x : ((j & 3) == 1 ? tq[j >> 2].y : ((j & 3) == 2 ? tq[j >> 2].z : tq[j >> 2].w)); \
                if ((j & 3) == 0) a0 = dot2bf(tw, x0, a0); else if ((j & 3) == 1) c0 = dot2bf(tw, x0, c0); else if ((j & 3) == 2) a1 = dot2bf(tw, x0, a1); else c1 = dot2bf(tw, x0, c1); } \
            s0 = (a0 + c0) + (a1 + c1); sp[(size_t)((n_) + 1) * 4096] = s0; \
            __syncthreads(); } } while (0)
#pragma unroll 1
        for (int nb = 0; nb < 128; nb += 8) { CL_STEP(nb, 0); CL_STEP(nb + 1, 1); CL_STEP(nb + 2, 2); CL_STEP(nb + 3, 3); CL_STEP(nb + 4, 4); CL_STEP(nb + 5, 5); CL_STEP(nb + 6, 6); CL_STEP(nb + 7, 7); }
#undef CL_LOAD
#undef CL_WRITE
#undef CL_STEP
    }
}
typedef short rbf16x8 __attribute__((ext_vector_type(8)));
__device__ __forceinline__ void phase_rwkv_fix(Frame& F, CArgs A, int l) {
    LAS unsigned char* XG = F.lds;
    const bf16* MIXIN = (const bf16*)(A->ws + WS_BIG); bf16* YW = (bf16*)(A->ws + WS_YW); const float* YL = (const float*)(A->ws + WS_YL); const bf16* U = (const bf16*)(A->ws + WS_U);
    const float* SIN = (const float*)(A->ws + WS_SIN); const float* BS = (const float*)(A->ws + WS_BS); const bf16* G2T = (const bf16*)(A->ws + WS_G2T);
    const float* mu = A->in[7] + (size_t)l * 1024; const float* gn = A->in[16] + l * 256;
    const int lane = F.lane, su = F.wave >> 1, tp = F.wave & 1, ut = F.tid & 127, fr = lane & 15, fq = lane >> 4;
#pragma unroll 1
    for (int u0 = 4 * F.vcu; u0 < 1024; u0 += 4 * F.G) {
        const int unit = u0 + su, bh = unit >> 7, chunk = unit & 127, b = bh >> 2, h = bh & 3; const size_t mb = (size_t)b * SEQ + chunk * 64;
        __syncthreads();
        { const int tok = ut >> 1, q2 = ut & 1; const size_t m = mb + tok; const int t = chunk * 64 + tok;
          const v4u* cp = (const v4u*)(MIXIN + m * MIXLD + C_RW + 896 + 64 * q2); const v4u* pp = (const v4u*)(MIXIN + (m > 0 ? m - 1 : 0) * MIXLD + C_RW + 896 + 64 * q2);
#pragma unroll
          for (int c = 0; c < 8; ++c) { const v4u cw = cp[c]; v4u pw = pp[c]; if (t == 0) pw = (v4u){0u, 0u, 0u, 0u};
              const float* mup = mu + 896 + 64 * q2 + 8 * c; float o[8];
              const unsigned cwa[4] = {cw.x, cw.y, cw.z, cw.w}, pwa[4] = {pw.x, pw.y, pw.z, pw.w};
#pragma unroll
              for (int e = 0; e < 4; ++e) { const float c0 = bflo(cwa[e]), c1 = bfhi(cwa[e]), p0 = bflo(pwa[e]), p1 = bfhi(pwa[e]);
                  o[2 * e] = sigm(c0 + (p0 - c0) * mup[2 * e]); o[2 * e + 1] = sigm(c1 + (p1 - c1) * mup[2 * e + 1]); }
              v4u w; w.x = pk2(o[0], o[1]); w.y = pk2(o[2], o[3]); w.z = pk2(o[4], o[5]); w.w = pk2(o[6], o[7]);
              *(LAS v4u*)(XG + ((su * 64 + tok) * 136 + 64 * q2 + 8 * c) * 2) = w; } }
        __syncthreads();
        f32x4 acc[2][4], accg[2][4];
#pragma unroll
        for (int th = 0; th < 2; ++th)
#pragma unroll
            for (int vt = 0; vt < 4; ++vt) { acc[th][vt] = (f32x4){0.f, 0.f, 0.f, 0.f}; accg[th][vt] = (f32x4){0.f, 0.f, 0.f, 0.f}; }
        if (chunk > 0) {
            const float* sin_ = SIN + ((size_t)bh * 128 + chunk) * 4096;
#pragma unroll
            for (int ks = 0; ks < 2; ++ks) {
                const rbf16x8 af0 = *(const rbf16x8*)(U + (mb + 32 * tp + fr) * 256 + h * 64 + 32 * ks + 8 * fq);
                const rbf16x8 af1 = *(const rbf16x8*)(U + (mb + 32 * tp + 16 + fr) * 256 + h * 64 + 32 * ks + 8 * fq);
#pragma unroll
                for (int vt = 0; vt < 4; ++vt) { const f32x4* sp = (const f32x4*)(sin_ + (16 * vt + fr) * 64 + 32 * ks + 8 * fq); const f32x4 s0 = sp[0], s1 = sp[1];
                    v4u bw; bw.x = pk2(s0[0], s0[1]); bw.y = pk2(s0[2], s0[3]); bw.z = pk2(s1[0], s1[1]); bw.w = pk2(s1[2], s1[3]);
                    const rbf16x8 bfr = __builtin_bit_cast(rbf16x8, bw);
                    acc[0][vt] = __builtin_amdgcn_mfma_f32_16x16x32_bf16(bfr, af0, acc[0][vt], 0, 0, 0);
                    acc[1][vt] = __builtin_amdgcn_mfma_f32_16x16x32_bf16(bfr, af1, acc[1][vt], 0, 0, 0); } }
        }
#pragma unroll
        for (int ks = 0; ks < 4; ++ks) {
            const rbf16x8 af0 = *(const LAS rbf16x8*)(XG + ((su * 64 + 32 * tp + fr) * 136 + 32 * ks + 8 * fq) * 2);
            const rbf16x8 af1 = *(const LAS rbf16x8*)(XG + ((su * 64 + 32 * tp + 16 + fr) * 136 + 32 * ks + 8 * fq) * 2);
#pragma unroll
            for (int vt = 0; vt < 4; ++vt) { const rbf16x8 bfr = *(const rbf16x8*)(G2T + (size_t)(h * 64 + 16 * vt + fr) * 128 + 32 * ks + 8 * fq);
                accg[0][vt] = __builtin_amdgcn_mfma_f32_16x16x32_bf16(bfr, af0, accg[0][vt], 0, 0, 0);
                accg[1][vt] = __builtin_amdgcn_mfma_f32_16x16x32_bf16(bfr, af1, accg[1][vt], 0, 0, 0); } }
        typedef unsigned v2u_ __attribute__((ext_vector_type(2)));
#pragma unroll
        for (int th = 0; th < 2; ++th) { const size_t m = mb + 32 * tp + 16 * th + fr; const int t = chunk * 64 + 32 * tp + 16 * th + fr; const size_t mp = m > 0 ? m - 1 : 0;
            f32x4 y4[4]; v2u_ vc[4], vp[4];
#pragma unroll
            for (int vt = 0; vt < 4; ++vt) { const int ch0 = h * 64 + 16 * vt + 4 * fq; y4[vt] = *(const f32x4*)(YL + m * 256 + ch0);
                vc[vt] = *(const v2u_*)(MIXIN + m * MIXLD + C_RW + 512 + ch0); vp[vt] = *(const v2u_*)(MIXIN + mp * MIXLD + C_RW + 512 + ch0); }
            const float bsv = BS[m * 4 + h];
            float sm = 0.f;
#pragma unroll
            for (int vt = 0; vt < 4; ++vt) { y4[vt] = y4[vt] + acc[th][vt]; sm += (y4[vt][0] + y4[vt][1]) + (y4[vt][2] + y4[vt][3]); }
            sm = half_sum(pair16_sum(sm));
            const float mean = sm * (1.f / 64.f); float vs = 0.f;
#pragma unroll
            for (int vt = 0; vt < 4; ++vt)
#pragma unroll
                for (int r = 0; r < 4; ++r) { y4[vt][r] -= mean; vs += y4[vt][r] * y4[vt][r]; }
            vs = half_sum(pair16_sum(vs));
            const float rs = __builtin_amdgcn_rsqf(vs * (1.f / 64.f) + 64e-5f);
#pragma unroll
            for (int vt = 0; vt < 4; ++vt) { const int ch0 = h * 64 + 16 * vt + 4 * fq; const f32x4 mu4 = *(const f32x4*)(mu + 512 + ch0), gn4 = *(const f32x4*)(gn + ch0);
                v2u_ pw = vp[vt]; if (t == 0) pw = (v2u_){0u, 0u};
                const float c0 = bflo(vc[vt].x), c1 = bfhi(vc[vt].x), c2 = bflo(vc[vt].y), c3 = bfhi(vc[vt].y), p0 = bflo(pw.x), p1 = bfhi(pw.x), p2 = bflo(pw.y), p3 = bfhi(pw.y);
                const float v0 = c0 + (p0 - c0) * mu4[0], v1 = c1 + (p1 - c1) * mu4[1], v2 = c2 + (p2 - c2) * mu4[2], v3 = c3 + (p3 - c3) * mu4[3];
                const f32x4 g4 = accg[th][vt];
                v2u_ o; o.x = pk2((y4[vt][0] * rs * gn4[0] + bsv * v0) * g4[0], (y4[vt][1] * rs * gn4[1] + bsv * v1) * g4[1]);
                o.y = pk2((y4[vt][2] * rs * gn4[2] + bsv * v2) * g4[2], (y4[vt][3] * rs * gn4[3] + bsv * v3) * g4[3]);
                *(v2u_*)(YW + m * 256 + ch0) = o; } }
    }
}
constexpr int LQ = 72, LKP = 136;
constexpr int RL_QS = 0, RL_KS = 18432, RL_VT = 36864, RL_KD = 54272, RL_PS = 71680;
constexpr size_t WS_UB = 1 * MiB;
typedef short rbf16x8 __attribute__((ext_vector_type(8)));
__device__ __forceinline__ void rot8(const float* rope, int pos, int c, const float* lo, const float* hi, float* olo, float* ohi) {
    const f32x4* rp = (const f32x4*)(rope + ((size_t)pos * 32 + 8 * c) * 2);
#pragma unroll
    for (int q = 0; q < 4; ++q) { const f32x4 cs = rp[q];
        olo[2 * q] = lo[2 * q] * cs[0] - hi[2 * q] * cs[1]; ohi[2 * q] = lo[2 * q] * cs[1] + hi[2 * q] * cs[0];
        olo[2 * q + 1] = lo[2 * q + 1] * cs[2] - hi[2 * q + 1] * cs[3]; ohi[2 * q + 1] = lo[2 * q + 1] * cs[3] + hi[2 * q + 1] * cs[2]; }
}
__device__ __forceinline__ void ret_stage_vt(Frame& F, const bf16* MIXIN, size_t mb, int h) {
    const int j = F.tid & 127, dg = F.tid >> 7; const v4u* vp = (const v4u*)(MIXIN + (mb + j) * MIXLD + C_RETV + h * 64 + 16 * dg);
    const v4u a = vp[0], c = vp[1]; LAS bf16* Vt = (LAS bf16*)(F.lds + RL_VT) + (16 * dg) * LKP + j;
    const unsigned w[8] = {a.x, a.y, a.z, a.w, c.x, c.y, c.z, c.w};
#pragma unroll
    for (int e = 0; e < 8; ++e) { Vt[(2 * e) * LKP] = (bf16)(w[e] & 0xffffu); Vt[(2 * e + 1) * LKP] = (bf16)(w[e] >> 16); }
}
__device__ __forceinline__ void phase_ret_state(Frame& F, CArgs A, int l) {
    const bf16* MIXIN = (const bf16*)(A->ws + WS_BIG); const float* rope = (const float*)(A->ws + WS_ROPE); bf16* UB = (bf16*)(A->ws + WS_UB);
    const int lane = F.lane, fr = lane & 15, fq = lane >> 4, w = F.wave;
#pragma unroll 1
    for (int u = F.vcu; u < 512; u += F.G) {
        const int bh = u >> 6, n = u & 63, b = bh >> 2, h = bh & 3; const size_t mb = (size_t)b * SEQ + n * 128;
        const float lg2g = log2f(1.0f - exp2f(-5.0f - (float)h));
        __syncthreads();
        { const int j = F.tid & 127, c2 = F.tid >> 7; const bf16* kp = MIXIN + (mb + j) * MIXLD + C_RETK + h * 64 + 8 * c2;
          float lo[8], hi[8], olo[8], ohi[8]; unpack8(*(const v4u*)kp, lo); unpack8(*(const v4u*)(kp + 32), hi);
          rot8(rope, n * 128 + j, c2, lo, hi, olo, ohi); const float dk = __builtin_amdgcn_exp2f((float)(127 - j) * lg2g);
          LAS bf16* Kd = (LAS bf16*)(F.lds + RL_KD) + j;
#pragma unroll
          for (int e = 0; e < 8; ++e) { Kd[(8 * c2 + e) * LKP] = (bf16)f2bf(olo[e] * dk); Kd[(32 + 8 * c2 + e) * LKP] = (bf16)f2bf(ohi[e] * dk); } }
        ret_stage_vt(F, MIXIN, mb, h);
        __syncthreads();
#pragma unroll
        for (int ti = 0; ti < 2; ++ti) { const int tI = 2 * w + ti, at = tI >> 2, ct = tI & 3; f32x4 acc = (f32x4){0.f, 0.f, 0.f, 0.f};
#pragma unroll
            for (int ks = 0; ks < 4; ++ks) { const rbf16x8 af = *(const LAS rbf16x8*)(F.lds + RL_KD + ((16 * at + fr) * LKP + 32 * ks + 8 * fq) * 2);
                const rbf16x8 bfr = *(const LAS rbf16x8*)(F.lds + RL_VT + ((16 * ct + fr) * LKP + 32 * ks + 8 * fq) * 2);
                acc = __builtin_amdgcn_mfma_f32_16x16x32_bf16(af, bfr, acc, 0, 0, 0); }
#pragma unroll
            for (int r = 0; r < 4; ++r) UB[((size_t)(bh * 64 + n) * 64 + 16 * at + 4 * fq + r) * 64 + 16 * ct + fr] = (bf16)f2bf(acc[r]); }
    }
}
__device__ __forceinline__ void phase_ret_carry(Frame& F, CArgs A, int l) {
    const bf16* UB = (const bf16*)(A->ws + WS_UB); bf16* RP = (bf16*)(A->ws + WS_RP);
    const int nthr = (F.G + 3) / 4 * NWAVES * 64;
#pragma unroll 1
    for (int e = (F.vcu >> 2) * NWAVES * 64 + F.tid; e < 32768; e += nthr) {
        const int bh = e >> 12, idx = e & 4095, h = bh & 3; const float dec = exp2f(128.0f * log2f(1.0f - exp2f(-5.0f - (float)h)));
        const bf16* p = UB + (size_t)bh * 64 * 4096 + idx; bf16* o = RP + (size_t)bh * 64 * 4096 + idx; float R = 0.f;
#pragma unroll 1
        for (int n0 = 0; n0 < 64; n0 += 32) { float u[32];
#pragma unroll
            for (int n = 0; n < 32; ++n) u[n] = bf2f(p[(size_t)(n0 + n) * 4096]);
#pragma unroll
            for (int n = 0; n < 32; ++n) { o[(size_t)(n0 + n) * 4096] = (bf16)f2bf(R); R = R * dec + u[n]; } }
    }
}
__device__ __forceinline__ void phase_fox_combine(Frame& F, CArgs A) {
    const bf16* O0 = (const bf16*)(A->ws + WS_FO0); bf16* O1 = (bf16*)(A->ws + WS_YF); const float* L0 = (const float*)(A->ws + WS_FL0); const float* L1 = (const float*)(A->ws + WS_FL1);
#pragma unroll 1
    for (int it = F.vcu * NWAVES * 64 + F.tid; it < M * 32; it += F.G * NWAVES * 64) {
        const int m = it >> 5, c8 = it & 31, h = c8 >> 3; const float l0 = L0[(size_t)m * 4 + h], l1 = L1[(size_t)m * 4 + h];
        if (l0 == -INFINITY) continue;
        const float mx = fmaxf(l0, l1), w0 = exp2f(l0 - mx), w1 = exp2f(l1 - mx), inv = 1.0f / (w0 + w1);
        const v4u a = *(const v4u*)(O0 + (size_t)m * 256 + 8 * c8); v4u* op = (v4u*)(O1 + (size_t)m * 256 + 8 * c8); const v4u c = *op;
        float fa[8], fc[8]; unpack8(a, fa); unpack8(c, fc);
#pragma unroll
        for (int e = 0; e < 8; ++e) fa[e] = (w0 * fa[e] + w1 * fc[e]) * inv;
        v4u o; o.x = pk2(fa[0], fa[1]); o.y = pk2(fa[2], fa[3]); o.z = pk2(fa[4], fa[5]); o.w = pk2(fa[6], fa[7]); *op = o;
    }
}
__device__ __forceinline__ void phase_ret_out(Frame& F, CArgs A, int l, unsigned* ctr) {
    const bf16* MIXIN = (const bf16*)(A->ws + WS_BIG); const float* rope = (const float*)(A->ws + WS_ROPE); const bf16* UB = (const bf16*)(A->ws + WS_RP);
    bf16* YR = (bf16*)(A->ws + WS_YR); const float* rgn = A->in[3] + l * 256;
    const int lane = F.lane, fr = lane & 15, fq = lane >> 4, w = F.wave;
    volatile LAS unsigned* slot = (volatile LAS unsigned*)(F.lds + STG_OFF);
    unsigned nxt = 0u; if (F.tid == 0) nxt = __hip_atomic_fetch_add(ctr, 1u, __ATOMIC_RELAXED, __HIP_MEMORY_SCOPE_AGENT);
#pragma unroll 1
    for (;;) {
        __syncthreads();
        if (F.tid == 0) slot[0] = nxt;
        __syncthreads();
        const int u = (int)__builtin_amdgcn_readfirstlane(slot[0]);
        if (u >= 512) break;
        if (F.tid == 0) nxt = __hip_atomic_fetch_add(ctr, 1u, __ATOMIC_RELAXED, __HIP_MEMORY_SCOPE_AGENT);
        const int bh = u >> 6, n = u & 63, b = bh >> 2, h = bh & 3; const size_t mb = (size_t)b * SEQ + n * 128;
        const float lg2g = log2f(1.0f - exp2f(-5.0f - (float)h));
        __syncthreads();
        { const int j = F.tid >> 2, c = F.tid & 3; const bf16* qp = MIXIN + (mb + j) * MIXLD + C_RETQ + h * 64 + 8 * c; const bf16* kp = MIXIN + (mb + j) * MIXLD + C_RETK + h * 64 + 8 * c;
          float lo[8], hi[8], olo[8], ohi[8];
          unpack8(*(const v4u*)qp, lo); unpack8(*(const v4u*)(qp + 32), hi); rot8(rope, n * 128 + j, c, lo, hi, olo, ohi);
          { v4u a, d; a.x = pk2(olo[0] * 0.125f, olo[1] * 0.125f); a.y = pk2(olo[2] * 0.125f, olo[3] * 0.125f); a.z = pk2(olo[4] * 0.125f, olo[5] * 0.125f); a.w = pk2(olo[6] * 0.125f, olo[7] * 0.125f);
            d.x = pk2(ohi[0] * 0.125f, ohi[1] * 0.125f); d.y = pk2(ohi[2] * 0.125f, ohi[3] * 0.125f); d.z = pk2(ohi[4] * 0.125f, ohi[5] * 0.125f); d.w = pk2(ohi[6] * 0.125f, ohi[7] * 0.125f);
            *(LAS v4u*)(F.lds + RL_QS + (j * LQ + 8 * c) * 2) = a; *(LAS v4u*)(F.lds + RL_QS + (j * LQ + 32 + 8 * c) * 2) = d; }
          unpack8(*(const v4u*)kp, lo); unpack8(*(const v4u*)(kp + 32), hi); rot8(rope, n * 128 + j, c, lo, hi, olo, ohi);
          { v4u a, d; a.x = pk2(olo[0], olo[1]); a.y = pk2(olo[2], olo[3]); a.z = pk2(olo[4], olo[5]); a.w = pk2(olo[6], olo[7]);
            d.x = pk2(ohi[0], ohi[1]); d.y = pk2(ohi[2], ohi[3]); d.z = pk2(ohi[4], ohi[5]); d.w = pk2(ohi[6], ohi[7]);
            *(LAS v4u*)(F.lds + RL_KS + (j * LQ + 8 * c) * 2) = a; *(LAS v4u*)(F.lds + RL_KS + (j * LQ + 32 + 8 * c) * 2) = d; } }
        ret_stage_vt(F, MIXIN, mb, h);
        if (n > 0) { const int dk = F.tid >> 3, dv0 = 8 * (F.tid & 7); const v4u rw = *(const v4u*)(UB + (size_t)(bh * 64 + n) * 4096 + dk * 64 + dv0);
            LAS bf16* Rt = (LAS bf16*)(F.lds + RL_KD) + dv0 * LQ + dk; const unsigned ww[4] = {rw.x, rw.y, rw.z, rw.w};
#pragma unroll
            for (int e = 0; e < 4; ++e) { Rt[(2 * e) * LQ] = (bf16)(ww[e] & 0xffffu); Rt[(2 * e + 1) * LQ] = (bf16)(ww[e] >> 16); } }
        __syncthreads();
        const int whalf = w >> 1;
#pragma unroll
        for (int c = 0; c < 8; ++c) { if (c <= 2 * whalf + 1) { f32x4 s = (f32x4){0.f, 0.f, 0.f, 0.f};
                if (c <= w) {
#pragma unroll
                    for (int ks = 0; ks < 2; ++ks) { const rbf16x8 af = *(const LAS rbf16x8*)(F.lds + RL_QS + ((16 * w + fr) * LQ + 32 * ks + 8 * fq) * 2);
                        const rbf16x8 bfr = *(const LAS rbf16x8*)(F.lds + RL_KS + ((16 * c + fr) * LQ + 32 * ks + 8 * fq) * 2);
                        s = __builtin_amdgcn_mfma_f32_16x16x32_bf16(af, bfr, s, 0, 0, 0); } }
#pragma unroll
                for (int r = 0; r < 4; ++r) { const int i = 16 * w + 4 * fq + r, j = 16 * c + fr; const float pv = (j <= i) ? s[r] * __builtin_amdgcn_exp2f((float)(i - j) * lg2g) : 0.f;
                    *(LAS bf16*)(F.lds + RL_PS + (i * LKP + j) * 2) = (bf16)f2bf(pv); } } }
        f32x4 o[4];
#pragma unroll
        for (int c = 0; c < 4; ++c) o[c] = (f32x4){0.f, 0.f, 0.f, 0.f};
        if (n > 0) {
#pragma unroll
            for (int ks = 0; ks < 2; ++ks) { const rbf16x8 af = *(const LAS rbf16x8*)(F.lds + RL_QS + ((16 * w + fr) * LQ + 32 * ks + 8 * fq) * 2);
#pragma unroll
                for (int c = 0; c < 4; ++c) { const rbf16x8 bfr = *(const LAS rbf16x8*)(F.lds + RL_KD + ((16 * c + fr) * LQ + 32 * ks + 8 * fq) * 2);
                    o[c] = __builtin_amdgcn_mfma_f32_16x16x32_bf16(af, bfr, o[c], 0, 0, 0); } }
#pragma unroll
            for (int r = 0; r < 4; ++r) { const float qd = __builtin_amdgcn_exp2f((float)(16 * w + 4 * fq + r + 1) * lg2g);
#pragma unroll
                for (int c = 0; c < 4; ++c) o[c][r] *= qd; }
        }
#pragma unroll
        for (int ks = 0; ks < 4; ++ks) { if (ks <= whalf) { const rbf16x8 af = *(const LAS rbf16x8*)(F.lds + RL_PS + ((16 * w + fr) * LKP + 32 * ks + 8 * fq) * 2);
#pragma unroll
                for (int c = 0; c < 4; ++c) { const rbf16x8 bfr = *(const LAS rbf16x8*)(F.lds + RL_VT + ((16 * c + fr) * LKP + 32 * ks + 8 * fq) * 2);
                    o[c] = __builtin_amdgcn_mfma_f32_16x16x32_bf16(af, bfr, o[c], 0, 0, 0); } } }
#pragma unroll
        for (int r = 0; r < 4; ++r) { const size_t m = mb + 16 * w + 4 * fq + r; float sm = (o[0][r] + o[1][r]) + (o[2][r] + o[3][r]);
            sm = row_sum16(sm);
            const float mean = sm * (1.f / 64.f); float d[4], vs = 0.f;
#pragma unroll
            for (int c = 0; c < 4; ++c) { d[c] = o[c][r] - mean; vs += d[c] * d[c]; }
            vs = row_sum16(vs);
            const float rs = __builtin_amdgcn_rsqf(vs * (1.f / 64.f) + 1e-5f);
#pragma unroll
            for (int c = 0; c < 4; ++c) { const int ch = h * 64 + 16 * c + fr; const float gg = bf2f(MIXIN[m * MIXLD + C_RETG + ch]);
                YR[m * 256 + ch] = (bf16)f2bf(d[c] * rs * rgn[ch] * (gg * sigm(gg))); } }
    }
}
constexpr int PH_PER_LAYER = 11, N_PHASES = 1 + DEPTH * PH_PER_LAYER;
#ifndef PROBE_DUP
#define PROBE_DUP 0
#endif
#ifndef PROBE_VAR
#define PROBE_VAR 0
#endif
#ifndef MK_THRL
#define MK_THRL 64
#define OUT_HI(A) ((bf16*)(A)->out + (size_t)M * D)
#define OUT_LO(A) ((bf16*)(A)->out)
#endif
#ifndef MK_ONE_LAUNCH
#define MK_ONE_LAUNCH 1
#endif
__device__ __forceinline__ Frame make_frame(unsigned char* lds_generic, int wave_s) {
    Frame F;
    asm volatile("" : "+s"(wave_s));
    int lane_v; asm volatile("v_mbcnt_lo_u32_b32 %0, -1, 0\n\tv_mbcnt_hi_u32_b32 %0, -1, %0" : "=v"(lane_v));
    int tid = wave_s * 64 + lane_v;
    int bx = blockIdx.x, G = gridDim.x; asm volatile("" : "+s"(bx), "+s"(G));
    F.lds = (LAS unsigned char*)lds_generic;
    F.MISC = (volatile LAS unsigned*)(F.lds + MISC_OFF);
    F.tid = tid; F.lane = tid & 63; F.wave = __builtin_amdgcn_readfirstlane(tid >> 6);
    F.G = G; F.vcu = (G % 8 == 0) ? (bx % 8) * (G / 8) + bx / 8 : bx; F.bx = bx;
    F.ctl = nullptr;
    return F;
}
#define IN(k) (lo <= (k) && (k) < hi)
#define SEAM(k) do { if (IN(k) && IN((k) + 1)) { int w_ = wave0; asm volatile("" : "+s"(w_)); int l_; asm volatile("v_mbcnt_lo_u32_b32 %0, -1, 0\n\tv_mbcnt_hi_u32_b32 %0, -1, %0" : "=v"(l_)); xcd_barrier(bar, w_ == 0 && l_ == 0); if ((PROBE_DUP >> 20) & 1) { xcd_barrier(bar, w_ == 0 && l_ == 0); xcd_barrier(bar, w_ == 0 && l_ == 0); } } } while (0)
#define WSP(T, off) ((T*)(A->ws + (off)))
#define LOCAL_SEAM(k) do { if (IN(k) && IN((k) + 1)) { asm volatile("s_waitcnt vmcnt(0)" ::: "memory"); __syncthreads(); __builtin_amdgcn_fence(__ATOMIC_ACQUIRE, "agent"); asm volatile("s_waitcnt vmcnt(0)" ::: "memory"); __syncthreads(); } } while (0)
#define BARRIER_NOW() do { int w_ = wave0; asm volatile("" : "+s"(w_)); int l_; asm volatile("v_mbcnt_lo_u32_b32 %0, -1, 0\n\tv_mbcnt_hi_u32_b32 %0, -1, %0" : "=v"(l_)); xcd_barrier(bar, w_ == 0 && l_ == 0); } while (0)
template <int l> __device__ __forceinline__ void run_layer(unsigned char* lds, const XcdBarrier& bar, const int lo, const int hi, const int wave0) {
        const int pb = 1 + l * PH_PER_LAYER;
        if (IN(pb + 0)) { for (int rep_ = 0; rep_ < ((PROBE_DUP >> 0) & 1) + 1; ++rep_) { if (rep_) BARRIER_NOW(); CArgs A = get_args(); Frame F = make_frame(lds, wave0); phase_weights(F, A, l); } SEAM(pb + 0); }
        if (IN(pb + 1)) { for (int rep_ = 0; rep_ < ((PROBE_DUP >> 1) & 1) + 1; ++rep_) { if (rep_) BARRIER_NOW(); CArgs A = get_args(); Frame F = make_frame(lds, wave0); pg8::Gemm g{l == 0 ? WSP(bf16, WS_XB) : OUT_HI(A), WSP(bf16, WS_WIN), M, NMIX, D, 0}; pg8::StaticOrder S; S.init(M, NMIX, F.G, F.bx);
                  pg8::EpiScale<0> E{WSP(bf16, WS_BIG), MIXLD, WSP(float, WS_SS1), WSP(float, WS_FLOG), 11, 11};
                  pg8::gemm_phase<pg8::EpiScale<0>, pg8::StaticOrder, PG8_ALIGN, PG8_SP2>(F.lds + RING_OFF, g, S, E, F.tid); } SEAM(pb + 1); }
        if (IN(pb + 2)) { for (int rep_ = 0; rep_ < ((PROBE_DUP >> 2) & 1) + 1; ++rep_) { if (rep_) BARRIER_NOW(); { CArgs A = get_args(); Frame F = make_frame(lds, wave0); phase_cumsum(F, A, l); if (rep_ == 0) phase_fox_prep(F, A, l); } { CArgs A = get_args(); Frame F = make_frame(lds, wave0); phase_rwkv_prep(F, A, l); } { CArgs A = get_args(); Frame F = make_frame(lds, wave0); phase_ret_state(F, A, l); } } SEAM(pb + 2); }
        if (IN(pb + 3)) { for (int rep_ = 0; rep_ < ((PROBE_DUP >> 3) & 1) + 1; ++rep_) { if (rep_) BARRIER_NOW(); CArgs A = get_args(); Frame F = make_frame(lds, wave0); phase_rwkv_scan1<0>(F, A, l); } { CArgs A = get_args(); Frame F = make_frame(lds, wave0); if ((F.vcu & 3) == 1) phase_ret_carry(F, A, l); } SEAM(pb + 3); }
        if (IN(pb + 4)) { { CArgs A = get_args(); Frame F = make_frame(lds, wave0); if ((F.vcu & 3) == 0) phase_rwkv_carry(F, A, l); }

#if (PROBE_DUP >> 11) & 1
                  BARRIER_NOW(); { CArgs A = get_args(); Frame F = make_frame(lds, wave0); if ((F.vcu & 3) == 0) phase_rwkv_carry(F, A, l); }

#endif
                  #if (PROBE_DUP >> 12) & 1
                  { CArgs A = get_args(); Frame F = make_frame(lds, wave0);
                    const attn_body::AttnTensors AT{(const attn_body::bf16*)WSP(bf16, WS_BIG) + C_FOXQ, (const attn_body::bf16*)WSP(bf16, WS_BIG) + C_FOXK, (const attn_body::bf16*)WSP(bf16, WS_BIG) + C_FOXV,
                        (attn_body::bf16*)WSP(bf16, WS_FO0), (attn_body::bf16*)WSP(bf16, WS_YF), WSP(float, WS_FL0), WSP(float, WS_FL1), WSP(float, WS_CUM), WSP(float, WS_SEGT)};
                    attn_body::attn_phase_queue<MK_THRL, PROBE_VAR>((char*)lds + RING_OFF, AT, fox_skip_threshold(F, A, l), (unsigned*)(A->ws + WS_CTL) + CW_QUEUE + 64 * l + 32, (volatile LAS unsigned*)((LAS unsigned char*)lds + STG_OFF), F.tid); } BARRIER_NOW();
#endif
                  { CArgs A = get_args(); Frame F = make_frame(lds, wave0);
                    const attn_body::AttnTensors AT{(const attn_body::bf16*)WSP(bf16, WS_BIG) + C_FOXQ, (const attn_body::bf16*)WSP(bf16, WS_BIG) + C_FOXK, (const attn_body::bf16*)WSP(bf16, WS_BIG) + C_FOXV,
                        (attn_body::bf16*)WSP(bf16, WS_FO0), (attn_body::bf16*)WSP(bf16, WS_YF), WSP(float, WS_FL0), WSP(float, WS_FL1), WSP(float, WS_CUM), WSP(float, WS_SEGT)};
                    attn_body::attn_phase_queue<MK_THRL>((char*)lds + RING_OFF, AT, fox_skip_threshold(F, A, l), (unsigned*)(A->ws + WS_CTL) + CW_QUEUE + 64 * l, (volatile LAS unsigned*)((LAS unsigned char*)lds + STG_OFF), F.tid); }

                  { CArgs A = get_args(); Frame F = make_frame(lds, wave0); phase_ret_out(F, A, l, (unsigned*)(A->ws + WS_CTL) + CW_QUEUE + 64 * l + 16); }
                  SEAM(pb + 4); }
        if (IN(pb + 5)) { for (int rep_ = 0; rep_ < ((PROBE_DUP >> 5) & 1) + 1; ++rep_) { if (rep_) BARRIER_NOW(); { CArgs A = get_args(); Frame F = make_frame(lds, wave0); phase_rwkv_fix(F, A, l); if ((PROBE_DUP >> 16) & 1) { BARRIER_NOW(); phase_rwkv_fix(F, A, l); } }  { CArgs A = get_args(); Frame F = make_frame(lds, wave0); phase_fox_combine(F, A); } } SEAM(pb + 5); }
        if (IN(pb + 6)) { for (int rep_ = 0; rep_ < ((PROBE_DUP >> 6) & 1) + 1; ++rep_) { if (rep_) BARRIER_NOW(); CArgs A = get_args(); Frame F = make_frame(lds, wave0); pg8::Gemm g{l == 0 ? WSP(bf16, WS_XB) : OUT_HI(A), WSP(bf16, WS_WGATE), M, NGATE, D, 0}; pg8::StaticOrder S; S.init(M, NGATE, F.G, F.bx);
                  pg8::EpiScale<1> E{WSP(bf16, WS_BIG), NGATE, WSP(float, WS_SS1), nullptr, -1, 12};
                  pg8::gemm_phase<pg8::EpiScale<1>, pg8::StaticOrder, PG8_ALIGN, PG8_SP2>(F.lds + RING_OFF, g, S, E, F.tid); } SEAM(pb + 6); }
        if (IN(pb + 7)) { for (int rep_ = 0; rep_ < ((PROBE_DUP >> 7) & 1) + 1; ++rep_) { if (rep_) BARRIER_NOW();
                  { CArgs A = get_args(); Frame F = make_frame(lds, wave0); pg8::StaticOrder S; S.init(2 * M, D, F.G, F.bx);
                    pg8::gemm_phase_seg<pg8::StaticOrder>(F.lds + RING_OFF, WSP(bf16, WS_YR), WSP(bf16, WS_YF), WSP(bf16, WS_YW), WSP(bf16, WS_PBR), WSP(bf16, WS_BIG), WSP(bf16, WS_XB), S, F.tid); }
                  } SEAM(pb + 7); }
        if (IN(pb + 8)) { if ((PROBE_DUP >> 8) & 1) { CArgs A = get_args(); Frame F = make_frame(lds, wave0); pg8::Gemm g{WSP(bf16, WS_XB), WSP(bf16, WS_WOUT), M, D, D, 0}; pg8::StaticOrder S; S.init(M, D, F.G, F.bx); pg8::EpiProbe E{A->out, A->ph_hi < 0};
                  pg8::gemm_phase<pg8::EpiProbe, pg8::StaticOrder, PG8_ALIGN, PG8_SP2>(F.lds + RING_OFF, g, S, E, F.tid); BARRIER_NOW(); }
                  CArgs A = get_args(); Frame F = make_frame(lds, wave0); pg8::Gemm g{WSP(bf16, WS_XB), WSP(bf16, WS_WOUT), M, D, D, 0}; pg8::StaticOrder S; S.init(M, D, F.G, F.bx);
                  if constexpr (l == 0) { pg8::EpiResid<true, false> E{A->in[0], nullptr, nullptr, nullptr, WSP(bf16, WS_RB), WSP(bf16, WS_XLO), WSP(float, WS_SS2)};
                      pg8::gemm_phase<pg8::EpiResid<true, false>, pg8::StaticOrder, false, PG8_SP2>(F.lds + RING_OFF, g, S, E, F.tid); }
                  else { pg8::EpiResid<false, false> E{nullptr, OUT_HI(A), OUT_LO(A), nullptr, WSP(bf16, WS_RB), WSP(bf16, WS_XLO), WSP(float, WS_SS2)};
                      pg8::gemm_phase<pg8::EpiResid<false, false>, pg8::StaticOrder, false, PG8_SP2>(F.lds + RING_OFF, g, S, E, F.tid); }
                  SEAM(pb + 8); }
        if (IN(pb + 9)) { for (int rep_ = 0; rep_ < ((PROBE_DUP >> 9) & 1) + 1; ++rep_) { if (rep_) BARRIER_NOW(); CArgs A = get_args(); Frame F = make_frame(lds, wave0); pg8::Gemm g{WSP(bf16, WS_RB), WSP(bf16, WS_WGU), M, NGU, D, 0}; pg8::HalfTailOrder S; S.init(M, NGU, F.G, F.bx);
                  pg8::EpiSwiglu E{WSP(bf16, WS_BIG), WSP(float, WS_SS2)};
                  pg8::gemm_phase<pg8::EpiSwiglu, pg8::HalfTailOrder, PG8_ALIGN, PG8_SP2>(F.lds + RING_OFF, g, S, E, F.tid); } SEAM(pb + 9); }
        if (IN(pb + 10)) { if ((PROBE_DUP >> 10) & 1) { CArgs A = get_args(); Frame F = make_frame(lds, wave0); pg8::Gemm g{WSP(bf16, WS_BIG), WSP(bf16, WS_WDOWN), M, D, DFF, 0}; pg8::StaticOrder S; S.init(M, D, F.G, F.bx); pg8::EpiProbe E{A->out, A->ph_hi < 0};
                  pg8::gemm_phase<pg8::EpiProbe, pg8::StaticOrder, PG8_ALIGN, PG8_SP2>(F.lds + RING_OFF, g, S, E, F.tid); BARRIER_NOW(); }
                  CArgs A = get_args(); Frame F = make_frame(lds, wave0); pg8::Gemm g{WSP(bf16, WS_BIG), WSP(bf16, WS_WDOWN), M, D, DFF, 0}; pg8::StaticOrder S; S.init(M, D, F.G, F.bx);
                  if constexpr (l == DEPTH - 1) { pg8::EpiResid<false, true> E{nullptr, WSP(bf16, WS_RB), WSP(bf16, WS_XLO), A->out, nullptr, nullptr, nullptr};
                      pg8::gemm_phase<pg8::EpiResid<false, true>, pg8::StaticOrder, false, PG8_SP2>(F.lds + RING_OFF, g, S, E, F.tid); }
                  else { pg8::EpiResid<false, false> E{nullptr, WSP(bf16, WS_RB), WSP(bf16, WS_XLO), nullptr, OUT_HI(A), OUT_LO(A), WSP(float, WS_SS1)};
                      pg8::gemm_phase<pg8::EpiResid<false, false>, pg8::StaticOrder, false, PG8_SP2>(F.lds + RING_OFF, g, S, E, F.tid); }
                  SEAM(pb + 10); }
    }
#ifndef MK_NO_PK
#define MK_NO_PK 0
#endif
#if MK_NO_PK
#define MK_KATTR __attribute__((target("no-packed-fp32-ops")))
#else
#define MK_KATTR
#endif
__global__ void __launch_bounds__(NWAVES * 64, 2) MK_KATTR mega_fwd(Args args) {
    extern __shared__ __attribute__((aligned(16))) unsigned char lds[];
    const int wave0 = __builtin_amdgcn_readfirstlane((int)threadIdx.x >> 6);
    { const int tid0 = threadIdx.x;
      for (int u = tid0; u < (LDS_BYTES - LDSCTL_OFF) / 4; u += NWAVES * 64) ((LAS unsigned*)((LAS unsigned char*)lds + LDSCTL_OFF))[u] = 0u; }
    __syncthreads();
    XcdBarrier bar = xcd_barrier_post((unsigned*)((gu32*)(args.ws + WS_CTL) + CW_BAR), (volatile LAS unsigned*)((LAS unsigned char*)lds + MISC_OFF) + 8);
    const int lo = args.ph_lo, hi = args.ph_hi;
    if (IN(0)) { CArgs A = get_args(); Frame F = make_frame(lds, wave0); phase_prologue(F, A); }
    run_layer<0>(lds, bar, lo, hi, wave0);
    run_layer<1>(lds, bar, lo, hi, wave0);
}

#undef IN
#undef SEAM
#undef WSP
#undef LOCAL_SEAM
#undef BARRIER_NOW
extern "C" void kernel_launch(void* const* d_in, const int* in_sizes, int n_in, void* d_out, int out_size, void* d_ws, size_t ws_size, hipStream_t stream) {
    static int grid = 0;
    if (grid == 0) {
        if (n_in != 24 || in_sizes[0] != M * D || out_size != M * D || ws_size < WS_END) { fprintf(stderr, "kernel_launch: unexpected shapes (n_in %d, in0 %d, out %d, ws %zu); nothing launched\n", n_in, n_in > 0 ? in_sizes[0] : -1, out_size, ws_size); grid = -1; return; }
        int dev = 0, cus = 0;
        if (hipGetDevice(&dev) != hipSuccess || hipDeviceGetAttribute(&cus, hipDeviceAttributeMultiprocessorCount, dev) != hipSuccess) { grid = -1; return; }
        if (hipFuncSetAttribute((const void*)mega_fwd, hipFuncAttributeMaxDynamicSharedMemorySize, LDS_BYTES) != hipSuccess) { fprintf(stderr, "kernel_launch: hipFuncSetAttribute failed\n"); grid = -1; return; }
        (void)hipGetLastError();
        grid = cus;
    }
    if (grid < 0) return;
    if (hipMemsetAsync((char*)d_ws + WS_CTL, 0, CTL_ZERO_BYTES, stream) != hipSuccess) return;
    Args a{};
    for (int i = 0; i < 24; ++i) a.in[i] = (const float*)d_in[i];
    a.out = (float*)d_out; a.ws = (unsigned char*)d_ws;
#if MK_ONE_LAUNCH
    a.ph_lo = 0; a.ph_hi = N_PHASES;
    hipLaunchKernelGGL(mega_fwd, dim3(grid), dim3(NWAVES * 64), LDS_BYTES, stream, a);
#else
    for (int ph = 0; ph < N_PHASES; ++ph) { a.ph_lo = ph; a.ph_hi = ph + 1;
        hipLaunchKernelGGL(mega_fwd, dim3(grid), dim3(NWAVES * 64), LDS_BYTES, stream, a); }
#endif
}
```

```cpp
#include <hip/hip_runtime.h>
#include <cstdio>
#include <cstdint>
#include <cmath>
namespace pg8 {
#define PG8_LAS __attribute__((address_space(3)))
typedef unsigned short bf16_t;
typedef short bf16x8 __attribute__((ext_vector_type(8)));
typedef float f32x4 __attribute__((ext_vector_type(4)));
typedef unsigned u32x4 __attribute__((ext_vector_type(4)));
constexpr int BM = 256, BK = 64, HALF = 128, HTB = HALF * BK * 2  , STAGE_BYTES = 8 * HTB, NXCD = 8, WGM = 4;

__host__ __device__ __forceinline__ int lds_byte(int r, int c) { const int st = (r >> 4) * 2 + (c >> 5), rr = r & 15, cc = c & 31, ob = rr * 64 + cc * 2; return st * 1024 + (ob ^ (((ob >> 9) & 1) << 5)); }
__host__ __device__ __forceinline__ void stage_rc(int b, int& R, int& C) { const int st = b / 1024, sb = b % 1024, swz = sb ^ (((sb >> 9) & 1) << 5); R = (st >> 1) * 16 + swz / 64; C = (st & 1) * 32 + (swz % 64) / 2; }
__host__ __device__ __forceinline__ int perm32(int rho) { const int n = rho >> 4, i = rho & 15; return 8 * (i >> 2) + 4 * n + (i & 3); }

struct Unit { int pm, pn, half; };
struct Gemm { const bf16_t* A; const bf16_t* Bt; int M, N, K, lda; };

struct StaticOrder {
    static constexpr bool HALVES = false;
    int nM, nN, nwg, G, c;
    __host__ __device__ void init(int M, int N, int G_, int c_) { nM = M / BM; nN = N / BM; nwg = nM * nN; G = G_; c = c_; }
    __host__ __device__ bool next(int i, Unit& u) const {
        const long L = (long)i * G + c; if (L >= nwg) return false;
        int wgid = (int)L; { const int q = nwg / NXCD, r = nwg % NXCD, xcd = wgid % NXCD, off = wgid / NXCD; wgid = (xcd < r ? xcd * (q + 1) : r * (q + 1) + (xcd - r) * q) + off; }
        const int nig = WGM * nN, gid = wgid / nig, fm = gid * WGM, gsz = (nM - fm) < WGM ? (nM - fm) : WGM;
        u.pm = fm + ((wgid % nig) % gsz); u.pn = (wgid % nig) / gsz; u.half = 0; return true;
    }
    __device__ __forceinline__ void a_ready(const Unit&) const {}
    __device__ __forceinline__ void done(const Unit&) const {}
};
struct GateOrder {
    static constexpr bool HALVES = false;
    StaticOrder base;
    __host__ __device__ void init(int M, int G_, int c_) { base.init(M, 1024, G_, c_); }
    __host__ __device__ bool next(int i, Unit& u) const { Unit b; if (!base.next(i / 3, b)) return false; u.pm = b.pm; u.pn = b.pn + 4 * (i % 3); u.half = 0; return true; }
    __device__ __forceinline__ void a_ready(const Unit&) const {}
    __device__ __forceinline__ void done(const Unit&) const {}
};
struct HalfTailOrder : StaticOrder {
    static constexpr bool HALVES = true;
    __host__ __device__ bool next(int i, Unit& u) const {
        const int full = (nwg / G) * G, rem = nwg - full;
        if ((long)i * G + c < full || rem * 2 != G) return StaticOrder::next(i, u);
        if ((long)i * G != full) return false;
        StaticOrder t = *this; t.c = 0; t.G = 1; if (!t.next(full + (c >> 1), u)) return false;
        u.half = 1 + (c & 1); return true;
    }
};

typedef unsigned u32x4 __attribute__((ext_vector_type(4)));
typedef float f32x2e __attribute__((ext_vector_type(2))); typedef __bf16 bf16x2e __attribute__((ext_vector_type(2)));
__device__ __forceinline__ unsigned pk2_(float lo, float hi) { const f32x2e v = {lo, hi}; return __builtin_bit_cast(unsigned, __builtin_convertvector(v, bf16x2e)); }
__device__ __forceinline__ float bflo_(unsigned w) { return __builtin_bit_cast(float, w << 16); }
__device__ __forceinline__ float bfhi_(unsigned w) { return __builtin_bit_cast(float, w & 0xffff0000u); }
__device__ __forceinline__ float sigmoidf_(float x) { return __builtin_amdgcn_rcpf(1.0f + __expf(-x)); }
__device__ __forceinline__ void rstd8(const float* ss, int row0, float (&rs)[8]) {
    f32x4 v[8];
#pragma unroll
    for (int i = 0; i < 8; ++i) v[i] = *(const f32x4*)(ss + (unsigned)(row0 + (i >> 2) * HALF + (i & 3) * 16) * 4u);
#pragma unroll
    for (int i = 0; i < 8; ++i) rs[i] = __builtin_amdgcn_rsqf(((v[i][0] + v[i][1]) + (v[i][2] + v[i][3])) * (1.0f / 1024.0f) + 1e-6f);
}

template <int ACT> struct EpiScale {
    static constexpr bool PERM = true, AFTER_DRAIN = false;
    bf16_t* O; int ldc; const float* ss; float* flog; int flog_tile; int store_tiles;
    __device__ __forceinline__ void operator()(const f32x4 (&acc)[2][2][4][2], const Unit& u, int wr, int wc, int fr, int fq) const {
        const int row0 = u.pm * BM + wr * 64 + fr, col0 = u.pn * BM + wc * 32 + 8 * fq;
        float rs[8]; rstd8(ss, row0, rs);
#pragma unroll
        for (int ai = 0; ai < 2; ++ai)
#pragma unroll
            for (int m = 0; m < 4; ++m) { const int row = row0 + ai * HALF + m * 16; const float r_ = rs[ai * 4 + m];
#pragma unroll
                for (int bj = 0; bj < 2; ++bj) { f32x4 v0 = acc[ai][bj][m][0] * r_, v1 = acc[ai][bj][m][1] * r_;
                    if (ACT == 1) { v0 = (f32x4){sigmoidf_(v0[0]), sigmoidf_(v0[1]), sigmoidf_(v0[2]), sigmoidf_(v0[3])}; v1 = (f32x4){sigmoidf_(v1[0]), sigmoidf_(v1[1]), sigmoidf_(v1[2]), sigmoidf_(v1[3])}; }
                    if (u.pn < store_tiles) { u32x4 w; w.x = pk2_(v0[0], v0[1]); w.y = pk2_(v0[2], v0[3]); w.z = pk2_(v1[0], v1[1]); w.w = pk2_(v1[2], v1[3]);
                        *(u32x4*)(O + ((unsigned)row * (unsigned)ldc + (unsigned)(col0 + bj * HALF))) = w; }
                    if (u.pn == flog_tile && bj == 0 && wc == 0 && fq == 0) *(f32x4*)(flog + (unsigned)row * 4u) = v0; } }
    }
};
template <int FIRST> struct EpiBranch {
    static constexpr bool PERM = true, AFTER_DRAIN = false;
    bf16_t* T; const bf16_t* gates; int gcol0;
    __device__ __forceinline__ void operator()(const f32x4 (&acc)[2][2][4][2], const Unit& u, int wr, int wc, int fr, int fq) const {
        const int row0 = u.pm * BM + wr * 64 + fr, col0 = u.pn * BM + wc * 32 + 8 * fq;
#pragma unroll
        for (int ai = 0; ai < 2; ++ai)
#pragma unroll
        for (int mh = 0; mh < 2; ++mh) { u32x4 g[2][2], p[2][2];
#pragma unroll
            for (int mm = 0; mm < 2; ++mm)
#pragma unroll
                for (int bj = 0; bj < 2; ++bj) { const int row = row0 + ai * HALF + (2 * mh + mm) * 16, col = col0 + bj * HALF;
                    g[mm][bj] = *(const u32x4*)(gates + ((unsigned)row * 3072u + (unsigned)(gcol0 + col)));
                    if (!FIRST) p[mm][bj] = *(const u32x4*)(T + ((unsigned)row * 1024u + (unsigned)col)); else p[mm][bj] = (u32x4){0u, 0u, 0u, 0u}; }
#pragma unroll
            for (int mm = 0; mm < 2; ++mm)
#pragma unroll
                for (int bj = 0; bj < 2; ++bj) { const int m = 2 * mh + mm, row = row0 + ai * HALF + m * 16, col = col0 + bj * HALF;
                    const f32x4 a0 = acc[ai][bj][m][0], a1 = acc[ai][bj][m][1]; const u32x4 gg = g[mm][bj], pp = p[mm][bj]; u32x4 w;
                    w.x = pk2_(bflo_(pp.x) + bflo_(gg.x) * a0[0], bfhi_(pp.x) + bfhi_(gg.x) * a0[1]);
                    w.y = pk2_(bflo_(pp.y) + bflo_(gg.y) * a0[2], bfhi_(pp.y) + bfhi_(gg.y) * a0[3]);
                    w.z = pk2_(bflo_(pp.z) + bflo_(gg.z) * a1[0], bfhi_(pp.z) + bfhi_(gg.z) * a1[1]);
                    w.w = pk2_(bflo_(pp.w) + bflo_(gg.w) * a1[2], bfhi_(pp.w) + bfhi_(gg.w) * a1[3]);
                    *(u32x4*)(T + ((unsigned)row * 1024u + (unsigned)col)) = w; }
            asm volatile("" ::: "memory"); }
    }
};
template <bool IN_F32, bool OUT_F32> struct EpiResid {
    static constexpr bool PERM = true, AFTER_DRAIN = true;
    const float* Xin; const bf16_t* Hin; const bf16_t* Lin; float* X; bf16_t* Hout; bf16_t* Lout; float* ss;
    __device__ __forceinline__ void ldx(u32x4 (&x)[2][2][2], int row0, int col0, int b) const {
#pragma unroll
        for (int mm = 0; mm < 2; ++mm)
#pragma unroll
            for (int bj = 0; bj < 2; ++bj) { const unsigned xoff = (unsigned)(row0 + (b >> 1) * HALF + ((b & 1) * 2 + mm) * 16) * 1024u + (unsigned)(col0 + bj * HALF);
                if (IN_F32) { x[mm][bj][0] = *(const u32x4*)(Xin + xoff); x[mm][bj][1] = *(const u32x4*)(Xin + xoff + 4); }
                else { x[mm][bj][0] = *(const u32x4*)(Hin + xoff); x[mm][bj][1] = *(const u32x4*)(Lin + xoff); } }
    }
    __device__ __forceinline__ void fused(f32x4 (&acc)[2][2][4][2], const Unit& u, int wr, int wc, int fr, int fq, PG8_LAS unsigned char* lds, int wid, int lane) const {
        const int row0 = u.pm * BM + wr * 64 + fr, col0 = u.pn * BM + wc * 32 + 8 * fq;
        PG8_LAS float* P = (PG8_LAS float*)lds;
        u32x4 x[2][2][2][2];
        ldx(x[0], row0, col0, 0);
#pragma unroll
        for (int b = 0; b < 4; ++b) { const int ai = b >> 1;
            if (b + 1 < 4) ldx(x[(b + 1) & 1], row0, col0, b + 1);
#pragma unroll
            for (int mm = 0; mm < 2; ++mm) { const int m = (b & 1) * 2 + mm; const int row = row0 + ai * HALF + m * 16; float q = 0.f;
#pragma unroll
                for (int bj = 0; bj < 2; ++bj) { const unsigned xoff = (unsigned)row * 1024u + (unsigned)(col0 + bj * HALF);
                    const u32x4 r0 = x[b & 1][mm][bj][0], r1 = x[b & 1][mm][bj][1]; f32x4 x0, x1;
                    if (IN_F32) { x0 = __builtin_bit_cast(f32x4, r0); x1 = __builtin_bit_cast(f32x4, r1); }
                    else { x0 = (f32x4){bflo_(r0.x) + bflo_(r1.x), bfhi_(r0.x) + bfhi_(r1.x), bflo_(r0.y) + bflo_(r1.y), bfhi_(r0.y) + bfhi_(r1.y)};
                           x1 = (f32x4){bflo_(r0.z) + bflo_(r1.z), bfhi_(r0.z) + bfhi_(r1.z), bflo_(r0.w) + bflo_(r1.w), bfhi_(r0.w) + bfhi_(r1.w)}; }
                    const f32x4 v0 = x0 + acc[ai][bj][m][0], v1 = x1 + acc[ai][bj][m][1];
                    if (OUT_F32) { *(f32x4*)(X + xoff) = v0; *(f32x4*)(X + xoff + 4) = v1; }
                    else { u32x4 w; w.x = pk2_(v0[0], v0[1]); w.y = pk2_(v0[2], v0[3]); w.z = pk2_(v1[0], v1[1]); w.w = pk2_(v1[2], v1[3]);
                        u32x4 e; e.x = pk2_(v0[0] - bflo_(w.x), v0[1] - bfhi_(w.x)); e.y = pk2_(v0[2] - bflo_(w.y), v0[3] - bfhi_(w.y)); e.z = pk2_(v1[0] - bflo_(w.z), v1[1] - bfhi_(w.z)); e.w = pk2_(v1[2] - bflo_(w.w), v1[3] - bfhi_(w.w));
                        *(u32x4*)(Hout + xoff) = w; *(u32x4*)(Lout + xoff) = e;
                        q += (v0[0] * v0[0] + v0[1] * v0[1]) + (v0[2] * v0[2] + v0[3] * v0[3]) + (v1[0] * v1[0] + v1[1] * v1[1]) + (v1[2] * v1[2] + v1[3] * v1[3]); } }
                if (!OUT_F32) { q += __shfl_xor(q, 16); q += __shfl_xor(q, 32);
                    if (fq == 0) P[(ai * HALF + wr * 64 + m * 16 + fr) * 4 + wc] = q; } }
            asm volatile("" ::: "memory"); }
        if (OUT_F32) return;
        asm volatile("s_waitcnt lgkmcnt(0)" ::: "memory"); __builtin_amdgcn_s_barrier(); asm volatile("" ::: "memory");
        if (lane < 32) { const int row = wid * 32 + lane; const f32x4 pv = *(const PG8_LAS f32x4*)(P + row * 4);
            ss[(unsigned)(u.pm * BM + row) * 4u + (unsigned)u.pn] = (pv[0] + pv[1]) + (pv[2] + pv[3]); }
    }
};
struct EpiSwiglu {
    static constexpr bool PERM = true, AFTER_DRAIN = false;
    bf16_t* H; const float* ss;
    __device__ __forceinline__ void operator()(const f32x4 (&acc)[2][2][4][2], const Unit& u, int wr, int wc, int fr, int fq) const {
        const int row0 = u.pm * BM + wr * 64 + fr, col0 = u.pn * HALF + wc * 32 + 8 * fq;
        float rs[8]; rstd8(ss, row0, rs);
#pragma unroll
        for (int ai = 0; ai < 2; ++ai) { if (u.half == 2 - ai) continue;
#pragma unroll
            for (int m = 0; m < 4; ++m) { const int row = row0 + ai * HALF + m * 16; const float r_ = rs[ai * 4 + m];
                float h[8];
#pragma unroll
                for (int n = 0; n < 2; ++n)
#pragma unroll
                    for (int i = 0; i < 4; ++i) { const float g = acc[ai][0][m][n][i] * r_, uu = acc[ai][1][m][n][i] * r_; h[4 * n + i] = g * sigmoidf_(g) * uu; }
                u32x4 w; w.x = pk2_(h[0], h[1]); w.y = pk2_(h[2], h[3]); w.z = pk2_(h[4], h[5]); w.w = pk2_(h[6], h[7]);
                *(u32x4*)(H + ((unsigned)row * 2816u + (unsigned)col0)) = w; } }
    }
};
struct EpiProbe {
    static constexpr bool PERM = true, AFTER_DRAIN = false;
    float* sink; int flag;
    __device__ __forceinline__ void operator()(const f32x4 (&acc)[2][2][4][2], const Unit& u, int wr, int wc, int fr, int fq) const {
        if (flag) {
#pragma unroll
            for (int ai = 0; ai < 2; ++ai)
#pragma unroll
                for (int bj = 0; bj < 2; ++bj)
#pragma unroll
                    for (int m = 0; m < 4; ++m)
#pragma unroll
                        for (int n = 0; n < 2; ++n) *(f32x4*)(sink + (((u.pm * 4 + u.pn) * 512 + wr * 256 + wc * 64 + fq * 16 + fr) * 16 + ai * 8 + bj * 4 + m) * 8 + n * 4) = acc[ai][bj][m][n]; }
    }
};
template <class Epi, class Sched, bool ALIGN_EPI = false, bool SP2 = false>
__device__ __forceinline__ void gemm_phase(PG8_LAS unsigned char* lds, const Gemm g, const Sched& S, const Epi& E, const int tid) {
    const int wid = __builtin_amdgcn_readfirstlane(tid >> 6), lane = tid & 63, wr = wid >> 2, wc = wid & 3, fr = lane & 15, fq = lane >> 4;
    const int K = g.K, nt = K / BK, lda = g.lda ? g.lda : g.K;
    unsigned voffA[2], voffB[2];
#pragma unroll
    for (int i = 0; i < 2; ++i) { int R, C; stage_rc(tid * 16 + i * 8192, R, C); const int Rb = Epi::PERM ? ((R & ~31) + perm32(R & 31)) : R;
        voffA[i] = (unsigned)(R * lda + C) * 2u; voffB[i] = (unsigned)(Rb * K + C) * 2u; }
    const size_t kstep = (size_t)(BK * 2);
    const size_t hstep = (size_t)HALF * K * 2;
    const size_t tstep = 2 * hstep;
    const size_t hstepA = (size_t)HALF * lda * 2, tstepA = 2 * hstepA;
    const unsigned ldsw = (unsigned)wid * 1024u;
    const int aoff = lds_byte(wr * 64 + fr, fq * 8), boff = lds_byte(wc * 32 + fr, fq * 8);
#define PG8_SA(b, h) (((b) * 2 + (h)) * HTB)
#define PG8_SB(b, h) ((4 + (b) * 2 + (h)) * HTB)
#define PG8_STAGE(bufoff, gbase, voff) do { _Pragma("unroll") for (int _i = 0; _i < 2; ++_i) \
        __builtin_amdgcn_global_load_lds((const unsigned*)((const char*)(gbase) + (voff)[_i]), (PG8_LAS unsigned*)(lds + (bufoff) + ldsw + _i * 8192), 16, 0, 0); } while (0)
#define PG8_LDA(dst, b, h) do { _Pragma("unroll") for (int m = 0; m < 4; ++m) _Pragma("unroll") for (int k = 0; k < 2; ++k) dst[m][k] = *(const PG8_LAS bf16x8*)(lds + PG8_SA(b, h) + aoff + m * 2048 + k * 1024); } while (0)
#define PG8_LDB(dst, b, h) do { _Pragma("unroll") for (int n = 0; n < 2; ++n) _Pragma("unroll") for (int k = 0; k < 2; ++k) dst[n][k] = *(const PG8_LAS bf16x8*)(lds + PG8_SB(b, h) + boff + n * 2048 + k * 1024); } while (0)
#define PG8_MMA(ai, bj, At, Bt) do { __builtin_amdgcn_s_setprio(1); _Pragma("unroll") for (int m = 0; m < 4; ++m) _Pragma("unroll") for (int n = 0; n < 2; ++n) _Pragma("unroll") for (int k = 0; k < 2; ++k) \
        acc[ai][bj][m][n] = __builtin_amdgcn_mfma_f32_16x16x32_bf16(Bt[n][k], At[m][k], acc[ai][bj][m][n], 0, 0, 0); __builtin_amdgcn_s_setprio(0); } while (0)
#define PG8_WAIT_V(n) asm volatile("s_waitcnt vmcnt(" #n ")" ::: "memory")
#define PG8_WAIT_L(n) asm volatile("s_waitcnt lgkmcnt(" #n ")" ::: "memory")
#define PG8_BAR __builtin_amdgcn_s_barrier()
#define PG8_SCHED __builtin_amdgcn_sched_barrier(0)
    Unit cur, nxt; int ui = 0;
    if (!S.next(0, cur)) return;
    f32x4 acc[2][2][4][2];
#pragma unroll
    for (int a = 0; a < 2; ++a)
#pragma unroll
        for (int b = 0; b < 2; ++b)
#pragma unroll
            for (int m = 0; m < 4; ++m)
#pragma unroll
                for (int n = 0; n < 2; ++n) acc[a][b][m][n] = (f32x4){0.f, 0.f, 0.f, 0.f};
    bf16x8 At[4][2], B0[2][2], B1[2][2];
    const char* cA = (const char*)g.A + (size_t)cur.pm * tstepA; const char* cB = (const char*)g.Bt + (size_t)cur.pn * tstep;
    S.a_ready(cur);
    if constexpr (SP2) {
        PG8_STAGE(PG8_SB(0, 0), cB, voffB); PG8_STAGE(PG8_SB(0, 1), cB + hstep, voffB); PG8_STAGE(PG8_SA(0, 0), cA, voffA); PG8_STAGE(PG8_SA(0, 1), cA + hstepA, voffA);
        if (wr == 1) PG8_BAR;
        PG8_WAIT_V(2); PG8_BAR;
        PG8_STAGE(PG8_SB(1, 0), cB + kstep, voffB); PG8_STAGE(PG8_SA(1, 0), cA + kstep, voffA); PG8_STAGE(PG8_SB(1, 1), cB + hstep + kstep, voffB);
        PG8_WAIT_V(6); PG8_BAR;
    } else {
        PG8_STAGE(PG8_SB(0, 0), cB, voffB); PG8_STAGE(PG8_SA(0, 0), cA, voffA); PG8_STAGE(PG8_SB(0, 1), cB + hstep, voffB); PG8_STAGE(PG8_SA(0, 1), cA + hstepA, voffA);
        if (wr == 1) PG8_BAR;
        PG8_WAIT_V(4); PG8_BAR;
        PG8_STAGE(PG8_SB(1, 0), cB + kstep, voffB); PG8_STAGE(PG8_SA(1, 0), cA + kstep, voffA); PG8_STAGE(PG8_SB(1, 1), cB + hstep + kstep, voffB);
        PG8_WAIT_V(6); PG8_BAR;
    }
    for (;;) {
        const bool has_next = S.next(ui + 1, nxt);
        const char* nA = has_next ? (const char*)g.A + (size_t)nxt.pm * tstepA : cA; const char* nB = has_next ? (const char*)g.Bt + (size_t)nxt.pn * tstep : cB;
        for (int t = 0; t < nt; t += 2) {
            const bool last = (t == nt - 2);
            const char* a1 = cA + (size_t)(t + 1) * kstep;
            const char* a2 = last ? nA : cA + (size_t)(t + 2) * kstep; const char* b2 = last ? nB : cB + (size_t)(t + 2) * kstep;
            const char* a3 = a2 + kstep; const char* b3 = b2 + kstep;
            if (last && has_next) S.a_ready(nxt);
            if constexpr (SP2) {
            PG8_LDB(B0, 0, 0); PG8_LDB(B1, 0, 1); PG8_SCHED; PG8_LDA(At, 0, 0); PG8_STAGE(PG8_SA(1, 1), a1 + hstepA, voffA);
            PG8_WAIT_V(8); PG8_WAIT_L(0); PG8_BAR; if (!Sched::HALVES || cur.half != 2) { PG8_MMA(0, 0, At, B0); PG8_MMA(0, 1, At, B1); } PG8_BAR; PG8_SCHED;
            PG8_LDA(At, 0, 1); PG8_STAGE(PG8_SB(0, 0), b2, voffB); PG8_STAGE(PG8_SB(0, 1), b2 + hstep, voffB); PG8_STAGE(PG8_SA(0, 0), a2, voffA);
            PG8_WAIT_V(8); PG8_WAIT_L(0); PG8_BAR; if (!Sched::HALVES || cur.half != 1) { PG8_MMA(1, 0, At, B0); PG8_MMA(1, 1, At, B1); } PG8_BAR; PG8_SCHED;
            PG8_LDB(B0, 1, 0); PG8_LDB(B1, 1, 1); PG8_SCHED; PG8_LDA(At, 1, 0); PG8_STAGE(PG8_SA(0, 1), a2 + hstepA, voffA);
            PG8_WAIT_V(8); PG8_WAIT_L(0); PG8_BAR; if (!Sched::HALVES || cur.half != 2) { PG8_MMA(0, 0, At, B0); PG8_MMA(0, 1, At, B1); } PG8_BAR; PG8_SCHED;
            PG8_LDA(At, 1, 1); PG8_STAGE(PG8_SB(1, 0), b3, voffB); PG8_STAGE(PG8_SB(1, 1), b3 + hstep, voffB); PG8_STAGE(PG8_SA(1, 0), a3, voffA);
            PG8_WAIT_V(8); PG8_WAIT_L(0); PG8_BAR; if (!Sched::HALVES || cur.half != 1) { PG8_MMA(1, 0, At, B0); PG8_MMA(1, 1, At, B1); } PG8_BAR; PG8_SCHED;
            } else {
            PG8_LDB(B0, 0, 0); PG8_SCHED; PG8_LDA(At, 0, 0); PG8_STAGE(PG8_SA(1, 1), a1 + hstepA, voffA);
            PG8_WAIT_L(8); PG8_BAR; PG8_WAIT_L(0); PG8_MMA(0, 0, At, B0); PG8_BAR; PG8_SCHED;
            PG8_LDB(B1, 0, 1); PG8_STAGE(PG8_SB(0, 0), b2, voffB);
            PG8_BAR; PG8_WAIT_L(0); PG8_MMA(0, 1, At, B1); PG8_BAR;
            PG8_LDA(At, 0, 1); PG8_STAGE(PG8_SA(0, 0), a2, voffA);
            PG8_BAR; PG8_WAIT_L(0); PG8_MMA(1, 0, At, B0); PG8_BAR; PG8_SCHED;
            PG8_STAGE(PG8_SB(0, 1), b2 + hstep, voffB);
            PG8_WAIT_V(6); PG8_BAR; PG8_MMA(1, 1, At, B1); PG8_BAR;
            PG8_LDB(B0, 1, 0); PG8_SCHED; PG8_LDA(At, 1, 0); PG8_STAGE(PG8_SA(0, 1), a2 + hstepA, voffA);
            PG8_WAIT_L(8); PG8_BAR; PG8_WAIT_L(0); PG8_MMA(0, 0, At, B0); PG8_BAR; PG8_SCHED;
            PG8_LDB(B1, 1, 1); PG8_STAGE(PG8_SB(1, 0), b3, voffB);
            PG8_BAR; PG8_WAIT_L(0); PG8_MMA(0, 1, At, B1); PG8_BAR;
            PG8_LDA(At, 1, 1); PG8_STAGE(PG8_SA(1, 0), a3, voffA);
            PG8_BAR; PG8_WAIT_L(0); PG8_MMA(1, 0, At, B0); PG8_BAR; PG8_SCHED;
            PG8_STAGE(PG8_SB(1, 1), b3 + hstep, voffB);
            PG8_WAIT_V(6); PG8_BAR; PG8_MMA(1, 1, At, B1); PG8_BAR;
            }
        }
        if constexpr (ALIGN_EPI) { if (wr == 0) PG8_BAR; }
        if constexpr (!Epi::AFTER_DRAIN) { E(acc, cur, wr, wc, fr, fq); S.done(cur); }
        if (!has_next) break;
#pragma unroll
        for (int a = 0; a < 2; ++a)
#pragma unroll
            for (int b = 0; b < 2; ++b)
#pragma unroll
                for (int m = 0; m < 4; ++m)
#pragma unroll
                    for (int n = 0; n < 2; ++n) acc[a][b][m][n] = (f32x4){0.f, 0.f, 0.f, 0.f};
        cur = nxt; cA = nA; cB = nB; ++ui;
        if constexpr (ALIGN_EPI) { if (wr == 1) PG8_BAR; }
    }
    PG8_WAIT_V(0);
    if constexpr (!ALIGN_EPI) { if (wr == 0) PG8_BAR; }
    PG8_BAR;
    if constexpr (Epi::AFTER_DRAIN) { E.fused(acc, cur, wr, wc, fr, fq, lds, wid, lane); S.done(cur); }
}
template <class Sched>
__device__ __forceinline__ void gemm_phase_seg(PG8_LAS unsigned char* lds, const bf16_t* A0, const bf16_t* A1, const bf16_t* A2, const bf16_t* Bt0, const bf16_t* gates, bf16_t* T, const Sched& S, const int tid) {
    const int wid = __builtin_amdgcn_readfirstlane(tid >> 6), lane = tid & 63, wr = wid >> 2, wc = wid & 3, fr = lane & 15, fq = lane >> 4;
    constexpr int K = 256, nt = 12;
    unsigned voffA[2], voffB[2];
#pragma unroll
    for (int i = 0; i < 2; ++i) { int R, C; stage_rc(tid * 16 + i * 8192, R, C); const int Rb = (R & ~31) + perm32(R & 31);
        voffA[i] = (unsigned)(R * K + C) * 2u; voffB[i] = (unsigned)(Rb * K + C) * 2u; }
    const size_t kstep = (size_t)(BK * 2), hstep = (size_t)HALF * K * 2, tstep = 2 * hstep, tstepA = hstep, hstepA = 0, sstepB = (size_t)1024 * K * 2;
    const unsigned ldsw = (unsigned)wid * 1024u;
    const int aoff = lds_byte(wr * 64 + fr, fq * 8), boff = lds_byte(wc * 32 + fr, fq * 8);
#define PG8_SEGA(off, t) ((const char*)((t) < 4 ? A0 : (t) < 8 ? A1 : A2) + (off) + (size_t)((t) & 3) * kstep)
#define PG8_SEGB(off, t) ((const char*)Bt0 + (size_t)((t) >> 2) * sstepB + (off) + (size_t)((t) & 3) * kstep)
    Unit cur, nxt; int ui = 0;
    if (!S.next(0, cur)) return;
    f32x4 acc[2][2][4][2];
#pragma unroll
    for (int a = 0; a < 2; ++a)
#pragma unroll
        for (int b = 0; b < 2; ++b)
#pragma unroll
            for (int m = 0; m < 4; ++m)
#pragma unroll
                for (int n = 0; n < 2; ++n) acc[a][b][m][n] = (f32x4){0.f, 0.f, 0.f, 0.f};
    bf16x8 At[4][2], B0[2][2], B1[2][2];
    size_t cAo = (size_t)cur.pm * tstepA, cBo = (size_t)cur.pn * tstep;
    { const char* cA = PG8_SEGA(cAo, 0); const char* cB = PG8_SEGB(cBo, 0);
      PG8_STAGE(PG8_SB(0, 0), cB, voffB); PG8_STAGE(PG8_SB(0, 1), cB + hstep, voffB); PG8_STAGE(PG8_SA(0, 0), cA, voffA); PG8_STAGE(PG8_SA(0, 1), cA + hstepA, voffA);
      if (wr == 1) PG8_BAR;
      PG8_WAIT_V(2); PG8_BAR;
      PG8_STAGE(PG8_SB(1, 0), cB + kstep, voffB); PG8_STAGE(PG8_SA(1, 0), cA + kstep, voffA); PG8_STAGE(PG8_SB(1, 1), cB + hstep + kstep, voffB);
      PG8_WAIT_V(6); PG8_BAR; }
    for (;;) {
        const bool has_next = S.next(ui + 1, nxt);
        const size_t nAo = has_next ? (size_t)nxt.pm * tstepA : cAo, nBo = has_next ? (size_t)nxt.pn * tstep : cBo;
        for (int t = 0; t < nt; t += 2) {
            const bool last = (t == nt - 2);
            const char* a1 = PG8_SEGA(cAo, t + 1);
            const char* a2 = last ? PG8_SEGA(nAo, 0) : PG8_SEGA(cAo, t + 2); const char* b2 = last ? PG8_SEGB(nBo, 0) : PG8_SEGB(cBo, t + 2);
            const char* a3 = a2 + kstep; const char* b3 = b2 + kstep;
            PG8_LDB(B0, 0, 0); PG8_LDB(B1, 0, 1); PG8_SCHED; PG8_LDA(At, 0, 0); PG8_STAGE(PG8_SA(1, 1), a1 + hstepA, voffA);
            PG8_WAIT_V(8); PG8_WAIT_L(0); PG8_BAR; PG8_MMA(0, 0, At, B0); PG8_MMA(0, 1, At, B1); PG8_BAR; PG8_SCHED;
            PG8_STAGE(PG8_SB(0, 0), b2, voffB); PG8_STAGE(PG8_SB(0, 1), b2 + hstep, voffB); PG8_STAGE(PG8_SA(0, 0), a2, voffA);
            PG8_WAIT_V(8); PG8_WAIT_L(0); PG8_BAR; PG8_BAR; PG8_SCHED;
            PG8_LDB(B0, 1, 0); PG8_LDB(B1, 1, 1); PG8_SCHED; PG8_LDA(At, 1, 0); PG8_STAGE(PG8_SA(0, 1), a2 + hstepA, voffA);
            PG8_WAIT_V(8); PG8_WAIT_L(0); PG8_BAR; PG8_MMA(0, 0, At, B0); PG8_MMA(0, 1, At, B1); PG8_BAR; PG8_SCHED;
            PG8_STAGE(PG8_SB(1, 0), b3, voffB); PG8_STAGE(PG8_SB(1, 1), b3 + hstep, voffB); PG8_STAGE(PG8_SA(1, 0), a3, voffA);
            PG8_WAIT_V(8); PG8_WAIT_L(0); PG8_BAR; PG8_BAR; PG8_SCHED;
            if ((t & 3) == 2) {
                const int seg = t >> 2; unsigned row0 = (unsigned)(cur.pm * HALF + wr * 64 + fr), col0 = (unsigned)(cur.pn * BM + wc * 32 + 8 * fq); asm volatile("" : "+v"(row0), "+v"(col0));
#pragma unroll
                for (int bj = 0; bj < 2; ++bj) { u32x4 gg[4];
#pragma unroll
                    for (int m = 0; m < 4; ++m) gg[m] = *(const u32x4*)(gates + ((row0 + m * 16) * 3072u + ((unsigned)(seg * 1024 + bj * HALF) + col0)));
#pragma unroll
                    for (int m = 0; m < 4; ++m) { const u32x4 g_ = gg[m]; f32x4 a0 = acc[0][bj][m][0], a1 = acc[0][bj][m][1], t0 = acc[1][bj][m][0], t1 = acc[1][bj][m][1];
                        { float q0 = t0[0], q1 = t0[1], q2 = t0[2], q3 = t0[3], q4 = t1[0], q5 = t1[1], q6 = t1[2], q7 = t1[3];
#define PG8_FMAC(t, g, a) asm("v_fmac_f32 %0, %1, %2" : "+v"(t) : "v"(g), "v"(a))
                          PG8_FMAC(q0, bflo_(g_.x), a0[0]); PG8_FMAC(q1, bfhi_(g_.x), a0[1]); PG8_FMAC(q2, bflo_(g_.y), a0[2]); PG8_FMAC(q3, bfhi_(g_.y), a0[3]);
                          PG8_FMAC(q4, bflo_(g_.z), a1[0]); PG8_FMAC(q5, bfhi_(g_.z), a1[1]); PG8_FMAC(q6, bflo_(g_.w), a1[2]); PG8_FMAC(q7, bfhi_(g_.w), a1[3]);
#undef PG8_FMAC
                          t0 = (f32x4){q0, q1, q2, q3}; t1 = (f32x4){q4, q5, q6, q7}; }
                        acc[1][bj][m][0] = t0; acc[1][bj][m][1] = t1; acc[0][bj][m][0] = (f32x4){0.f, 0.f, 0.f, 0.f}; acc[0][bj][m][1] = (f32x4){0.f, 0.f, 0.f, 0.f};
                        if (seg == 2) { u32x4 w; w.x = pk2_(t0[0], t0[1]); w.y = pk2_(t0[2], t0[3]); w.z = pk2_(t1[0], t1[1]); w.w = pk2_(t1[2], t1[3]);
                            *(u32x4*)(T + ((row0 + m * 16) * 1024u + (col0 + bj * HALF))) = w; } }
                    asm volatile("" ::: "memory"); }
            }
        }
        if (wr == 0) PG8_BAR;
        if (!has_next) break;
#pragma unroll
        for (int b = 0; b < 2; ++b)
#pragma unroll
            for (int m = 0; m < 4; ++m)
#pragma unroll
                for (int n = 0; n < 2; ++n) acc[1][b][m][n] = (f32x4){0.f, 0.f, 0.f, 0.f};
        cur = nxt; cAo = nAo; cBo = nBo; ++ui;
        if (wr == 1) PG8_BAR;
    }
    PG8_WAIT_V(0);
    PG8_BAR;
#undef PG8_SEGA
#undef PG8_SEGB
#undef PG8_SA
#undef PG8_SB
#undef PG8_STAGE
#undef PG8_LDA
#undef PG8_LDB
#undef PG8_MMA
#undef PG8_WAIT_V
#undef PG8_WAIT_L
#undef PG8_BAR
#undef PG8_SCHED
}
}
#ifndef PG8_SP2
#define PG8_SP2 true
#endif
#ifndef PG8_ALIGN
#define PG8_ALIGN true
#endif
constexpr int NWAVES = 8;
constexpr int BATCH = 2, SEQ = 8192, D = 1024, M = BATCH * SEQ, DEPTH = 2;
constexpr int IN_COLS = 5892, NMIX = 3072, MIXLD = 2816, NGATE = 3072, DFF = 2816, NGU = 2 * DFF;
constexpr int C_RETQ = 0, C_RETK = 256, C_RETV = 512, C_RETG = 768, C_FOXQ = 1024, C_FOXK = 1280, C_FOXV = 1536, C_RW = 1792;
constexpr size_t MiB = 1u << 20;
constexpr size_t WS_CTL = 0, CTL_ZERO_BYTES = 64 * 1024;
constexpr size_t WS_WIN = 1 * MiB, WS_WGATE = 7 * MiB, WS_PBR = 13 * MiB, WS_WOUT = 14 * MiB + 512 * 1024, WS_WGU = 16 * MiB + 512 * 1024, WS_WDOWN = 27 * MiB + 512 * 1024;
constexpr size_t WS_XB = 33 * MiB;
constexpr size_t WS_RB = 65 * MiB;
constexpr size_t WS_BIG = 97 * MiB;
constexpr size_t WS_SW = 193 * MiB, WS_REC = 209 * MiB, WS_SA = 225 * MiB;
constexpr size_t WS_TT = 241 * MiB;
constexpr size_t WS_YL = WS_RB;
constexpr size_t WS_LS = WS_RB + 16 * MiB;
constexpr size_t WS_U = WS_BIG + 88 * MiB;
constexpr size_t WS_BS = 251 * MiB + 512 * 1024;
constexpr size_t WS_XLO = WS_SW;
constexpr size_t WS_SIN = WS_SW;
constexpr size_t WS_FO0 = WS_SA + 4 * MiB;
constexpr size_t WS_FL0 = WS_SA + 12 * MiB, WS_FL1 = WS_SA + 12 * MiB + 512 * 1024;
constexpr size_t WS_RP = 1 * MiB;
constexpr size_t WS_SEGT = 254 * MiB + 512 * 1024;
constexpr size_t WS_G2T = 254 * MiB;
constexpr size_t WS_YR = WS_REC, WS_YF = WS_REC + 8 * MiB, WS_YW = WS_TT;
constexpr size_t WS_SS1 = 249 * MiB, WS_SS2 = 250 * MiB;
constexpr size_t WS_FLOG = 251 * MiB, WS_CUM = 251 * MiB + 256 * 1024;
constexpr size_t WS_ROPE = 252 * MiB;
constexpr size_t WS_END = 256 * MiB;
constexpr int CW_TMO = 0, CW_CODE = 1, CW_BAR = 4096, CW_QUEUE = 8192;
constexpr int RING_OFF = 0, RING_BYTES = 131072;
constexpr int LDSCTL_OFF = RING_BYTES, MISC_OFF = LDSCTL_OFF + 320;
constexpr int LDS_BYTES = 147456;
#define GAS __attribute__((address_space(1)))
#define LAS __attribute__((address_space(3)))
typedef unsigned short bf16;
typedef unsigned v4u __attribute__((ext_vector_type(4)));
typedef float f32x4 __attribute__((ext_vector_type(4)));
typedef short bf16x8 __attribute__((ext_vector_type(8)));
typedef GAS unsigned gu32;
typedef GAS unsigned long long gu64;
#define RLX_AGENT __ATOMIC_RELAXED, __HIP_MEMORY_SCOPE_AGENT
#define LDS_WAIT() asm volatile("s_waitcnt lgkmcnt(0)" ::: "memory")
#define VM_WAIT() asm volatile("s_waitcnt vmcnt(0)" ::: "memory")
__device__ __forceinline__ unsigned long long rt() { return __builtin_amdgcn_s_memrealtime(); }
typedef float f32x2h __attribute__((ext_vector_type(2))); typedef __bf16 bf16x2h __attribute__((ext_vector_type(2)));
__device__ __forceinline__ unsigned f2bf(float f) { const f32x2h v = {f, f}; return __builtin_bit_cast(unsigned, __builtin_convertvector(v, bf16x2h)) & 0xffffu; }
typedef float f32x2g __attribute__((ext_vector_type(2))); typedef __bf16 bf16x2g __attribute__((ext_vector_type(2)));
__device__ __forceinline__ unsigned pk2(float lo, float hi) { const f32x2g v = {lo, hi}; return __builtin_bit_cast(unsigned, __builtin_convertvector(v, bf16x2g)); }

#define XB_TMO      128
#define XB_XCNT(j)  (256  + 64 * (j))
#define XB_XSUB(j)  (1280 + 64 * (j))
#define XB_XGEN(j)  (2304 + 64 * (j))
#define XB_TOP      3328
#define XB_TOPGEN   3392
#define XCD_BAR_WORDS 3456
#define XB_SPIN_CAP (1u << 18)

__device__ __forceinline__ unsigned xb_ld(unsigned* p)              { return __hip_atomic_load(p, __ATOMIC_RELAXED, __HIP_MEMORY_SCOPE_AGENT); }
__device__ __forceinline__ unsigned xb_add(unsigned* p, unsigned v) { return __hip_atomic_fetch_add(p, v, __ATOMIC_RELAXED, __HIP_MEMORY_SCOPE_AGENT); }
__device__ __forceinline__ unsigned xb_xcc_id() { return (unsigned)__builtin_amdgcn_s_getreg((3 << 11) | 20) & 0xFu; }
#define XB_SPIN(cond, bar) do { unsigned _sp = 0; while (cond) { __builtin_amdgcn_s_sleep(1); \
    if ((++_sp & 255u) == 0u) { if (xb_ld(&(bar)[XB_TMO])) break; if (_sp > XB_SPIN_CAP) { atomicAdd(&(bar)[XB_TMO], 1u); break; } } } } while (0)

struct XcdBarrier {
    unsigned* bar; unsigned x;
    volatile LAS unsigned* st;
};

__device__ __forceinline__ XcdBarrier xcd_barrier_post(unsigned* bar, volatile LAS unsigned* st) {
    XcdBarrier b; b.bar = bar; b.x = xb_xcc_id(); b.st = st;
    if (threadIdx.x == 0) (void)xb_add(&bar[XB_XCNT(b.x)], 1u);
    return b;
}
__device__ __forceinline__ void xcd_barrier_complete(unsigned* bar, unsigned x, unsigned& nloc, unsigned& nx) {
    const unsigned G = gridDim.x * gridDim.y * gridDim.z;
    unsigned sum, cnt, mine, sp = 0u;
    for (;;) {
        sum = 0u; cnt = 0u; mine = 0u;
#pragma unroll
        for (unsigned j = 0; j < 16; ++j) { const unsigned c = xb_ld(&bar[XB_XCNT(j)]); sum += c; cnt += (c > 0u) ? 1u : 0u; mine = (j == x) ? c : mine; }
        if (sum == G) break;
        __builtin_amdgcn_s_sleep(1);
        if ((++sp & 255u) == 0u) { if (xb_ld(&bar[XB_TMO])) break; if (sp > XB_SPIN_CAP) { atomicAdd(&bar[XB_TMO], 1u); break; } }
    }
    nloc = mine > 0u ? mine : 1u; nx = cnt > 0u ? cnt : 1u;
}

__device__ __forceinline__ void xcd_barrier(const XcdBarrier& b, const bool leader_thread) {
    asm volatile("s_waitcnt vmcnt(0)" ::: "memory");
    __syncthreads();
    if (leader_thread) {
        unsigned* bar = b.bar; asm volatile("" : "+s"(bar));
        __builtin_amdgcn_s_waitcnt(0);
        unsigned nloc = b.st[0], nx = b.st[1];
        if (nloc == 0u) { xcd_barrier_complete(bar, b.x, nloc, nx); b.st[0] = nloc; b.st[1] = nx; }
        const unsigned old = xb_add(&bar[XB_XSUB(b.x)], 1u);
        const unsigned gen = old / nloc;
        if (old + 1u == (gen + 1u) * nloc) {
            __builtin_amdgcn_fence(__ATOMIC_RELEASE, "agent");
            asm volatile("s_waitcnt vmcnt(0)" ::: "memory");
            const unsigned og = xb_add(&bar[XB_TOP], 1u);
            const unsigned tg = og / nx;
            if (og + 1u == (tg + 1u) * nx) xb_add(&bar[XB_TOPGEN], 1u);
            else XB_SPIN(xb_ld(&bar[XB_TOPGEN]) == tg, bar);
            __builtin_amdgcn_fence(__ATOMIC_ACQUIRE, "agent");
            xb_add(&bar[XB_XGEN(b.x)], 1u);
            asm volatile("s_waitcnt vmcnt(0)" ::: "memory");
        } else {
            XB_SPIN(xb_ld(&bar[XB_XGEN(b.x)]) == gen, bar);
            __builtin_amdgcn_fence(__ATOMIC_ACQUIRE, "agent");
            asm volatile("s_waitcnt vmcnt(0)" ::: "memory");
        }
    }
    __syncthreads();
}
#include <hip/hip_bf16.h>
#include <cmath>
namespace attn_body {
using bf16=__hip_bfloat16;
using bf16x8=__attribute__((ext_vector_type(8)))short;
using s16x4=__attribute__((ext_vector_type(4)))short;
using f32x16=__attribute__((ext_vector_type(16)))float;
using u32x4=__attribute__((ext_vector_type(4)))unsigned;
using f32x4v=__attribute__((ext_vector_type(4)))float;
constexpr int BATCH=2,NHEAD=4,SEQ=8192,D=64,DM=2816,OP=256;
constexpr int NW=8,QBLK=32,QB=QBLK*NW,KVBLK=64,NQB=SEQ/QB;
constexpr int ATTN_PITCH=DM, ATTN_UNIT_ROWS=QB;
__device__ __forceinline__ int crow(int r,int hi){return (r&3)+8*(r>>2)+4*hi;}
#define SBAR() __builtin_amdgcn_sched_barrier(0)
__device__ __forceinline__ void cmask(f32x16&p0,f32x16&p1,int jb,int qrel,int hi){
  const float NEG=-INFINITY; int kb=64*jb+4*hi;
  #pragma unroll
  for(int r=0;r<16;++r){int kv=kb+(r&3)+8*(r>>2); if(kv>qrel)p0[r]=NEG; if(kv+32>qrel)p1[r]=NEG;}
}

constexpr int NSLOT=3, SLOTB=8192;
constexpr int LDS_K=0, LDS_V=NSLOT*SLOTB, LDS_WS=2*NSLOT*SLOTB, LDS_OST=LDS_WS+NW*64*4, LDS_BIAS=LDS_OST+NW*4096, LDS_BYTES=LDS_BIAS+SEQ*4;
constexpr float C2=0.125f*1.4426950408889634f;
__device__ __forceinline__ void glds16(const void*gsrc,unsigned lds_dst){unsigned keep;
  asm volatile("s_mov_b32 %0, m0\n\ts_mov_b32 m0, %2\n\ts_nop 0\n\tglobal_load_lds_dwordx4 %1, off\n\ts_mov_b32 m0, %0":"=&s"(keep):"v"(gsrc),"s"(lds_dst):"memory");}
__device__ __forceinline__ float max3f(float a,float b,float c){float r;asm("v_max3_f32 %0, %1, %2, %3":"=v"(r):"v"(a),"v"(b),"v"(c));return r;}
__device__ __forceinline__ float max2f(float a,float b){float r;asm("v_max_f32_e32 %0, %1, %2":"=v"(r):"v"(a),"v"(b));return r;}
__device__ __forceinline__ float fadd_s(float a,float b){float r;asm("v_add_f32_e32 %0, %1, %2":"=v"(r):"v"(a),"v"(b));return r;}
__device__ __forceinline__ float fsub_s(float a,float b){float r;asm("v_sub_f32_e32 %0, %1, %2":"=v"(r):"v"(a),"v"(b));return r;}
typedef float f32x2_t __attribute__((ext_vector_type(2))); typedef __bf16 bf16x2_t __attribute__((ext_vector_type(2)));
__device__ __forceinline__ unsigned cvtpk_s(float lo,float hi){f32x2_t v={lo,hi};bf16x2_t b=__builtin_convertvector(v,bf16x2_t);return __builtin_bit_cast(unsigned,b);}
#define WAIT_BAR(N) asm volatile("s_waitcnt vmcnt(" #N ") lgkmcnt(0)\n\ts_barrier":::"memory")

__device__ __forceinline__ void qkt(f32x16&p0,f32x16&p1,const char*Kslot,const bf16x8*qr,int r32,int hi){
  const char*kb=Kslot+hi*1024+r32*16;
  #pragma unroll
  for(int d0=0;d0<4;++d0){
    const bf16x8 b0=*reinterpret_cast<const bf16x8*>(kb+d0*2048);
    const bf16x8 b1=*reinterpret_cast<const bf16x8*>(kb+d0*2048+512);
    p0=__builtin_amdgcn_mfma_f32_32x32x16_bf16(b0,qr[d0],p0,0,0,0);p1=__builtin_amdgcn_mfma_f32_32x32x16_bf16(b1,qr[d0],p1,0,0,0);}
}
typedef __attribute__((address_space(3))) const char* lds_cptr;
typedef short v4i16_t __attribute__((ext_vector_type(4)));
__device__ __forceinline__ void kload8(bf16x8*kf,lds_cptr kp){
  kf[0]=*(const __attribute__((address_space(3))) bf16x8*)(kp);      kf[1]=*(const __attribute__((address_space(3))) bf16x8*)(kp+512);
  kf[2]=*(const __attribute__((address_space(3))) bf16x8*)(kp+2048); kf[3]=*(const __attribute__((address_space(3))) bf16x8*)(kp+2560);
  kf[4]=*(const __attribute__((address_space(3))) bf16x8*)(kp+4096); kf[5]=*(const __attribute__((address_space(3))) bf16x8*)(kp+4608);
  kf[6]=*(const __attribute__((address_space(3))) bf16x8*)(kp+6144); kf[7]=*(const __attribute__((address_space(3))) bf16x8*)(kp+6656);
}
__device__ __forceinline__ void kload2(bf16x8*kf,lds_cptr kp,int j){ kf[2*j]=*(const __attribute__((address_space(3))) bf16x8*)(kp+j*2048); kf[2*j+1]=*(const __attribute__((address_space(3))) bf16x8*)(kp+j*2048+512); }
__device__ __forceinline__ s16x4 vtr(lds_cptr p){ return __builtin_bit_cast(s16x4,__builtin_amdgcn_ds_read_tr16_b64_v4i16((__attribute__((address_space(3))) v4i16_t*)p)); }
__device__ __forceinline__ float rowmax(const f32x16&p0,const f32x16&p1){
  float a=max3f(p0[0],p0[1],p1[0]),b=max3f(p0[2],p0[3],p1[1]);a=max3f(a,p1[2],p1[3]);
  #pragma unroll
  for(int r=4;r<16;r+=4){a=max3f(a,p0[r],p0[r+1]);b=max3f(b,p0[r+2],p0[r+3]);a=max3f(a,p1[r],p1[r+1]);b=max3f(b,p1[r+2],p1[r+3]);}
  const float m=max2f(a,b);
  auto rr=__builtin_amdgcn_permlane32_swap(__float_as_uint(m),__float_as_uint(m),false,false);
  return max2f(__uint_as_float(rr[0]),__uint_as_float(rr[1]));
}
__device__ __forceinline__ void pv(f32x16*o,int vb,bf16x8 pa0,bf16x8 pa1,bf16x8 pa2,bf16x8 pa3){
  #pragma unroll
  for(int d0=0;d0<2;++d0){s16x4 lo[4],hi[4];
    #pragma unroll
    for(int ks=0;ks<4;++ks){
      asm volatile("ds_read_b64_tr_b16 %0,%1 offset:%c2":"=&v"(lo[ks]):"v"(vb),"i"(d0*4096+ks*1024):"memory");
      asm volatile("ds_read_b64_tr_b16 %0,%1 offset:%c2":"=&v"(hi[ks]):"v"(vb),"i"(d0*4096+ks*1024+512):"memory");}
    asm volatile("s_waitcnt lgkmcnt(0)":::"memory");SBAR();
    #define PK(k) (bf16x8){lo[k][0],lo[k][1],lo[k][2],lo[k][3],hi[k][0],hi[k][1],hi[k][2],hi[k][3]}
    o[d0]=__builtin_amdgcn_mfma_f32_32x32x16_bf16(pa0,PK(0),o[d0],0,0,0);
    o[d0]=__builtin_amdgcn_mfma_f32_32x32x16_bf16(pa1,PK(1),o[d0],0,0,0);
    o[d0]=__builtin_amdgcn_mfma_f32_32x32x16_bf16(pa2,PK(2),o[d0],0,0,0);
    o[d0]=__builtin_amdgcn_mfma_f32_32x32x16_bf16(pa3,PK(3),o[d0],0,0,0);
    #undef PK
  }
}

#ifndef ATTN_STORE16
#define ATTN_STORE16(p,v) (*(u32x4*)(p)=(v))
#endif
template<int THRL,int NB=0> __device__ __forceinline__ void attn_unit(int b,int h,int qb,int T0in,int T1,bool mband,float skipthr,const bf16*Q,const bf16*__restrict__ K,const bf16*__restrict__ V,bf16*O,float*lse_out,float*lse_neg,const float*cum,const float*segt,char*shm,int tid){
  const int lane=tid&63,r32=lane&31,hi=lane>>5; const int wid=__builtin_amdgcn_readfirstlane(tid>>6);
  const long rowbase=(long)b*SEQ; const int q0=qb*QB;
  float off[8]; { float r_=0.f; _Pragma("unroll") for(int s_=0;s_<8;++s_){ off[s_]=r_; r_+=segt[s_]; } }
  float cref=cum[q0]; { const int sq=q0>>10; _Pragma("unroll") for(int s_=0;s_<8;++s_) if(s_==sq)cref+=off[s_]; }
  int T0=T0in;
  { int flag=0;
    if(tid<128){ const int jl=64*tid+63; float cj=cum[jl]; { const int sj=jl>>10; _Pragma("unroll") for(int s_=0;s_<8;++s_) if(s_==sj)cj+=off[s_]; } flag=((cref-cj)*1.4426950408889634f< -skipthr)?1:0; }
    const unsigned long long bal=__ballot(flag); int*cnt=(int*)(shm+LDS_WS);
    if(lane==0&&wid<2)cnt[wid]=__builtin_popcountll(bal);
    __syncthreads();
    const int nskip=cnt[0]+cnt[1];
    __syncthreads();
    if(!mband&&nskip>=T1){ if(hi==0)lse_out[(rowbase+q0+wid*QBLK+r32)*4+h]=-INFINITY; return; }
    int t0n=nskip<T1-4?nskip:T1-4; if(t0n>T0){ if((T1-t0n)&1)t0n-=1; T0=t0n; } }
  const bf16*Qw=Q+(rowbase+q0+wid*QBLK)*DM+h*D;
  const bf16*Kh=K+rowbase*DM+h*D,*Vh=V+rowbase*DM+h*D;
  const unsigned lds0=(unsigned)(uintptr_t)shm;
  float*wsf=(float*)(shm+LDS_WS)+wid*64;
  const bf16*ksrc=Kh+(long)(T0*KVBLK+lane)*DM+wid*8;
  const bf16*vsrc=Vh+(long)(T0*KVBLK+16*(wid&3)+(lane>>2))*DM+(wid>>2)*32+(lane&3)*8;
  const unsigned kdst=lds0+LDS_K+wid*1024, vdst=lds0+LDS_V+wid*1024;
  #define DMA_K(t,slot) glds16(ksrc+(long)(t)*KVBLK*DM,(unsigned)__builtin_amdgcn_readfirstlane(kdst+(slot)))
  #define DMA_V(t,slot) glds16(vsrc+(long)(t)*KVBLK*DM,(unsigned)__builtin_amdgcn_readfirstlane(vdst+(slot)))
  const int vb0=(int)(lds0+LDS_V)+((lane>>4)&1)*32+(lane&3)*8+(4*hi+((lane&15)>>2))*64;
  const char*Kbase=shm+LDS_K; bf16x8 kf[8];
  const lds_cptr shm3=(lds_cptr)shm; const lds_cptr kp0=shm3+LDS_K+hi*1024+r32*16; const lds_cptr vp0=shm3+LDS_V+((lane>>4)&1)*32+(lane&3)*8+(4*hi+((lane&15)>>2))*64;
  const int NT=T1-T0;
  {
    float*bl=(float*)(shm+LDS_BIAS);
    _Pragma("clang loop unroll(disable) vectorize(disable)") for(int j=tid*4;j<NT*KVBLK;j+=NW*64*4){ const int ja=T0*KVBLK+j; const float4 c4=*reinterpret_cast<const float4*>(cum+ja);
      float oj=0.f; { const int sj=ja>>10; _Pragma("unroll") for(int s_=0;s_<8;++s_) if(s_==sj)oj=off[s_]; } const float cr=cref-oj;
      float4 o4; o4.x=(cr-c4.x)*1.4426950408889634f;o4.y=(cr-c4.y)*1.4426950408889634f;o4.z=(cr-c4.z)*1.4426950408889634f;o4.w=(cr-c4.w)*1.4426950408889634f; *reinterpret_cast<float4*>(bl+j)=o4; }
    asm volatile("s_waitcnt vmcnt(0) lgkmcnt(0)":::"memory"); }
  const lds_cptr bp0=(lds_cptr)shm+LDS_BIAS+hi*16;
  #define LDBIAS(P0,P1,t) do{ if(NB){ _Pragma("unroll") for(int r_=0;r_<16;++r_){P0[r_]=0.f;P1[r_]=0.f;} break; } const lds_cptr bp_=bp0+(t)*256; _Pragma("unroll") for(int g_=0;g_<4;++g_){ const f32x4v a_=*(const __attribute__((address_space(3))) f32x4v*)(bp_+32*g_); const f32x4v c_=*(const __attribute__((address_space(3))) f32x4v*)(bp_+128+32*g_); \
      P0[4*g_]=a_[0];P0[4*g_+1]=a_[1];P0[4*g_+2]=a_[2];P0[4*g_+3]=a_[3]; P1[4*g_]=c_[0];P1[4*g_+1]=c_[1];P1[4*g_+2]=c_[2];P1[4*g_+3]=c_[3]; } }while(0)
  DMA_K(0,0);DMA_V(0,0);DMA_K(1,SLOTB);
  bf16x8 qr[4];
  #pragma unroll
  for(int d0=0;d0<4;++d0)qr[d0]=*reinterpret_cast<const bf16x8*>(&Qw[(long)r32*DM+d0*16+hi*8]);
  float mhat=0.f,l_reg=0.f;f32x16 o[2];o[0]=f32x16{};o[1]=f32x16{};
  const int qrel=wid*QBLK+r32;
  #define CMASK(P0,P1,t) do{int jb_=(t)-(NT-4); if(mband&&jb_>=0)cmask(P0,P1,jb_,qrel,hi);}while(0)
  bool resc=false;
  #define START(P0,P1) do{ const float rm=rowmax(P0,P1); resc=false; \
    { const float dl=rm; mhat=fadd_s(mhat,dl); \
      _Pragma("unroll") for(int r=0;r<16;++r){P0[r]=fsub_s(P0[r],dl);P1[r]=fsub_s(P1[r],dl);} } \
    _Pragma("unroll") for(int r=0;r<16;++r)P0[r]=__builtin_amdgcn_exp2f(P0[r]); }while(0)
  #define RESC() do{ if(resc){ asm volatile("s_waitcnt lgkmcnt(0)":::"memory"); \
      _Pragma("unroll") for(int d_=0;d_<2;++d_) _Pragma("unroll") for(int r=0;r<16;++r)o[d_][r]*=wsf[crow(r,hi)]; } }while(0)
  f32x16 pA0,pA1,pB0,pB1;
  int sl_prev=0,sl_cur=0,sl_next=SLOTB;
  #define ROT() do{sl_prev=sl_cur;sl_cur=sl_next;sl_next=(sl_next==(NSLOT-1)*SLOTB)?0:sl_next+SLOTB;}while(0)
  DMA_K(2,2*SLOTB);
  WAIT_BAR(3);
  LDBIAS(pA0,pA1,0); qkt(pA0,pA1,Kbase,qr,r32,hi);asm volatile("s_nop 15\n\ts_nop 7":"+v"(pA0),"+v"(pA1));CMASK(pA0,pA1,0);
  START(pA0,pA1);
  _Pragma("unroll") for(int r=0;r<16;++r)pA1[r]=__builtin_amdgcn_exp2f(pA1[r]);
  LDBIAS(pB0,pB1,1); _Pragma("unroll") for(int r=0;r<16;++r){pB0[r]-=mhat;pB1[r]-=mhat;}
  WAIT_BAR(0);
  DMA_K(3,0);DMA_V(1,SLOTB);
  ROT();
  kload8(kf,kp0+sl_cur);
  WAIT_BAR(2);
  s16x4 vlo[8],vhi[8]; u32x4 pw0,pw1,pw2,pw3;
  #define PKW(P,B) cvtpk_s(P[B],P[B+1])
  #define PAF(k) __builtin_bit_cast(bf16x8,pw##k)
  #define VFR(i) (bf16x8){vlo[i][0],vlo[i][1],vlo[i][2],vlo[i][3],vhi[i][0],vhi[i][1],vhi[i][2],vhi[i][3]}
  #define PIN(x) asm volatile("":"+v"(x))
  #define MX3(a,b,c) __builtin_fmaxf(__builtin_fmaxf((a),(b)),(c))
  #define GAPA(MF,A0,A1,A2,A3,W0,W1,PW) do{ MF; sacc+=A0; sacc+=A1; sacc+=A2; sacc+=A3; PIN(sacc); W0; W1; PIN(PW); SBAR(); }while(0)
  #define EX(v) __builtin_amdgcn_exp2f(v)
  #define GAPB(MF,X,B) do{ MF; X[B]=EX(X[B]); X[B+1]=EX(X[B+1]); X[B+2]=EX(X[B+2]); X[B+3]=EX(X[B+3]); PIN(X); SBAR(); }while(0)
  #define VRD(i) do{ vlo[i]=vtr(vp_+(((i)>>2)*4096+((i)&3)*1024)); vhi[i]=vtr(vp_+(((i)>>2)*4096+((i)&3)*1024+512)); }while(0)
  #define KRD(G,j) do{ if(G){ kload2(kf,kp0+sl_next,j); SBAR(); } }while(0)
  #define STEP(C0,C1,P0,P1,t,GK,GV,GL) do{ SBAR(); \
    const lds_cptr vp_=vp0+sl_prev; \
    VRD(0); SBAR(); float sacc=(P0[0]+P0[1]); \
    GAPA(C0=__builtin_amdgcn_mfma_f32_32x32x16_bf16(kf[0],qr[0],C0,0,0,0), P0[2],P0[3],P0[4],P0[5],     pw0[0]=PKW(P0,0), pw0[1]=PKW(P0,2), pw0); \
    VRD(4); SBAR(); GAPA(C1=__builtin_amdgcn_mfma_f32_32x32x16_bf16(kf[1],qr[0],C1,0,0,0), P0[6],P0[7],P0[8],P0[9],     pw0[2]=PKW(P0,4), pw0[3]=PKW(P0,6), pw0); \
    VRD(1); SBAR(); GAPA(C0=__builtin_amdgcn_mfma_f32_32x32x16_bf16(kf[2],qr[1],C0,0,0,0),   P0[10],P0[11],P0[12],P0[13], pw1[0]=PKW(P0,8), pw1[1]=PKW(P0,10), pw1); \
    VRD(5); SBAR(); GAPA(C1=__builtin_amdgcn_mfma_f32_32x32x16_bf16(kf[3],qr[1],C1,0,0,0),   P0[14],P0[15],P1[0],P1[1],   pw1[2]=PKW(P0,12),pw1[3]=PKW(P0,14), pw1); \
    VRD(2); SBAR(); GAPA(C0=__builtin_amdgcn_mfma_f32_32x32x16_bf16(kf[4],qr[2],C0,0,0,0),   P1[2],P1[3],P1[4],P1[5],     pw2[0]=PKW(P1,0), pw2[1]=PKW(P1,2), pw2); \
    VRD(6); SBAR(); GAPA(C1=__builtin_amdgcn_mfma_f32_32x32x16_bf16(kf[5],qr[2],C1,0,0,0),   P1[6],P1[7],P1[8],P1[9],     pw2[2]=PKW(P1,4), pw2[3]=PKW(P1,6), pw2); \
    VRD(3); SBAR(); GAPA(C0=__builtin_amdgcn_mfma_f32_32x32x16_bf16(kf[6],qr[3],C0,0,0,0),   P1[10],P1[11],P1[12],P1[13], pw3[0]=PKW(P1,8), pw3[1]=PKW(P1,10), pw3); \
    VRD(7); SBAR(); GAPA(C1=__builtin_amdgcn_mfma_f32_32x32x16_bf16(kf[7],qr[3],C1,0,0,0),   P1[14],P1[15],0.f,0.f,       pw3[2]=PKW(P1,12),pw3[3]=PKW(P1,14), pw3); \
    l_reg+=sacc; \
    if(GK){DMA_K((t)+3,sl_cur);} if(GV){DMA_V((t)+1,sl_next);} \
    CMASK(C0,C1,t); \
    { float a=MX3(C0[0],C0[1],C1[0]),b=MX3(C0[2],C0[3],C1[1]); a=MX3(a,C1[2],C1[3]); \
      _Pragma("unroll") for(int r=4;r<16;r+=4){a=MX3(a,C0[r],C0[r+1]);b=MX3(b,C0[r+2],C0[r+3]);a=MX3(a,C1[r],C1[r+1]);b=MX3(b,C1[r+2],C1[r+3]);} \
      float rm=__builtin_fmaxf(a,b); { auto rr=__builtin_amdgcn_permlane32_swap(__float_as_uint(rm),__float_as_uint(rm),false,false); rm=__builtin_fmaxf(__uint_as_float(rr[0]),__uint_as_float(rr[1])); } \
      resc=false; \
      if(__builtin_expect(__any(rm>(float)THRL),0)){ const float dl=__builtin_fmaxf(rm,0.f); mhat+=dl; \
        _Pragma("unroll") for(int r=0;r<16;++r){C0[r]-=dl;C1[r]-=dl;} \
        const float f=__builtin_amdgcn_exp2f(-dl); l_reg*=f; if(hi==0)wsf[r32]=f; resc=true; } } \
    SBAR(); \
    if(GL){ LDBIAS(P0,P1,(t)+1); SBAR(); } \
    GAPB(o[0]=__builtin_amdgcn_mfma_f32_32x32x16_bf16(PAF(0),VFR(0),o[0],0,0,0), C0,0); \
    GAPB(o[1]=__builtin_amdgcn_mfma_f32_32x32x16_bf16(PAF(0),VFR(4),o[1],0,0,0), C0,4); \
    KRD(GL,0); GAPB(o[0]=__builtin_amdgcn_mfma_f32_32x32x16_bf16(PAF(1),VFR(1),o[0],0,0,0), C0,8); \
    KRD(GL,1); GAPB(o[1]=__builtin_amdgcn_mfma_f32_32x32x16_bf16(PAF(1),VFR(5),o[1],0,0,0), C0,12); \
    KRD(GL,2); GAPB(o[0]=__builtin_amdgcn_mfma_f32_32x32x16_bf16(PAF(2),VFR(2),o[0],0,0,0), C1,0); \
    KRD(GL,3); GAPB(o[1]=__builtin_amdgcn_mfma_f32_32x32x16_bf16(PAF(2),VFR(6),o[1],0,0,0), C1,4); \
    GAPB(o[0]=__builtin_amdgcn_mfma_f32_32x32x16_bf16(PAF(3),VFR(3),o[0],0,0,0), C1,8); \
    GAPB(o[1]=__builtin_amdgcn_mfma_f32_32x32x16_bf16(PAF(3),VFR(7),o[1],0,0,0), C1,12); \
    if(GL&&NB!=2){ _Pragma("unroll") for(int r=0;r<16;++r){P0[r]-=mhat;P1[r]-=mhat;} PIN(P0); PIN(P1); SBAR(); } \
    }while(0)
  int t=1;
  #undef CMASK
  #define CMASK(P0,P1,t) do{}while(0)
  for(;t+5<NT;t+=2){
    STEP(pB0,pB1,pA0,pA1,t,true,true,true);     WAIT_BAR(2); RESC(); ROT();
    STEP(pA0,pA1,pB0,pB1,t+1,true,true,true);   WAIT_BAR(2); RESC(); ROT();
  }
  #undef CMASK
  #define CMASK(P0,P1,t) do{int jb_=(t)-(NT-4); if(mband&&jb_>=0)cmask(P0,P1,jb_,qrel,hi);}while(0)
  #define ENDW(tt) do{ if((tt)+3<NT){WAIT_BAR(2);} else if((tt)+2<NT){WAIT_BAR(1);} else {WAIT_BAR(0);} }while(0)
  for(;t+1<NT;t+=2){
    STEP(pB0,pB1,pA0,pA1,t,(t+3<NT),(t+1<NT),(t+1<NT));       ENDW(t);   RESC(); ROT();
    STEP(pA0,pA1,pB0,pB1,t+1,(t+4<NT),(t+2<NT),(t+2<NT));     ENDW(t+1); RESC(); ROT();
  }
  STEP(pB0,pB1,pA0,pA1,NT-1,false,false,false); RESC();
  { float sacc=pB0[0]+pB0[1]; _Pragma("unroll") for(int r=2;r<16;++r)sacc+=pB0[r]; _Pragma("unroll") for(int r=0;r<16;++r)sacc+=pB1[r]; l_reg+=sacc;
    pw0=(u32x4){PKW(pB0,0),PKW(pB0,2),PKW(pB0,4),PKW(pB0,6)};pw1=(u32x4){PKW(pB0,8),PKW(pB0,10),PKW(pB0,12),PKW(pB0,14)};pw2=(u32x4){PKW(pB1,0),PKW(pB1,2),PKW(pB1,4),PKW(pB1,6)};pw3=(u32x4){PKW(pB1,8),PKW(pB1,10),PKW(pB1,12),PKW(pB1,14)};
    SBAR(); pv(o,vb0+sl_cur,PAF(0),PAF(1),PAF(2),PAF(3)); }
  #undef PKW
  #undef PAF
  #undef VFR
  #undef PIN
  #undef MX3
  #undef GAPA
  #undef GAPB
  #undef EX
  #undef VRD
  #undef KRD
  #undef STEP
  #undef ENDW
  {auto rr=__builtin_amdgcn_permlane32_swap(__float_as_uint(l_reg),__float_as_uint(l_reg),false,false);l_reg=__uint_as_float(rr[0])+__uint_as_float(rr[1]);}
  if(hi==0){ wsf[32+r32]=l_reg; const long lrow=(rowbase+q0+wid*QBLK+r32)*4+h; lse_out[lrow]=mhat+__log2f(l_reg); if(lse_neg)lse_neg[lrow]=-INFINITY; } asm volatile("s_waitcnt lgkmcnt(0)":::"memory");
  float rli[16];
  #pragma unroll
  for(int r=0;r<16;++r)rli[r]=__builtin_amdgcn_rcpf(wsf[32+crow(r,hi)]);
  bf16*Ow=O+(rowbase+q0+wid*QBLK)*OP+h*D;
  { bf16*stg=(bf16*)(shm+LDS_OST)+wid*2048;
    #pragma unroll
    for(int r=0;r<16;++r){const int orow=crow(r,hi);
      #pragma unroll
      for(int d0=0;d0<2;++d0)stg[orow*64+d0*32+r32]=__float2bfloat16(o[d0][r]*rli[r]);}
    asm volatile("s_waitcnt lgkmcnt(0)":::"memory");
    #pragma unroll
    for(int i=0;i<4;++i){const int row=i*8+(lane>>3),ch=lane&7; const u32x4 v=*(const u32x4*)(stg+row*64+ch*8); ATTN_STORE16(Ow+(long)row*OP+ch*8,v);} }
  asm volatile("s_waitcnt lgkmcnt(0)\n\ts_barrier":::"memory");
  #undef DMA_K
  #undef DMA_V
  #undef CMASK
  #undef START
  #undef RESC
  #undef ROT
  #undef LDBIAS
}
constexpr int ATTN_LDS_BYTES=LDS_BYTES;
struct AttnTensors { const bf16* Q; const bf16* K; const bf16* V; bf16* O0; bf16* O1; float* L0; float* L1; const float* cum; const float* segt; };
constexpr int N_ITEMS=28*16+32;
template<int THRL=8,int NB=0> __device__ __forceinline__ void attn_phase_queue(char*lds,const AttnTensors&T,float skipthr,unsigned*ctr,volatile __attribute__((address_space(3))) unsigned*slot,int tid){
  unsigned nxt=0u; if(tid==0)nxt=__hip_atomic_fetch_add(ctr,1u,__ATOMIC_RELAXED,__HIP_MEMORY_SCOPE_AGENT);
  for(;;){
    if(tid==0)slot[0]=nxt;
    __syncthreads();
    const int idx=(int)__builtin_amdgcn_readfirstlane(slot[0]);
    __syncthreads();
    if(idx>=N_ITEMS)break;
    if(tid==0)nxt=__hip_atomic_fetch_add(ctr,1u,__ATOMIC_RELAXED,__HIP_MEMORY_SCOPE_AGENT);
    int qb,bh,part;
    if(idx<448){ qb=31-(idx>>4); bh=(idx&15)>>1; part=idx&1; } else { const int r=idx-448; qb=3-(r>>3); bh=r&7; part=2; }
    const int T0=(part==1)?2*qb+2:0, T1=(part==0)?2*qb+2:4*qb+4;
    attn_unit<THRL,NB>(bh/NHEAD,bh%NHEAD,qb,T0,T1,part!=0,skipthr,T.Q,T.K,T.V,part==0?T.O0:T.O1,part==0?T.L0:T.L1,part==2?T.L0:nullptr,T.cum+(long)bh*SEQ,T.segt+bh*8,lds,tid);
  }
}
#undef SBAR
#undef WAIT_BAR
}
struct Args { const float* in[24]; float* out; unsigned char* ws; int ph_lo, ph_hi; };
typedef const __attribute__((address_space(4))) Args* CArgs;
__device__ __forceinline__ CArgs get_args() { CArgs p = (CArgs)__builtin_amdgcn_kernarg_segment_ptr(); asm volatile("" : "+s"(p)); return p; }
struct Frame {
    LAS unsigned char* lds;
    volatile LAS unsigned* MISC;
    gu32* ctl;
    int tid, lane, wave;
    int vcu, G, bx;
};
__device__ __forceinline__ float bf2f(unsigned short b) { return __builtin_bit_cast(float, (unsigned)b << 16); }
__device__ __forceinline__ float bflo(unsigned w) { return __builtin_bit_cast(float, w << 16); }
__device__ __forceinline__ float bfhi(unsigned w) { return __builtin_bit_cast(float, w & 0xffff0000u); }
template <int CTRL> __device__ __forceinline__ float dppf(float x) { return __builtin_bit_cast(float, __builtin_amdgcn_mov_dpp(__builtin_bit_cast(int, x), CTRL, 0xf, 0xf, true)); }
__device__ __forceinline__ float row_sum16(float x) { x += dppf<0xB1>(x); x += dppf<0x4E>(x); x += dppf<0x141>(x); x += dppf<0x128>(x); return x; }
__device__ __forceinline__ float half_sum(float x) { auto rr = __builtin_amdgcn_permlane32_swap(__float_as_uint(x), __float_as_uint(x), false, false); return __uint_as_float(rr[0]) + __uint_as_float(rr[1]); }
__device__ __forceinline__ float pair16_sum(float x) { auto rr = __builtin_amdgcn_permlane16_swap(__float_as_uint(x), __float_as_uint(x), false, false); return __uint_as_float(rr[0]) + __uint_as_float(rr[1]); }
__device__ __forceinline__ float wave_sum_fast(float x) { return half_sum(pair16_sum(row_sum16(x))); }
__device__ __forceinline__ float wave_sum(float v) { return wave_sum_fast(v); }
__device__ __forceinline__ float sigm(float x) { return __builtin_amdgcn_rcpf(1.0f + __expf(-x)); }

template <class SRC>
__device__ __forceinline__ void conv_item(const float* W, int ldw, int K, bf16* WT, int dst0, int k0, const float* gain, LAS float* scr, int lane, SRC src) {
    const int cg = lane & 7, r8 = lane >> 3; const int sc = src(dst0 + 4 * cg); const int scc = sc < 0 ? 0 : sc;
#pragma unroll
    for (int i = 0; i < 8; ++i) { const int kk = 8 * i + r8;
        f32x4 v = *(const f32x4*)(W + (size_t)(k0 + kk) * ldw + scc); const float g = gain ? gain[k0 + kk] : 1.0f;
        if (sc < 0) v = (f32x4){0.f, 0.f, 0.f, 0.f};
        LAS float* d = scr + kk * 33 + 4 * cg; d[0] = v[0] * g; d[1] = v[1] * g; d[2] = v[2] * g; d[3] = v[3] * g; }
    LDS_WAIT(); asm volatile("" ::: "memory");
    const int c = lane & 7;
#pragma unroll
    for (int j = 0; j < 4; ++j) { const int n = (lane >> 3) + 8 * j; const LAS float* s = scr + (8 * c) * 33 + n;
        v4u o; o.x = pk2(s[0 * 33], s[1 * 33]); o.y = pk2(s[2 * 33], s[3 * 33]); o.z = pk2(s[4 * 33], s[5 * 33]); o.w = pk2(s[6 * 33], s[7 * 33]);
        *(GAS v4u*)(WT + (size_t)(dst0 + n) * K + k0 + 8 * c) = o; }
    LDS_WAIT(); asm volatile("" ::: "memory");
}
__device__ __forceinline__ void phase_weights(Frame& F, CArgs A, int l) {
    LAS float* scr = (LAS float*)(F.lds + RING_OFF + F.wave * 16384);
    const int gw = F.vcu * NWAVES + F.wave, NGW = F.G * NWAVES;
    const float* w_in = A->in[2] + (size_t)l * D * IN_COLS; const float* mixg = A->in[1] + (size_t)l * D;
    const float* p_ret = A->in[17] + (size_t)l * 256 * D; const float* p_fox = A->in[18] + (size_t)l * 256 * D; const float* p_rw = A->in[19] + (size_t)l * 256 * D;
    const float* w_out = A->in[20] + (size_t)l * D * D; const float* ffng = A->in[21] + (size_t)l * D;
    const float* w_gu = A->in[22] + (size_t)l * D * NGU; const float* w_down = A->in[23] + (size_t)l * DFF * D;
    bf16* Win_t = (bf16*)(A->ws + WS_WIN); bf16* Wgate_t = (bf16*)(A->ws + WS_WGATE); bf16* Pbr_t = (bf16*)(A->ws + WS_PBR);
    bf16* Wout_t = (bf16*)(A->ws + WS_WOUT); bf16* Wgu_t = (bf16*)(A->ws + WS_WGU); bf16* Wdown_t = (bf16*)(A->ws + WS_WDOWN);
    constexpr int I_IN = (NMIX / 32) * (D / 64), I_G = (NGATE / 32) * (D / 64), I_P = (D / 32) * (256 / 64), I_O = (D / 32) * (D / 64), I_GU = (NGU / 32) * (D / 64), I_DN = (D / 32) * (DFF / 64);
    constexpr int I_G2 = (256 / 32) * (128 / 64);
    constexpr int NITEMS = I_IN + I_G + 3 * I_P + I_O + I_GU + I_DN + I_G2;
    for (int it = gw; it < NITEMS; it += NGW) {
        int r = it;
        if (r < I_IN) { const int nb = r % (NMIX / 32), kb = r / (NMIX / 32);
            conv_item(w_in, IN_COLS, D, Win_t, nb * 32, kb * 64, mixg, scr, F.lane, [](int d) { return d < 1792 ? d : (d < 2816 ? d + 4 : (d < 2820 ? d - 1024 : -1)); }); continue; } r -= I_IN;
        if (r < I_G) { const int nb = r % (NGATE / 32), kb = r / (NGATE / 32);
            conv_item(w_in, IN_COLS, D, Wgate_t, nb * 32, kb * 64, mixg, scr, F.lane, [](int d) { return d + 2820; }); continue; } r -= I_G;
        if (r < 3 * I_P) { const int b = r / I_P, q = r % I_P, nb = q % (D / 32), kb = q / (D / 32); const float* src = b == 0 ? p_ret : (b == 1 ? p_fox : p_rw);
            conv_item(src, D, 256, Pbr_t + (size_t)b * D * 256, nb * 32, kb * 64, nullptr, scr, F.lane, [](int d) { return d; }); continue; } r -= 3 * I_P;
        if (r < I_O) { const int nb = r % (D / 32), kb = r / (D / 32);
            conv_item(w_out, D, D, Wout_t, nb * 32, kb * 64, nullptr, scr, F.lane, [](int d) { return d; }); continue; } r -= I_O;
        if (r < I_GU) { const int nb = r % (NGU / 32), kb = r / (NGU / 32);
            conv_item(w_gu, NGU, D, Wgu_t, nb * 32, kb * 64, ffng, scr, F.lane, [](int d) { const int t = d >> 8, w = d & 255; return w < 128 ? 128 * t + w : DFF + 128 * t + (w - 128); }); continue; } r -= I_GU;
        if (r < I_DN) { const int nb = r % (D / 32), kb = r / (D / 32);
            conv_item(w_down, D, DFF, Wdown_t, nb * 32, kb * 64, nullptr, scr, F.lane, [](int d) { return d; }); continue; } r -= I_DN;
        { const int nb = r % 8, kb = r / 8;
            conv_item(A->in[12] + (size_t)l * 128 * 256, 256, 128, (bf16*)(A->ws + WS_G2T), nb * 32, kb * 64, nullptr, scr, F.lane, [](int d) { return d; }); }
    }
}
__device__ __forceinline__ void phase_prologue(Frame& F, CArgs A) {
    const int gw = F.vcu * NWAVES + F.wave, NGW = F.G * NWAVES;
    const float* x = A->in[0]; bf16* XB = (bf16*)(A->ws + WS_XB); float* SS1 = (float*)(A->ws + WS_SS1);
    for (int m = gw; m < M; m += NGW) {
        const GAS f32x4* xr = (const GAS f32x4*)(x + (size_t)m * D) + F.lane; GAS f32x4* orow = (GAS f32x4*)(A->out + (size_t)m * D) + F.lane;
        GAS unsigned long long* o8 = (GAS unsigned long long*)(XB + (size_t)m * D) + F.lane; float s = 0.f;
#pragma unroll
        for (int j = 0; j < 4; ++j) { const f32x4 v = xr[64 * j]; s += (v.x * v.x + v.y * v.y) + (v.z * v.z + v.w * v.w);
            o8[64 * j] = (unsigned long long)pk2(v.x, v.y) | ((unsigned long long)pk2(v.z, v.w) << 32); }
        s = wave_sum(s);
        if (F.lane < 4) SS1[(size_t)m * 4 + F.lane] = F.lane == 0 ? s : 0.f;
    }
    float* rope = (float*)(A->ws + WS_ROPE);
    for (int e = (F.vcu * NWAVES + F.wave) * 64 + F.lane; e < SEQ * 32; e += NGW * 64) { const int t = e >> 5, i = e & 31;
        const float inv = exp2f(-(float)i * (13.287712379549449f / 32.0f)); const float ang = (float)t * inv;
        double rev = (double)ang * 0.15915494309189535; rev -= rint(rev); const float rv = (float)rev;
        rope[2 * e] = __builtin_amdgcn_cosf(rv); rope[2 * e + 1] = __builtin_amdgcn_sinf(rv); }
}
__device__ __forceinline__ void unpack8(const v4u w, float* f) { f[0] = bflo(w.x); f[1] = bfhi(w.x); f[2] = bflo(w.y); f[3] = bfhi(w.y); f[4] = bflo(w.z); f[5] = bfhi(w.z); f[6] = bflo(w.w); f[7] = bfhi(w.w); }
__device__ __forceinline__ float log_sigmoid(float z) { return fminf(z, 0.f) - __logf(1.0f + __expf(-fabsf(z))); }
__device__ __forceinline__ void phase_cumsum(Frame& F, CArgs A, int l) {
    LAS float* part = (LAS float*)(F.lds);
#pragma unroll 1
    for (int item = F.vcu; item < 64; item += F.G) {
        const int bh = item >> 3, seg = item & 7, b = bh >> 2, h = bh & 3; const float bias = A->in[6][l * 4 + h];
        const int t0 = seg * 1024 + F.tid * 2;
        const float* fl = (const float*)(A->ws + WS_FLOG) + ((size_t)b * SEQ + t0) * 4 + h; float* cum = (float*)(A->ws + WS_CUM) + (size_t)bh * SEQ + t0;
        const float lf0 = log_sigmoid(fl[0] + bias), lf1 = log_sigmoid(fl[4] + bias); const float s = lf0 + lf1;
        float incl = s;
#pragma unroll
        for (int o = 1; o < 64; o <<= 1) { const float t = __shfl_up(incl, o); if (F.lane >= o) incl += t; }
        __syncthreads();
        if (F.lane == 63) part[F.wave] = incl;
        __syncthreads();
        float run = incl - s;
        for (int w = 0; w < F.wave; ++w) run += part[w];
        cum[0] = run + lf0; cum[1] = run + s;
        if (F.tid == NWAVES * 64 - 1) ((float*)(A->ws + WS_SEGT))[bh * 8 + seg] = run + s;
    }
}
__device__ __forceinline__ float fox_skip_threshold(Frame& F, CArgs A, int l) {
    float gq = fabsf(A->in[4][l * 64 + F.lane]), gk = fabsf(A->in[5][l * 64 + F.lane]);
#pragma unroll
    for (int o = 1; o < 64; o <<= 1) { gq = fmaxf(gq, __shfl_xor(gq, o)); gk = fmaxf(gk, __shfl_xor(gk, o)); }
    const float bound = 0.125f * 1.4426950408889634f * 64.0f * gq * gk * 1.03f;
    return 64.0f + 2.0f * bound;
}
__device__ __forceinline__ void phase_fox_prep(Frame& F, CArgs A, int l) {
    const int gw = F.vcu * NWAVES + F.wave, NGW = F.G * NWAVES, lane = F.lane;
    bf16* MIXIN = (bf16*)(A->ws + WS_BIG); const float* gain = (lane < 32 ? A->in[4] : A->in[5]) + l * 64 + (lane & 7) * 8;
    const float sc = lane < 32 ? 0.125f * 1.4426950408889634f : 1.0f;
    float gv[8];
#pragma unroll
    for (int e = 0; e < 8; ++e) gv[e] = gain[e] * sc;
    for (int m = gw; m < M; m += NGW) {
        v4u* p = (v4u*)(MIXIN + (size_t)m * MIXLD + C_FOXQ + 8 * lane); const v4u w = *p;
        float f[8] = {bflo(w.x), bfhi(w.x), bflo(w.y), bfhi(w.y), bflo(w.z), bfhi(w.z), bflo(w.w), bfhi(w.w)};
        float ss = 0.f;
#pragma unroll
        for (int e = 0; e < 8; ++e) ss += f[e] * f[e];
        ss += dppf<0xB1>(ss); ss += dppf<0x4E>(ss); ss += dppf<0x141>(ss);
        const float rs = __builtin_amdgcn_rsqf(ss * (1.f / 64.f) + 1e-6f);
        v4u o; o.x = pk2(f[0] * rs * gv[0], f[1] * rs * gv[1]); o.y = pk2(f[2] * rs * gv[2], f[3] * rs * gv[3]); o.z = pk2(f[4] * rs * gv[4], f[5] * rs * gv[5]); o.w = pk2(f[6] * rs * gv[6], f[7] * rs * gv[7]);
        *p = o;
    }
}
constexpr int STG_OFF = 132096;
__device__ __forceinline__ float lerp_col(const bf16* MIXIN, int m, int t, int col, float mu) {
    const float cur = bf2f(MIXIN[(size_t)m * MIXLD + C_RW + col]); const float prev = t > 0 ? bf2f(MIXIN[(size_t)(m - 1) * MIXLD + C_RW + col]) : 0.f;
    return cur + (prev - cur) * mu;
}
typedef short pbf16x8 __attribute__((ext_vector_type(8)));
__device__ __forceinline__ void phase_rwkv_prep(Frame& F, CArgs A, int l) {
    const float* w2 = A->in[9] + (size_t)l * 64 * 256; const float* a2 = A->in[11] + (size_t)l * 64 * 256;
    const float* mu = A->in[7] + (size_t)l * 1024; const float* w0 = A->in[8] + l * 256; const float* a0 = A->in[10] + l * 256;
    const bf16* MIXIN = (const bf16*)(A->ws + WS_BIG); float* SW = (float*)(A->ws + WS_SW); float* SA = (float*)(A->ws + WS_SA);
    const int lane = F.lane, fr = lane & 15, fq = lane >> 4, w = F.wave;
    pbf16x8 bh_[2][2][2], bl_[2][2][2];
#pragma unroll
    for (int mt = 0; mt < 2; ++mt)
#pragma unroll
        for (int nt = 0; nt < 2; ++nt)
#pragma unroll
            for (int ks = 0; ks < 2; ++ks) { const float* W = (mt ? a2 : w2) + (size_t)(32 * ks + 8 * fq) * 256 + 32 * w + 16 * nt + fr; unsigned hw[4], lw[4];
#pragma unroll
                for (int j = 0; j < 4; ++j) { const float x0 = W[(2 * j) * 256], x1 = W[(2 * j + 1) * 256]; const unsigned h0 = f2bf(x0), h1 = f2bf(x1);
                    hw[j] = h0 | (h1 << 16); lw[j] = pk2(x0 - bf2f((unsigned short)h0), x1 - bf2f((unsigned short)h1)); }
                bh_[mt][nt][ks] = __builtin_bit_cast(pbf16x8, (v4u){hw[0], hw[1], hw[2], hw[3]}); bl_[mt][nt][ks] = __builtin_bit_cast(pbf16x8, (v4u){lw[0], lw[1], lw[2], lw[3]}); }
#pragma unroll 1
    for (int item = F.vcu; item < M / 64; item += F.G) {
        const size_t mb = (size_t)item * 64;
        __syncthreads();
        { const int tok = F.tid >> 3, c = F.tid & 7; const size_t m = mb + tok; const int t = (int)(m & (SEQ - 1));
          const v4u* cp = (const v4u*)(MIXIN + m * MIXLD + C_RW + 768 + 16 * c); const v4u* pp = (const v4u*)(MIXIN + (m > 0 ? m - 1 : 0) * MIXLD + C_RW + 768 + 16 * c);
          float cur[16], prv[16]; unpack8(cp[0], cur); unpack8(cp[1], cur + 8);
          unpack8(pp[0], prv); unpack8(pp[1], prv + 8);
          if (t == 0) {
#pragma unroll
              for (int e = 0; e < 16; ++e) prv[e] = 0.f; }
          const float* mup = mu + 768 + 16 * c; unsigned hw[8], lw[8];
#pragma unroll
          for (int e = 0; e < 8; ++e) { float x0 = cur[2 * e] + (prv[2 * e] - cur[2 * e]) * mup[2 * e], x1 = cur[2 * e + 1] + (prv[2 * e + 1] - cur[2 * e + 1]) * mup[2 * e + 1];
              if (c < 4) { x0 = 1.0f - 2.0f * __builtin_amdgcn_rcpf(1.0f + __expf(2.0f * x0)); x1 = 1.0f - 2.0f * __builtin_amdgcn_rcpf(1.0f + __expf(2.0f * x1)); }
              const unsigned h0 = f2bf(x0), h1 = f2bf(x1); hw[e] = h0 | (h1 << 16); lw[e] = pk2(x0 - bf2f((unsigned short)h0), x1 - bf2f((unsigned short)h1)); }
          LAS unsigned char* xh = F.lds + (((c >> 2) * 2 + 0) * 64 + tok) * 144 + 32 * (c & 3); LAS unsigned char* xl = F.lds + (((c >> 2) * 2 + 1) * 64 + tok) * 144 + 32 * (c & 3);
          *(LAS v4u*)xh = (v4u){hw[0], hw[1], hw[2], hw[3]}; *(LAS v4u*)(xh + 16) = (v4u){hw[4], hw[5], hw[6], hw[7]};
          *(LAS v4u*)xl = (v4u){lw[0], lw[1], lw[2], lw[3]}; *(LAS v4u*)(xl + 16) = (v4u){lw[4], lw[5], lw[6], lw[7]}; }
        __syncthreads();
#pragma unroll
        for (int mt = 0; mt < 4; ++mt)
#pragma unroll
            for (int mat = 0; mat < 2; ++mat) { f32x4 acc[2] = {(f32x4){0.f, 0.f, 0.f, 0.f}, (f32x4){0.f, 0.f, 0.f, 0.f}};
#pragma unroll
                for (int ks = 0; ks < 2; ++ks) { const pbf16x8 ah = *(const LAS pbf16x8*)(F.lds + ((mat * 2 + 0) * 64 + 16 * mt + fr) * 144 + (32 * ks + 8 * fq) * 2);
                    const pbf16x8 al = *(const LAS pbf16x8*)(F.lds + ((mat * 2 + 1) * 64 + 16 * mt + fr) * 144 + (32 * ks + 8 * fq) * 2);
#pragma unroll
                    for (int nt = 0; nt < 2; ++nt) { acc[nt] = __builtin_amdgcn_mfma_f32_16x16x32_bf16(ah, bh_[mat][nt][ks], acc[nt], 0, 0, 0);
                        acc[nt] = __builtin_amdgcn_mfma_f32_16x16x32_bf16(ah, bl_[mat][nt][ks], acc[nt], 0, 0, 0); acc[nt] = __builtin_amdgcn_mfma_f32_16x16x32_bf16(al, bh_[mat][nt][ks], acc[nt], 0, 0, 0); } }
#pragma unroll
                for (int nt = 0; nt < 2; ++nt) { const int ch = 32 * w + 16 * nt + fr; const float bias = mat ? a0[ch] : w0[ch];
#pragma unroll
                    for (int r = 0; r < 4; ++r) { const size_t m = mb + 16 * mt + 4 * fq + r; const float z = acc[nt][r] + bias;
                        if (mat == 0) { const float nz = -z; const float sp = fmaxf(nz, 0.f) + __logf(1.0f + __expf(-fabsf(nz))); SW[m * 256 + ch] = __expf(-__expf(-sp - 0.5f)); }
                        else SA[m * 256 + ch] = sigm(z); } } }
    }
}
template <int VAR> __device__ __forceinline__ void phase_rwkv_scan1(Frame& F, CArgs A, int l) {
    const int w2 = F.wave >> 2, p = F.wave & 3, lane = F.lane, kh = lane >> 5, row = 32 * w2 + (lane & 31);
    const bf16* MIXIN = (const bf16*)(A->ws + WS_BIG); const float* SW = (const float*)(A->ws + WS_SW); const float* SA = (const float*)(A->ws + WS_SA);
    float* YL = (float*)(A->ws + WS_YL); bf16* U = (bf16*)(A->ws + WS_U); float* LS = (float*)(A->ws + WS_LS); bf16* TT = (bf16*)(A->ws + WS_TT); float* BS = (float*)(A->ws + WS_BS);
    LAS float* ops_u = (LAS float*)(F.lds) + p * 4096;
    LAS float* gfin = (LAS float*)(F.lds + 65536) + p * 64;
    LAS float* vst = (LAS float*)(F.lds + 66560) + F.wave * 1024;
    const float* mu = A->in[7] + (size_t)l * 1024;
#pragma unroll 1
    for (int wg = F.vcu; wg < 256; wg += F.G) {
        const int bh = wg >> 5, b = bh >> 2, h = bh & 3, chunk = 4 * (wg & 31) + p, t0 = chunk * 64, hk = h * 64 + lane, hr = h * 64 + row;
        const size_t m0 = (size_t)b * SEQ + t0;
        const float mur = mu[hk], muk = mu[256 + hk], muv = mu[512 + hr], kkp = A->in[13][l * 256 + hk], kap = A->in[14][l * 256 + hk], rkp = A->in[15][l * 256 + hk];
        float Sl[32], Si[32];
#pragma unroll
        for (int k = 0; k < 32; ++k) { Sl[k] = 0.f; Si[k] = (32 * kh + k == row) ? 1.f : 0.f; }
        float vprev = 0.f, gam = 1.f;
        { const size_t mp = m0 > 0 ? m0 - 1 : 0; const float v_ = bf2f(MIXIN[mp * MIXLD + C_RW + 512 + hr]); if (t0 > 0) vprev = v_; }
        float kc[4], xr[4], xw[8], aa[4], kp0_, rp0_, vn[8];
#define RW_LOAD(sb_, VD) do { const size_t mf_ = m0 + 8 * (sb_) + 4 * w2; const size_t mp_ = mf_ > 0 ? mf_ - 1 : 0; const bool z_ = (t0 + 8 * (sb_) + 4 * w2) == 0; \
            { const float k_ = bf2f(MIXIN[mp_ * MIXLD + C_RW + 256 + hk]), r_ = bf2f(MIXIN[mp_ * MIXLD + C_RW + hk]); kp0_ = z_ ? 0.f : k_; rp0_ = z_ ? 0.f : r_; } \
            _Pragma("unroll") for (int j = 0; j < 4; ++j) { const size_t m = mf_ + j; \
            kc[j] = bf2f(MIXIN[m * MIXLD + C_RW + 256 + hk]); aa[j] = SA[m * 256 + hk]; xr[j] = bf2f(MIXIN[m * MIXLD + C_RW + hk]); } \
            _Pragma("unroll") for (int j = 0; j < 8; ++j) { xw[j] = SW[(m0 + 8 * (sb_) + j) * 256 + hk]; VD[j] = bf2f(MIXIN[(m0 + 8 * (sb_) + j) * MIXLD + C_RW + 512 + hr]); } } while (0)
#define RW_COMP(sb_) do { LAS float* ob_ = ops_u + ((sb_) & 1) * 2048 + (4 * w2) * 256; float kprev = kp0_, rprev = rp0_; \
            _Pragma("unroll") for (int j = 0; j < 8; ++j) vst[(((sb_) & 1) * 8 + j) * 64 + lane] = vn[j]; \
            _Pragma("unroll") for (int jj = 0; jj < 8; ++jj) { const float gprev = gam; gam = gam * xw[jj]; \
              if ((jj >> 2) == w2) { const int j = jj & 3; const float kl = kc[j] + (kprev - kc[j]) * muk; kprev = kc[j]; const float a = aa[j]; \
                float kk = kl * kkp; const float n2 = wave_sum_fast(kk * kk); kk = kk * __builtin_amdgcn_rsqf(fmaxf(n2, 1e-24f)); \
                const float kp = kl * (1.f + (a - 1.f) * kap); const float r = xr[j] + (rprev - xr[j]) * mur; rprev = xr[j]; const float ginv = __builtin_amdgcn_rcpf(gam); \
                ob_[j * 256 + lane] = kk * gprev; ob_[j * 256 + 64 + lane] = -kk * a * ginv; ob_[j * 256 + 128 + lane] = kp * ginv; ob_[j * 256 + 192 + lane] = r * gam; \
                const float bs = wave_sum_fast(r * kp * rkp); if (lane == 0) BS[(m0 + 8 * (sb_) + jj) * 4 + h] = bs; } } } while (0)
        __syncthreads();
        RW_LOAD(0, vn); RW_COMP(0);
#pragma unroll 1
        for (int sb = 0; sb < 8; ++sb) {
            __syncthreads();
            if (sb < 7 && VAR != 2) RW_LOAD(sb + 1, vn);
            const LAS float* ob = ops_u + (sb & 1) * 2048 + 32 * kh;
#pragma unroll 1
            for (int j = 0; j < (VAR == 1 ? 0 : 8); ++j) { const size_t m = m0 + 8 * sb + j; const LAS f32x4* o4 = (const LAS f32x4*)(ob + j * 256); const float vraw = vst[((sb & 1) * 8 + j) * 64 + lane];
                f32x4 kkc[8];
#pragma unroll
                for (int q = 0; q < 8; ++q) kkc[q] = o4[q];
                f32x4 rg[3][3];
#pragma unroll
                for (int g = 0; g < 3; ++g) { rg[g][0] = o4[16 + g]; rg[g][1] = o4[32 + g]; rg[g][2] = o4[48 + g]; }
                asm volatile("" ::: "memory");
                float sl0 = 0.f, sl1 = 0.f, si0 = 0.f, si1 = 0.f;
#pragma unroll
                for (int q = 0; q < 8; ++q) { const f32x4 kk4 = kkc[q];
                    sl0 = fmaf(Sl[4 * q], kk4[0], sl0); sl1 = fmaf(Sl[4 * q + 1], kk4[1], sl1); sl0 = fmaf(Sl[4 * q + 2], kk4[2], sl0); sl1 = fmaf(Sl[4 * q + 3], kk4[3], sl1);
                    si0 = fmaf(Si[4 * q], kk4[0], si0); si1 = fmaf(Si[4 * q + 1], kk4[1], si1); si0 = fmaf(Si[4 * q + 2], kk4[2], si0); si1 = fmaf(Si[4 * q + 3], kk4[3], si1); }
                const float sal = half_sum(sl0 + sl1), sai = half_sum(si0 + si1);
                const float v = vraw + (vprev - vraw) * muv; vprev = vraw;
                float yl0 = 0.f, yl1 = 0.f, yi0 = 0.f, yi1 = 0.f;
#pragma unroll
                for (int q = 0; q < 8; ++q) {
                    const f32x4 nb4 = rg[q % 3][0], kp4 = rg[q % 3][1], r4 = rg[q % 3][2];
#pragma unroll
                    for (int e = 0; e < 4; ++e) { const int k = 4 * q + e;
                        Sl[k] = fmaf(sal, nb4[e], fmaf(v, kp4[e], Sl[k])); Si[k] = fmaf(sai, nb4[e], Si[k]);
                        if (e & 1) { yl1 = fmaf(Sl[k], r4[e], yl1); yi1 = fmaf(Si[k], r4[e], yi1); } else { yl0 = fmaf(Sl[k], r4[e], yl0); yi0 = fmaf(Si[k], r4[e], yi0); } }
                    if (q < 5) { rg[q % 3][0] = o4[16 + q + 3]; rg[q % 3][1] = o4[32 + q + 3]; rg[q % 3][2] = o4[48 + q + 3]; }
                    asm volatile("" ::: "memory"); }
                const float yl = half_sum(yl0 + yl1), yi = half_sum(yi0 + yi1);
                if (kh == 0) { YL[m * 256 + hr] = yl; U[m * 256 + hr] = (bf16)f2bf(yi); }
                }
            if (sb < 7 && VAR != 2) { RW_COMP(sb + 1); }
            if (sb == 6 && w2 == 0) gfin[lane] = gam;
        }
#undef RW_LOAD
#undef RW_COMP
        { f32x4 gf[8];
#pragma unroll
          for (int q = 0; q < 8; ++q) gf[q] = ((const LAS f32x4*)(gfin + 32 * kh))[q];
          f32x4* lp = (f32x4*)(LS + (((size_t)bh * 128 + chunk) * 64 + row) * 64 + 32 * kh);
#pragma unroll
          for (int q = 0; q < 8; ++q) lp[q] = (f32x4){Sl[4 * q] * gf[q][0], Sl[4 * q + 1] * gf[q][1], Sl[4 * q + 2] * gf[q][2], Sl[4 * q + 3] * gf[q][3]};
          bf16* tp = TT + ((size_t)bh * 128 + chunk) * 4096 + (size_t)(32 * kh) * 64 + row;
#pragma unroll
          for (int k = 0; k < 32; ++k) tp[k * 64] = (bf16)f2bf(Si[k] * gf[k >> 2][k & 3]); }
    }
}
typedef __bf16 bf16x2_t __attribute__((ext_vector_type(2)));
__device__ __forceinline__ float dot2bf(unsigned a, unsigned b, float c) { return __builtin_amdgcn_fdot2_f32_bf16(__builtin_bit_cast(bf16x2_t, a), __builtin_bit_cast(bf16x2_t, b), c, false); }
__device__ __forceinline__ void phase_rwkv_carry(Frame& F, CArgs A, int l) {
    const float* LS = (const float*)(A->ws + WS_LS); float* SIN = (float*)(A->ws + WS_SIN); const bf16* TT = (const bf16*)(A->ws + WS_TT);
    const int lane = F.lane, tid = F.tid, wv = F.wave;
    constexpr int STG = 11264;
#pragma unroll 1
    for (int g = F.vcu >> 2; g < 64; g += (F.G + 3) / 4) {
        const int bh = g >> 3, rbase = 8 * (g & 7);
        const bf16* tsrc = TT + ((size_t)bh * 128 * 64 + (tid >> 3)) * 64 + 8 * (tid & 7);
        const float* lsrc = LS + ((size_t)bh * 128 * 64 + rbase + ((tid & 127) >> 4)) * 64 + 4 * (tid & 15);
        const int tdst = (tid >> 3) * 144 + (tid & 7) * 16, ldst = 9216 + ((tid & 127) >> 4) * 256 + (tid & 15) * 16;
        float* sp = SIN + ((size_t)bh * 128 * 64 + rbase + wv) * 64 + lane;
        v4u rt[8]; f32x4 rl[8];
#define CL_LOAD(slot, n_) do { rt[slot] = *(const v4u*)(tsrc + (size_t)(n_) * 4096); if (tid < 128) rl[slot] = *(const f32x4*)(lsrc + (size_t)(n_) * 4096); } while (0)
#define CL_WRITE(slot, n_) do { LAS unsigned char* st_ = F.lds + ((n_) & 1) * STG; *(LAS v4u*)(st_ + tdst) = rt[slot]; if (tid < 128) *(LAS f32x4*)(st_ + ldst) = rl[slot]; } while (0)
        __syncthreads();
#pragma unroll
        for (int i = 0; i < 8; ++i) CL_LOAD(i, i);
        CL_WRITE(0, 0); CL_LOAD(0, 8);
        __syncthreads();
        float s0 = 0.f;
#define CL_STEP(n_, slot) do { if ((n_) < 127) { \
            if ((n_) + 1 < 127) { CL_WRITE(((slot) + 1) & 7, (n_) + 1); if ((n_) + 9 < 127) CL_LOAD(((slot) + 1) & 7, (n_) + 9); } \
            const LAS unsigned char* st_ = F.lds + ((n_) & 1) * STG; v4u tq[8]; \
            _Pragma("unroll") for (int q = 0; q < 8; ++q) tq[q] = *(const LAS v4u*)(st_ + lane * 144 + q * 16); \
            float a0 = *(const LAS float*)(st_ + 9216 + (wv * 64 + lane) * 4), c0 = 0.f, a1 = 0.f, c1 = 0.f; \
            const unsigned p0 = pk2(s0, __shfl_down(s0, 1)); \
            _Pragma("unroll") for (int j = 0; j < 32; ++j) { const unsigned x0 = (unsigned)__builtin_amdgcn_readlane((int)p0, 2 * j); \
                const unsigned tw = (j & 3) == 0 ? tq[j >> 2].x : ((j & 3) == 1 ? tq[j >> 2].y : ((j & 3) == 2 ? tq[j >> 2].z : tq[j >> 2].w)); \
                if ((j & 3) == 0) a0 = dot2bf(tw, x0, a0); else if ((j & 3) == 1) c0 = dot2bf(tw, x0, c0); else if ((j & 3) == 2) a1 = dot2bf(tw, x0, a1); else c1 = dot2bf(tw, x0, c1); } \
            s0 = (a0 + c0) + (a1 + c1); sp[(size_t)((n_) + 1) * 4096] = s0; \
            __syncthreads(); } } while (0)
#pragma unroll 1
        for (int nb = 0; nb < 128; nb += 8) { CL_STEP(nb, 0); CL_STEP(nb + 1, 1); CL_STEP(nb + 2, 2); CL_STEP(nb + 3, 3); CL_STEP(nb + 4, 4); CL_STEP(nb + 5, 5); CL_STEP(nb + 6, 6); CL_STEP(nb + 7, 7); }
#undef CL_LOAD
#undef CL_WRITE
#undef CL_STEP
    }
}
typedef short rbf16x8 __attribute__((ext_vector_type(8)));
__device__ __forceinline__ void phase_rwkv_fix(Frame& F, CArgs A, int l) {
    LAS unsigned char* XG = F.lds;
    const bf16* MIXIN = (const bf16*)(A->ws + WS_BIG); bf16* YW = (bf16*)(A->ws + WS_YW); const float* YL = (const float*)(A->ws + WS_YL); const bf16* U = (const bf16*)(A->ws + WS_U);
    const float* SIN = (const float*)(A->ws + WS_SIN); const float* BS = (const float*)(A->ws + WS_BS); const bf16* G2T = (const bf16*)(A->ws + WS_G2T);
    const float* mu = A->in[7] + (size_t)l * 1024; const float* gn = A->in[16] + l * 256;
    const int lane = F.lane, su = F.wave >> 1, tp = F.wave & 1, ut = F.tid & 127, fr = lane & 15, fq = lane >> 4;
#pragma unroll 1
    for (int u0 = 4 * F.vcu; u0 < 1024; u0 += 4 * F.G) {
        const int unit = u0 + su, bh = unit >> 7, chunk = unit & 127, b = bh >> 2, h = bh & 3; const size_t mb = (size_t)b * SEQ + chunk * 64;
        __syncthreads();
        { const int tok = ut >> 1, q2 = ut & 1; const size_t m = mb + tok; const int t = chunk * 64 + tok;
          const v4u* cp = (const v4u*)(MIXIN + m * MIXLD + C_RW + 896 + 64 * q2); const v4u* pp = (const v4u*)(MIXIN + (m > 0 ? m - 1 : 0) * MIXLD + C_RW + 896 + 64 * q2);
#pragma unroll
          for (int c = 0; c < 8; ++c) { const v4u cw = cp[c]; v4u pw = pp[c]; if (t == 0) pw = (v4u){0u, 0u, 0u, 0u};
              const float* mup = mu + 896 + 64 * q2 + 8 * c; float o[8];
              const unsigned cwa[4] = {cw.x, cw.y, cw.z, cw.w}, pwa[4] = {pw.x, pw.y, pw.z, pw.w};
#pragma unroll
              for (int e = 0; e < 4; ++e) { const float c0 = bflo(cwa[e]), c1 = bfhi(cwa[e]), p0 = bflo(pwa[e]), p1 = bfhi(pwa[e]);
                  o[2 * e] = sigm(c0 + (p0 - c0) * mup[2 * e]); o[2 * e + 1] = sigm(c1 + (p1 - c1) * mup[2 * e + 1]); }
              v4u w; w.x = pk2(o[0], o[1]); w.y = pk2(o[2], o[3]); w.z = pk2(o[4], o[5]); w.w = pk2(o[6], o[7]);
              *(LAS v4u*)(XG + ((su * 64 + tok) * 136 + 64 * q2 + 8 * c) * 2) = w; } }
        __syncthreads();
        f32x4 acc[2][4], accg[2][4];
#pragma unroll
        for (int th = 0; th < 2; ++th)
#pragma unroll
            for (int vt = 0; vt < 4; ++vt) { acc[th][vt] = (f32x4){0.f, 0.f, 0.f, 0.f}; accg[th][vt] = (f32x4){0.f, 0.f, 0.f, 0.f}; }
        if (chunk > 0) {
            const float* sin_ = SIN + ((size_t)bh * 128 + chunk) * 4096;
#pragma unroll
            for (int ks = 0; ks < 2; ++ks) {
                const rbf16x8 af0 = *(const rbf16x8*)(U + (mb + 32 * tp + fr) * 256 + h * 64 + 32 * ks + 8 * fq);
                const rbf16x8 af1 = *(const rbf16x8*)(U + (mb + 32 * tp + 16 + fr) * 256 + h * 64 + 32 * ks + 8 * fq);
#pragma unroll
                for (int vt = 0; vt < 4; ++vt) { const f32x4* sp = (const f32x4*)(sin_ + (16 * vt + fr) * 64 + 32 * ks + 8 * fq); const f32x4 s0 = sp[0], s1 = sp[1];
                    v4u bw; bw.x = pk2(s0[0], s0[1]); bw.y = pk2(s0[2], s0[3]); bw.z = pk2(s1[0], s1[1]); bw.w = pk2(s1[2], s1[3]);
                    const rbf16x8 bfr = __builtin_bit_cast(rbf16x8, bw);
                    acc[0][vt] = __builtin_amdgcn_mfma_f32_16x16x32_bf16(af0, bfr, acc[0][vt], 0, 0, 0);
                    acc[1][vt] = __builtin_amdgcn_mfma_f32_16x16x32_bf16(af1, bfr, acc[1][vt], 0, 0, 0); } }
        }
#pragma unroll
        for (int ks = 0; ks < 4; ++ks) {
            const rbf16x8 af0 = *(const LAS rbf16x8*)(XG + ((su * 64 + 32 * tp + fr) * 136 + 32 * ks + 8 * fq) * 2);
            const rbf16x8 af1 = *(const LAS rbf16x8*)(XG + ((su * 64 + 32 * tp + 16 + fr) * 136 + 32 * ks + 8 * fq) * 2);
#pragma unroll
            for (int vt = 0; vt < 4; ++vt) { const rbf16x8 bfr = *(const rbf16x8*)(G2T + (size_t)(h * 64 + 16 * vt + fr) * 128 + 32 * ks + 8 * fq);
                accg[0][vt] = __builtin_amdgcn_mfma_f32_16x16x32_bf16(af0, bfr, accg[0][vt], 0, 0, 0);
                accg[1][vt] = __builtin_amdgcn_mfma_f32_16x16x32_bf16(af1, bfr, accg[1][vt], 0, 0, 0); } }
#pragma unroll
        for (int th = 0; th < 2; ++th)
#pragma unroll
        for (int r = 0; r < 4; ++r) { const size_t m = mb + 32 * tp + 16 * th + 4 * fq + r; const int t = chunk * 64 + 32 * tp + 16 * th + 4 * fq + r;
            float y[4]; float sm = 0.f;
#pragma unroll
            for (int vt = 0; vt < 4; ++vt) { y[vt] = YL[m * 256 + h * 64 + 16 * vt + fr] + acc[th][vt][r]; sm += y[vt]; }
            sm = row_sum16(sm);
            const float mean = sm * (1.f / 64.f); float vs = 0.f;
#pragma unroll
            for (int vt = 0; vt < 4; ++vt) { y[vt] -= mean; vs += y[vt] * y[vt]; }
            vs = row_sum16(vs);
            const float rs = __builtin_amdgcn_rsqf(vs * (1.f / 64.f) + 64e-5f); const float bsv = BS[m * 4 + h];
#pragma unroll
            for (int vt = 0; vt < 4; ++vt) { const int ch = h * 64 + 16 * vt + fr;
                const float vc = bf2f(MIXIN[m * MIXLD + C_RW + 512 + ch]), vpl = bf2f(MIXIN[(m > 0 ? m - 1 : 0) * MIXLD + C_RW + 512 + ch]), vp = t > 0 ? vpl : 0.f, vv = vc + (vp - vc) * mu[512 + ch];
                YW[m * 256 + ch] = (bf16)f2bf((y[vt] * rs * gn[ch] + bsv * vv) * accg[th][vt][r]); } }
    }
}
constexpr int LQ = 72, LKP = 136;
constexpr int RL_QS = 0, RL_KS = 18432, RL_VT = 36864, RL_KD = 54272, RL_PS = 71680;
constexpr size_t WS_UB = 1 * MiB;
typedef short rbf16x8 __attribute__((ext_vector_type(8)));
__device__ __forceinline__ void rot8(const float* rope, int pos, int c, const float* lo, const float* hi, float* olo, float* ohi) {
    const f32x4* rp = (const f32x4*)(rope + ((size_t)pos * 32 + 8 * c) * 2);
#pragma unroll
    for (int q = 0; q < 4; ++q) { const f32x4 cs = rp[q];
        olo[2 * q] = lo[2 * q] * cs[0] - hi[2 * q] * cs[1]; ohi[2 * q] = lo[2 * q] * cs[1] + hi[2 * q] * cs[0];
        olo[2 * q + 1] = lo[2 * q + 1] * cs[2] - hi[2 * q + 1] * cs[3]; ohi[2 * q + 1] = lo[2 * q + 1] * cs[3] + hi[2 * q + 1] * cs[2]; }
}
__device__ __forceinline__ void ret_stage_vt(Frame& F, const bf16* MIXIN, size_t mb, int h) {
    const int j = F.tid & 127, dg = F.tid >> 7; const v4u* vp = (const v4u*)(MIXIN + (mb + j) * MIXLD + C_RETV + h * 64 + 16 * dg);
    const v4u a = vp[0], c = vp[1]; LAS bf16* Vt = (LAS bf16*)(F.lds + RL_VT) + (16 * dg) * LKP + j;
    const unsigned w[8] = {a.x, a.y, a.z, a.w, c.x, c.y, c.z, c.w};
#pragma unroll
    for (int e = 0; e < 8; ++e) { Vt[(2 * e) * LKP] = (bf16)(w[e] & 0xffffu); Vt[(2 * e + 1) * LKP] = (bf16)(w[e] >> 16); }
}
__device__ __forceinline__ void phase_ret_state(Frame& F, CArgs A, int l) {
    const bf16* MIXIN = (const bf16*)(A->ws + WS_BIG); const float* rope = (const float*)(A->ws + WS_ROPE); bf16* UB = (bf16*)(A->ws + WS_UB);
    const int lane = F.lane, fr = lane & 15, fq = lane >> 4, w = F.wave;
#pragma unroll 1
    for (int u = F.vcu; u < 512; u += F.G) {
        const int bh = u >> 6, n = u & 63, b = bh >> 2, h = bh & 3; const size_t mb = (size_t)b * SEQ + n * 128;
        const float lg2g = log2f(1.0f - exp2f(-5.0f - (float)h));
        __syncthreads();
        { const int j = F.tid & 127, c2 = F.tid >> 7; const bf16* kp = MIXIN + (mb + j) * MIXLD + C_RETK + h * 64 + 8 * c2;
          float lo[8], hi[8], olo[8], ohi[8]; unpack8(*(const v4u*)kp, lo); unpack8(*(const v4u*)(kp + 32), hi);
          rot8(rope, n * 128 + j, c2, lo, hi, olo, ohi); const float dk = __builtin_amdgcn_exp2f((float)(127 - j) * lg2g);
          LAS bf16* Kd = (LAS bf16*)(F.lds + RL_KD) + j;
#pragma unroll
          for (int e = 0; e < 8; ++e) { Kd[(8 * c2 + e) * LKP] = (bf16)f2bf(olo[e] * dk); Kd[(32 + 8 * c2 + e) * LKP] = (bf16)f2bf(ohi[e] * dk); } }
        ret_stage_vt(F, MIXIN, mb, h);
        __syncthreads();
#pragma unroll
        for (int ti = 0; ti < 2; ++ti) { const int tI = 2 * w + ti, at = tI >> 2, ct = tI & 3; f32x4 acc = (f32x4){0.f, 0.f, 0.f, 0.f};
#pragma unroll
            for (int ks = 0; ks < 4; ++ks) { const rbf16x8 af = *(const LAS rbf16x8*)(F.lds + RL_KD + ((16 * at + fr) * LKP + 32 * ks + 8 * fq) * 2);
                const rbf16x8 bfr = *(const LAS rbf16x8*)(F.lds + RL_VT + ((16 * ct + fr) * LKP + 32 * ks + 8 * fq) * 2);
                acc = __builtin_amdgcn_mfma_f32_16x16x32_bf16(af, bfr, acc, 0, 0, 0); }
#pragma unroll
            for (int r = 0; r < 4; ++r) UB[((size_t)(bh * 64 + n) * 64 + 16 * at + 4 * fq + r) * 64 + 16 * ct + fr] = (bf16)f2bf(acc[r]); }
    }
}
__device__ __forceinline__ void phase_ret_carry(Frame& F, CArgs A, int l) {
    const bf16* UB = (const bf16*)(A->ws + WS_UB); bf16* RP = (bf16*)(A->ws + WS_RP);
    const int nthr = (F.G + 3) / 4 * NWAVES * 64;
#pragma unroll 1
    for (int e = (F.vcu >> 2) * NWAVES * 64 + F.tid; e < 32768; e += nthr) {
        const int bh = e >> 12, idx = e & 4095, h = bh & 3; const float dec = exp2f(128.0f * log2f(1.0f - exp2f(-5.0f - (float)h)));
        const bf16* p = UB + (size_t)bh * 64 * 4096 + idx; bf16* o = RP + (size_t)bh * 64 * 4096 + idx; float R = 0.f;
#pragma unroll 1
        for (int n0 = 0; n0 < 64; n0 += 32) { float u[32];
#pragma unroll
            for (int n = 0; n < 32; ++n) u[n] = bf2f(p[(size_t)(n0 + n) * 4096]);
#pragma unroll
            for (int n = 0; n < 32; ++n) { o[(size_t)(n0 + n) * 4096] = (bf16)f2bf(R); R = R * dec + u[n]; } }
    }
}
__device__ __forceinline__ void phase_fox_combine(Frame& F, CArgs A) {
    const bf16* O0 = (const bf16*)(A->ws + WS_FO0); bf16* O1 = (bf16*)(A->ws + WS_YF); const float* L0 = (const float*)(A->ws + WS_FL0); const float* L1 = (const float*)(A->ws + WS_FL1);
#pragma unroll 1
    for (int it = F.vcu * NWAVES * 64 + F.tid; it < M * 32; it += F.G * NWAVES * 64) {
        const int m = it >> 5, c8 = it & 31, h = c8 >> 3; const float l0 = L0[(size_t)m * 4 + h], l1 = L1[(size_t)m * 4 + h];
        if (l0 == -INFINITY) continue;
        const float mx = fmaxf(l0, l1), w0 = exp2f(l0 - mx), w1 = exp2f(l1 - mx), inv = 1.0f / (w0 + w1);
        const v4u a = *(const v4u*)(O0 + (size_t)m * 256 + 8 * c8); v4u* op = (v4u*)(O1 + (size_t)m * 256 + 8 * c8); const v4u c = *op;
        float fa[8], fc[8]; unpack8(a, fa); unpack8(c, fc);
#pragma unroll
        for (int e = 0; e < 8; ++e) fa[e] = (w0 * fa[e] + w1 * fc[e]) * inv;
        v4u o; o.x = pk2(fa[0], fa[1]); o.y = pk2(fa[2], fa[3]); o.z = pk2(fa[4], fa[5]); o.w = pk2(fa[6], fa[7]); *op = o;
    }
}
__device__ __forceinline__ void phase_ret_out(Frame& F, CArgs A, int l, unsigned* ctr) {
    const bf16* MIXIN = (const bf16*)(A->ws + WS_BIG); const float* rope = (const float*)(A->ws + WS_ROPE); const bf16* UB = (const bf16*)(A->ws + WS_RP);
    bf16* YR = (bf16*)(A->ws + WS_YR); const float* rgn = A->in[3] + l * 256;
    const int lane = F.lane, fr = lane & 15, fq = lane >> 4, w = F.wave;
    volatile LAS unsigned* slot = (volatile LAS unsigned*)(F.lds + STG_OFF);
    unsigned nxt = 0u; if (F.tid == 0) nxt = __hip_atomic_fetch_add(ctr, 1u, __ATOMIC_RELAXED, __HIP_MEMORY_SCOPE_AGENT);
#pragma unroll 1
    for (;;) {
        __syncthreads();
        if (F.tid == 0) slot[0] = nxt;
        __syncthreads();
        const int u = (int)__builtin_amdgcn_readfirstlane(slot[0]);
        if (u >= 512) break;
        if (F.tid == 0) nxt = __hip_atomic_fetch_add(ctr, 1u, __ATOMIC_RELAXED, __HIP_MEMORY_SCOPE_AGENT);
        const int bh = u >> 6, n = u & 63, b = bh >> 2, h = bh & 3; const size_t mb = (size_t)b * SEQ + n * 128;
        const float lg2g = log2f(1.0f - exp2f(-5.0f - (float)h));
        __syncthreads();
        { const int j = F.tid >> 2, c = F.tid & 3; const bf16* qp = MIXIN + (mb + j) * MIXLD + C_RETQ + h * 64 + 8 * c; const bf16* kp = MIXIN + (mb + j) * MIXLD + C_RETK + h * 64 + 8 * c;
          float lo[8], hi[8], olo[8], ohi[8];
          unpack8(*(const v4u*)qp, lo); unpack8(*(const v4u*)(qp + 32), hi); rot8(rope, n * 128 + j, c, lo, hi, olo, ohi);
          { v4u a, d; a.x = pk2(olo[0] * 0.125f, olo[1] * 0.125f); a.y = pk2(olo[2] * 0.125f, olo[3] * 0.125f); a.z = pk2(olo[4] * 0.125f, olo[5] * 0.125f); a.w = pk2(olo[6] * 0.125f, olo[7] * 0.125f);
            d.x = pk2(ohi[0] * 0.125f, ohi[1] * 0.125f); d.y = pk2(ohi[2] * 0.125f, ohi[3] * 0.125f); d.z = pk2(ohi[4] * 0.125f, ohi[5] * 0.125f); d.w = pk2(ohi[6] * 0.125f, ohi[7] * 0.125f);
            *(LAS v4u*)(F.lds + RL_QS + (j * LQ + 8 * c) * 2) = a; *(LAS v4u*)(F.lds + RL_QS + (j * LQ + 32 + 8 * c) * 2) = d; }
          unpack8(*(const v4u*)kp, lo); unpack8(*(const v4u*)(kp + 32), hi); rot8(rope, n * 128 + j, c, lo, hi, olo, ohi);
          { v4u a, d; a.x = pk2(olo[0], olo[1]); a.y = pk2(olo[2], olo[3]); a.z = pk2(olo[4], olo[5]); a.w = pk2(olo[6], olo[7]);
            d.x = pk2(ohi[0], ohi[1]); d.y = pk2(ohi[2], ohi[3]); d.z = pk2(ohi[4], ohi[5]); d.w = pk2(ohi[6], ohi[7]);
            *(LAS v4u*)(F.lds + RL_KS + (j * LQ + 8 * c) * 2) = a; *(LAS v4u*)(F.lds + RL_KS + (j * LQ + 32 + 8 * c) * 2) = d; } }
        ret_stage_vt(F, MIXIN, mb, h);
        if (n > 0) { const int dk = F.tid >> 3, dv0 = 8 * (F.tid & 7); const v4u rw = *(const v4u*)(UB + (size_t)(bh * 64 + n) * 4096 + dk * 64 + dv0);
            LAS bf16* Rt = (LAS bf16*)(F.lds + RL_KD) + dv0 * LQ + dk; const unsigned ww[4] = {rw.x, rw.y, rw.z, rw.w};
#pragma unroll
            for (int e = 0; e < 4; ++e) { Rt[(2 * e) * LQ] = (bf16)(ww[e] & 0xffffu); Rt[(2 * e + 1) * LQ] = (bf16)(ww[e] >> 16); } }
        __syncthreads();
        const int whalf = w >> 1;
#pragma unroll
        for (int c = 0; c < 8; ++c) { if (c <= 2 * whalf + 1) { f32x4 s = (f32x4){0.f, 0.f, 0.f, 0.f};
                if (c <= w) {
#pragma unroll
                    for (int ks = 0; ks < 2; ++ks) { const rbf16x8 af = *(const LAS rbf16x8*)(F.lds + RL_QS + ((16 * w + fr) * LQ + 32 * ks + 8 * fq) * 2);
                        const rbf16x8 bfr = *(const LAS rbf16x8*)(F.lds + RL_KS + ((16 * c + fr) * LQ + 32 * ks + 8 * fq) * 2);
                        s = __builtin_amdgcn_mfma_f32_16x16x32_bf16(af, bfr, s, 0, 0, 0); } }
#pragma unroll
                for (int r = 0; r < 4; ++r) { const int i = 16 * w + 4 * fq + r, j = 16 * c + fr; const float pv = (j <= i) ? s[r] * __builtin_amdgcn_exp2f((float)(i - j) * lg2g) : 0.f;
                    *(LAS bf16*)(F.lds + RL_PS + (i * LKP + j) * 2) = (bf16)f2bf(pv); } } }
        f32x4 o[4];
#pragma unroll
        for (int c = 0; c < 4; ++c) o[c] = (f32x4){0.f, 0.f, 0.f, 0.f};
        if (n > 0) {
#pragma unroll
            for (int ks = 0; ks < 2; ++ks) { const rbf16x8 af = *(const LAS rbf16x8*)(F.lds + RL_QS + ((16 * w + fr) * LQ + 32 * ks + 8 * fq) * 2);
#pragma unroll
                for (int c = 0; c < 4; ++c) { const rbf16x8 bfr = *(const LAS rbf16x8*)(F.lds + RL_KD + ((16 * c + fr) * LQ + 32 * ks + 8 * fq) * 2);
                    o[c] = __builtin_amdgcn_mfma_f32_16x16x32_bf16(af, bfr, o[c], 0, 0, 0); } }
#pragma unroll
            for (int r = 0; r < 4; ++r) { const float qd = __builtin_amdgcn_exp2f((float)(16 * w + 4 * fq + r + 1) * lg2g);
#pragma unroll
                for (int c = 0; c < 4; ++c) o[c][r] *= qd; }
        }
#pragma unroll
        for (int ks = 0; ks < 4; ++ks) { if (ks <= whalf) { const rbf16x8 af = *(const LAS rbf16x8*)(F.lds + RL_PS + ((16 * w + fr) * LKP + 32 * ks + 8 * fq) * 2);
#pragma unroll
                for (int c = 0; c < 4; ++c) { const rbf16x8 bfr = *(const LAS rbf16x8*)(F.lds + RL_VT + ((16 * c + fr) * LKP + 32 * ks + 8 * fq) * 2);
                    o[c] = __builtin_amdgcn_mfma_f32_16x16x32_bf16(af, bfr, o[c], 0, 0, 0); } } }
#pragma unroll
        for (int r = 0; r < 4; ++r) { const size_t m = mb + 16 * w + 4 * fq + r; float sm = (o[0][r] + o[1][r]) + (o[2][r] + o[3][r]);
            sm = row_sum16(sm);
            const float mean = sm * (1.f / 64.f); float d[4], vs = 0.f;
#pragma unroll
            for (int c = 0; c < 4; ++c) { d[c] = o[c][r] - mean; vs += d[c] * d[c]; }
            vs = row_sum16(vs);
            const float rs = __builtin_amdgcn_rsqf(vs * (1.f / 64.f) + 1e-5f);
#pragma unroll
            for (int c = 0; c < 4; ++c) { const int ch = h * 64 + 16 * c + fr; const float gg = bf2f(MIXIN[m * MIXLD + C_RETG + ch]);
                YR[m * 256 + ch] = (bf16)f2bf(d[c] * rs * rgn[ch] * (gg * sigm(gg))); } }
    }
}
constexpr int PH_PER_LAYER = 11, N_PHASES = 1 + DEPTH * PH_PER_LAYER;
#ifndef PROBE_DUP
#define PROBE_DUP 0
#endif
#ifndef PROBE_VAR
#define PROBE_VAR 0
#endif
#ifndef MK_THRL
#define MK_THRL 64
#define OUT_HI(A) ((bf16*)(A)->out + (size_t)M * D)
#define OUT_LO(A) ((bf16*)(A)->out)
#endif
#ifndef MK_ONE_LAUNCH
#define MK_ONE_LAUNCH 1
#endif
__device__ __forceinline__ Frame make_frame(unsigned char* lds_generic, int wave_s) {
    Frame F;
    asm volatile("" : "+s"(wave_s));
    int lane_v; asm volatile("v_mbcnt_lo_u32_b32 %0, -1, 0\n\tv_mbcnt_hi_u32_b32 %0, -1, %0" : "=v"(lane_v));
    int tid = wave_s * 64 + lane_v;
    int bx = blockIdx.x, G = gridDim.x; asm volatile("" : "+s"(bx), "+s"(G));
    F.lds = (LAS unsigned char*)lds_generic;
    F.MISC = (volatile LAS unsigned*)(F.lds + MISC_OFF);
    F.tid = tid; F.lane = tid & 63; F.wave = __builtin_amdgcn_readfirstlane(tid >> 6);
    F.G = G; F.vcu = (G % 8 == 0) ? (bx % 8) * (G / 8) + bx / 8 : bx; F.bx = bx;
    F.ctl = nullptr;
    return F;
}
#define IN(k) (lo <= (k) && (k) < hi)
#define SEAM(k) do { if (IN(k) && IN((k) + 1)) { int w_ = wave0; asm volatile("" : "+s"(w_)); int l_; asm volatile("v_mbcnt_lo_u32_b32 %0, -1, 0\n\tv_mbcnt_hi_u32_b32 %0, -1, %0" : "=v"(l_)); xcd_barrier(bar, w_ == 0 && l_ == 0); if ((PROBE_DUP >> 20) & 1) { xcd_barrier(bar, w_ == 0 && l_ == 0); xcd_barrier(bar, w_ == 0 && l_ == 0); } } } while (0)
#define WSP(T, off) ((T*)(A->ws + (off)))
#define LOCAL_SEAM(k) do { if (IN(k) && IN((k) + 1)) { asm volatile("s_waitcnt vmcnt(0)" ::: "memory"); __syncthreads(); __builtin_amdgcn_fence(__ATOMIC_ACQUIRE, "agent"); asm volatile("s_waitcnt vmcnt(0)" ::: "memory"); __syncthreads(); } } while (0)
#define BARRIER_NOW() do { int w_ = wave0; asm volatile("" : "+s"(w_)); int l_; asm volatile("v_mbcnt_lo_u32_b32 %0, -1, 0\n\tv_mbcnt_hi_u32_b32 %0, -1, %0" : "=v"(l_)); xcd_barrier(bar, w_ == 0 && l_ == 0); } while (0)
template <int l> __device__ __forceinline__ void run_layer(unsigned char* lds, const XcdBarrier& bar, const int lo, const int hi, const int wave0) {
        const int pb = 1 + l * PH_PER_LAYER;
        if (IN(pb + 0)) { for (int rep_ = 0; rep_ < ((PROBE_DUP >> 0) & 1) + 1; ++rep_) { if (rep_) BARRIER_NOW(); CArgs A = get_args(); Frame F = make_frame(lds, wave0); phase_weights(F, A, l); } SEAM(pb + 0); }
        if (IN(pb + 1)) { for (int rep_ = 0; rep_ < ((PROBE_DUP >> 1) & 1) + 1; ++rep_) { if (rep_) BARRIER_NOW(); CArgs A = get_args(); Frame F = make_frame(lds, wave0); pg8::Gemm g{l == 0 ? WSP(bf16, WS_XB) : OUT_HI(A), WSP(bf16, WS_WIN), M, NMIX, D, 0}; pg8::StaticOrder S; S.init(M, NMIX, F.G, F.bx);
                  pg8::EpiScale<0> E{WSP(bf16, WS_BIG), MIXLD, WSP(float, WS_SS1), WSP(float, WS_FLOG), 11, 11};
                  pg8::gemm_phase<pg8::EpiScale<0>, pg8::StaticOrder, PG8_ALIGN, PG8_SP2>(F.lds + RING_OFF, g, S, E, F.tid); } SEAM(pb + 1); }
        if (IN(pb + 2)) { for (int rep_ = 0; rep_ < ((PROBE_DUP >> 2) & 1) + 1; ++rep_) { if (rep_) BARRIER_NOW(); { CArgs A = get_args(); Frame F = make_frame(lds, wave0); phase_cumsum(F, A, l); if (rep_ == 0) phase_fox_prep(F, A, l); } { CArgs A = get_args(); Frame F = make_frame(lds, wave0); phase_rwkv_prep(F, A, l); } { CArgs A = get_args(); Frame F = make_frame(lds, wave0); phase_ret_state(F, A, l); } } SEAM(pb + 2); }
        if (IN(pb + 3)) { for (int rep_ = 0; rep_ < ((PROBE_DUP >> 3) & 1) + 1; ++rep_) { if (rep_) BARRIER_NOW(); CArgs A = get_args(); Frame F = make_frame(lds, wave0); phase_rwkv_scan1<0>(F, A, l); } { CArgs A = get_args(); Frame F = make_frame(lds, wave0); if ((F.vcu & 3) == 1) phase_ret_carry(F, A, l); } SEAM(pb + 3); }
        if (IN(pb + 4)) { { CArgs A = get_args(); Frame F = make_frame(lds, wave0); if ((F.vcu & 3) == 0) phase_rwkv_carry(F, A, l); }

#if (PROBE_DUP >> 11) & 1
                  BARRIER_NOW(); { CArgs A = get_args(); Frame F = make_frame(lds, wave0); if ((F.vcu & 3) == 0) phase_rwkv_carry(F, A, l); }

#endif
                  #if (PROBE_DUP >> 12) & 1
                  { CArgs A = get_args(); Frame F = make_frame(lds, wave0);
                    const attn_body::AttnTensors AT{(const attn_body::bf16*)WSP(bf16, WS_BIG) + C_FOXQ, (const attn_body::bf16*)WSP(bf16, WS_BIG) + C_FOXK, (const attn_body::bf16*)WSP(bf16, WS_BIG) + C_FOXV,
                        (attn_body::bf16*)WSP(bf16, WS_FO0), (attn_body::bf16*)WSP(bf16, WS_YF), WSP(float, WS_FL0), WSP(float, WS_FL1), WSP(float, WS_CUM), WSP(float, WS_SEGT)};
                    attn_body::attn_phase_queue<MK_THRL, PROBE_VAR>((char*)lds + RING_OFF, AT, fox_skip_threshold(F, A, l), (unsigned*)(A->ws + WS_CTL) + CW_QUEUE + 64 * l + 32, (volatile LAS unsigned*)((LAS unsigned char*)lds + STG_OFF), F.tid); } BARRIER_NOW();
#endif
                  { CArgs A = get_args(); Frame F = make_frame(lds, wave0);
                    const attn_body::AttnTensors AT{(const attn_body::bf16*)WSP(bf16, WS_BIG) + C_FOXQ, (const attn_body::bf16*)WSP(bf16, WS_BIG) + C_FOXK, (const attn_body::bf16*)WSP(bf16, WS_BIG) + C_FOXV,
                        (attn_body::bf16*)WSP(bf16, WS_FO0), (attn_body::bf16*)WSP(bf16, WS_YF), WSP(float, WS_FL0), WSP(float, WS_FL1), WSP(float, WS_CUM), WSP(float, WS_SEGT)};
                    attn_body::attn_phase_queue<MK_THRL>((char*)lds + RING_OFF, AT, fox_skip_threshold(F, A, l), (unsigned*)(A->ws + WS_CTL) + CW_QUEUE + 64 * l, (volatile LAS unsigned*)((LAS unsigned char*)lds + STG_OFF), F.tid); }

                  { CArgs A = get_args(); Frame F = make_frame(lds, wave0); phase_ret_out(F, A, l, (unsigned*)(A->ws + WS_CTL) + CW_QUEUE + 64 * l + 16); }
                  SEAM(pb + 4); }
        if (IN(pb + 5)) { for (int rep_ = 0; rep_ < ((PROBE_DUP >> 5) & 1) + 1; ++rep_) { if (rep_) BARRIER_NOW(); { CArgs A = get_args(); Frame F = make_frame(lds, wave0); phase_rwkv_fix(F, A, l); if ((PROBE_DUP >> 16) & 1) { BARRIER_NOW(); phase_rwkv_fix(F, A, l); } }  { CArgs A = get_args(); Frame F = make_frame(lds, wave0); phase_fox_combine(F, A); } } SEAM(pb + 5); }
        if (IN(pb + 6)) { for (int rep_ = 0; rep_ < ((PROBE_DUP >> 6) & 1) + 1; ++rep_) { if (rep_) BARRIER_NOW(); CArgs A = get_args(); Frame F = make_frame(lds, wave0); pg8::Gemm g{l == 0 ? WSP(bf16, WS_XB) : OUT_HI(A), WSP(bf16, WS_WGATE), M, NGATE, D, 0}; pg8::StaticOrder S; S.init(M, NGATE, F.G, F.bx);
                  pg8::EpiScale<1> E{WSP(bf16, WS_BIG), NGATE, WSP(float, WS_SS1), nullptr, -1, 12};
                  pg8::gemm_phase<pg8::EpiScale<1>, pg8::StaticOrder, PG8_ALIGN, PG8_SP2>(F.lds + RING_OFF, g, S, E, F.tid); } SEAM(pb + 6); }
        if (IN(pb + 7)) { for (int rep_ = 0; rep_ < ((PROBE_DUP >> 7) & 1) + 1; ++rep_) { if (rep_) BARRIER_NOW();
                  { CArgs A = get_args(); Frame F = make_frame(lds, wave0); pg8::StaticOrder S; S.init(2 * M, D, F.G, F.bx);
                    pg8::gemm_phase_seg<pg8::StaticOrder>(F.lds + RING_OFF, WSP(bf16, WS_YR), WSP(bf16, WS_YF), WSP(bf16, WS_YW), WSP(bf16, WS_PBR), WSP(bf16, WS_BIG), WSP(bf16, WS_XB), S, F.tid); }
                  } SEAM(pb + 7); }
        if (IN(pb + 8)) { if ((PROBE_DUP >> 8) & 1) { CArgs A = get_args(); Frame F = make_frame(lds, wave0); pg8::Gemm g{WSP(bf16, WS_XB), WSP(bf16, WS_WOUT), M, D, D, 0}; pg8::StaticOrder S; S.init(M, D, F.G, F.bx); pg8::EpiProbe E{A->out, A->ph_hi < 0};
                  pg8::gemm_phase<pg8::EpiProbe, pg8::StaticOrder, PG8_ALIGN, PG8_SP2>(F.lds + RING_OFF, g, S, E, F.tid); BARRIER_NOW(); }
                  CArgs A = get_args(); Frame F = make_frame(lds, wave0); pg8::Gemm g{WSP(bf16, WS_XB), WSP(bf16, WS_WOUT), M, D, D, 0}; pg8::StaticOrder S; S.init(M, D, F.G, F.bx);
                  if constexpr (l == 0) { pg8::EpiResid<true, false> E{A->in[0], nullptr, nullptr, nullptr, WSP(bf16, WS_RB), WSP(bf16, WS_XLO), WSP(float, WS_SS2)};
                      pg8::gemm_phase<pg8::EpiResid<true, false>, pg8::StaticOrder, false, PG8_SP2>(F.lds + RING_OFF, g, S, E, F.tid); }
                  else { pg8::EpiResid<false, false> E{nullptr, OUT_HI(A), OUT_LO(A), nullptr, WSP(bf16, WS_RB), WSP(bf16, WS_XLO), WSP(float, WS_SS2)};
                      pg8::gemm_phase<pg8::EpiResid<false, false>, pg8::StaticOrder, false, PG8_SP2>(F.lds + RING_OFF, g, S, E, F.tid); }
                  SEAM(pb + 8); }
        if (IN(pb + 9)) { for (int rep_ = 0; rep_ < ((PROBE_DUP >> 9) & 1) + 1; ++rep_) { if (rep_) BARRIER_NOW(); CArgs A = get_args(); Frame F = make_frame(lds, wave0); pg8::Gemm g{WSP(bf16, WS_RB), WSP(bf16, WS_WGU), M, NGU, D, 0}; pg8::HalfTailOrder S; S.init(M, NGU, F.G, F.bx);
                  pg8::EpiSwiglu E{WSP(bf16, WS_BIG), WSP(float, WS_SS2)};
                  pg8::gemm_phase<pg8::EpiSwiglu, pg8::HalfTailOrder, PG8_ALIGN, PG8_SP2>(F.lds + RING_OFF, g, S, E, F.tid); } SEAM(pb + 9); }
        if (IN(pb + 10)) { if ((PROBE_DUP >> 10) & 1) { CArgs A = get_args(); Frame F = make_frame(lds, wave0); pg8::Gemm g{WSP(bf16, WS_BIG), WSP(bf16, WS_WDOWN), M, D, DFF, 0}; pg8::StaticOrder S; S.init(M, D, F.G, F.bx); pg8::EpiProbe E{A->out, A->ph_hi < 0};
                  pg8::gemm_phase<pg8::EpiProbe, pg8::StaticOrder, PG8_ALIGN, PG8_SP2>(F.lds + RING_OFF, g, S, E, F.tid); BARRIER_NOW(); }
                  CArgs A = get_args(); Frame F = make_frame(lds, wave0); pg8::Gemm g{WSP(bf16, WS_BIG), WSP(bf16, WS_WDOWN), M, D, DFF, 0}; pg8::StaticOrder S; S.init(M, D, F.G, F.bx);
                  if constexpr (l == DEPTH - 1) { pg8::EpiResid<false, true> E{nullptr, WSP(bf16, WS_RB), WSP(bf16, WS_XLO), A->out, nullptr, nullptr, nullptr};
                      pg8::gemm_phase<pg8::EpiResid<false, true>, pg8::StaticOrder, false, PG8_SP2>(F.lds + RING_OFF, g, S, E, F.tid); }
                  else { pg8::EpiResid<false, false> E{nullptr, WSP(bf16, WS_RB), WSP(bf16, WS_XLO), nullptr, OUT_HI(A), OUT_LO(A), WSP(float, WS_SS1)};
                      pg8::gemm_phase<pg8::EpiResid<false, false>, pg8::StaticOrder, false, PG8_SP2>(F.lds + RING_OFF, g, S, E, F.tid); }
                  SEAM(pb + 10); }
    }
#ifndef MK_NO_PK
#define MK_NO_PK 0
#endif
#if MK_NO_PK
#define MK_KATTR __attribute__((target("no-packed-fp32-ops")))
#else
#define MK_KATTR
#endif
__global__ void __launch_bounds__(NWAVES * 64, 2) MK_KATTR mega_fwd(Args args) {
    extern __shared__ __attribute__((aligned(16))) unsigned char lds[];
    const int wave0 = __builtin_amdgcn_readfirstlane((int)threadIdx.x >> 6);
    { const int tid0 = threadIdx.x;
      for (int u = tid0; u < (LDS_BYTES - LDSCTL_OFF) / 4; u += NWAVES * 64) ((LAS unsigned*)((LAS unsigned char*)lds + LDSCTL_OFF))[u] = 0u; }
    __syncthreads();
    XcdBarrier bar = xcd_barrier_post((unsigned*)((gu32*)(args.ws + WS_CTL) + CW_BAR), (volatile LAS unsigned*)((LAS unsigned char*)lds + MISC_OFF) + 8);
    const int lo = args.ph_lo, hi = args.ph_hi;
    if (IN(0)) { CArgs A = get_args(); Frame F = make_frame(lds, wave0); phase_prologue(F, A); }
    run_layer<0>(lds, bar, lo, hi, wave0);
    run_layer<1>(lds, bar, lo, hi, wave0);
}

#undef IN
#undef SEAM
#undef WSP
#undef LOCAL_SEAM
#undef BARRIER_NOW
extern "C" void kernel_launch(void* const* d_in, const int* in_sizes, int n_in, void* d_out, int out_size, void* d_ws, size_t ws_size, hipStream_t stream) {
    static int grid = 0;
    if (grid == 0) {
        if (n_in != 24 || in_sizes[0] != M * D || out_size != M * D || ws_size < WS_END) { fprintf(stderr, "kernel_launch: unexpected shapes (n_in %d, in0 %d, out %d, ws %zu); nothing launched\n", n_in, n_in > 0 ? in_sizes[0] : -1, out_size, ws_size); grid = -1; return; }
        int dev = 0, cus = 0;
        if (hipGetDevice(&dev) != hipSuccess || hipDeviceGetAttribute(&cus, hipDeviceAttributeMultiprocessorCount, dev) != hipSuccess) { grid = -1; return; }
        if (hipFuncSetAttribute((const void*)mega_fwd, hipFuncAttributeMaxDynamicSharedMemorySize, LDS_BYTES) != hipSuccess) { fprintf(stderr, "kernel_launch: hipFuncSetAttribute failed\n"); grid = -1; return; }
        (void)hipGetLastError();
        grid = cus;
    }
    if (grid < 0) return;
    if (hipMemsetAsync((char*)d_ws + WS_CTL, 0, CTL_ZERO_BYTES, stream) != hipSuccess) return;
    Args a{};
    for (int i = 0; i < 24; ++i) a.in[i] = (const float*)d_in[i];
    a.out = (float*)d_out; a.ws = (unsigned char*)d_ws;
#if MK_ONE_LAUNCH
    a.ph_lo = 0; a.ph_hi = N_PHASES;
    hipLaunchKernelGGL(mega_fwd, dim3(grid), dim3(NWAVES * 64), LDS_BYTES, stream, a);
#else
    for (int ph = 0; ph < N_PHASES; ++ph) { a.ph_lo = ph; a.ph_hi = ph + 1;
        hipLaunchKernelGGL(mega_fwd, dim3(grid), dim3(NWAVES * 64), LDS_BYTES, stream, a); }
#endif
}
```

```cpp
#include <hip/hip_runtime.h>
#include <cstdio>
#include <cstdint>
#include <cmath>
namespace pg8 {
#define PG8_LAS __attribute__((address_space(3)))
typedef unsigned short bf16_t;
typedef short bf16x8 __attribute__((ext_vector_type(8)));
typedef float f32x4 __attribute__((ext_vector_type(4)));
typedef unsigned u32x4 __attribute__((ext_vector_type(4)));
constexpr int BM = 256, BK = 64, HALF = 128, HTB = HALF * BK * 2  , STAGE_BYTES = 8 * HTB, NXCD = 8, WGM = 4;

__host__ __device__ __forceinline__ int lds_byte(int r, int c) { const int st = (r >> 4) * 2 + (c >> 5), rr = r & 15, cc = c & 31, ob = rr * 64 + cc * 2; return st * 1024 + (ob ^ (((ob >> 9) & 1) << 5)); }
__host__ __device__ __forceinline__ void stage_rc(int b, int& R, int& C) { const int st = b / 1024, sb = b % 1024, swz = sb ^ (((sb >> 9) & 1) << 5); R = (st >> 1) * 16 + swz / 64; C = (st & 1) * 32 + (swz % 64) / 2; }
__host__ __device__ __forceinline__ int perm32(int rho) { const int n = rho >> 4, i = rho & 15; return 8 * (i >> 2) + 4 * n + (i & 3); }

struct Unit { int pm, pn, half; };
struct Gemm { const bf16_t* A; const bf16_t* Bt; int M, N, K, lda; };

struct StaticOrder {
    static constexpr bool HALVES = false;
    int nM, nN, nwg, G, c;
    __host__ __device__ void init(int M, int N, int G_, int c_) { nM = M / BM; nN = N / BM; nwg = nM * nN; G = G_; c = c_; }
    __host__ __device__ bool next(int i, Unit& u) const {
        const long L = (long)i * G + c; if (L >= nwg) return false;
        int wgid = (int)L; { const int q = nwg / NXCD, r = nwg % NXCD, xcd = wgid % NXCD, off = wgid / NXCD; wgid = (xcd < r ? xcd * (q + 1) : r * (q + 1) + (xcd - r) * q) + off; }
        const int nig = WGM * nN, gid = wgid / nig, fm = gid * WGM, gsz = (nM - fm) < WGM ? (nM - fm) : WGM;
        u.pm = fm + ((wgid % nig) % gsz); u.pn = (wgid % nig) / gsz; u.half = 0; return true;
    }
    __device__ __forceinline__ void a_ready(const Unit&) const {}
    __device__ __forceinline__ void done(const Unit&) const {}
};
struct GateOrder {
    static constexpr bool HALVES = false;
    StaticOrder base;
    __host__ __device__ void init(int M, int G_, int c_) { base.init(M, 1024, G_, c_); }
    __host__ __device__ bool next(int i, Unit& u) const { Unit b; if (!base.next(i / 3, b)) return false; u.pm = b.pm; u.pn = b.pn + 4 * (i % 3); u.half = 0; return true; }
    __device__ __forceinline__ void a_ready(const Unit&) const {}
    __device__ __forceinline__ void done(const Unit&) const {}
};
struct HalfTailOrder : StaticOrder {
    static constexpr bool HALVES = true;
    __host__ __device__ bool next(int i, Unit& u) const {
        const int full = (nwg / G) * G, rem = nwg - full;
        if ((long)i * G + c < full || rem * 2 != G) return StaticOrder::next(i, u);
        if ((long)i * G != full) return false;
        StaticOrder t = *this; t.c = 0; t.G = 1; if (!t.next(full + (c >> 1), u)) return false;
        u.half = 1 + (c & 1); return true;
    }
};

typedef unsigned u32x4 __attribute__((ext_vector_type(4)));
typedef float f32x2e __attribute__((ext_vector_type(2))); typedef __bf16 bf16x2e __attribute__((ext_vector_type(2)));
__device__ __forceinline__ unsigned pk2_(float lo, float hi) { const f32x2e v = {lo, hi}; return __builtin_bit_cast(unsigned, __builtin_convertvector(v, bf16x2e)); }
__device__ __forceinline__ float bflo_(unsigned w) { return __builtin_bit_cast(float, w << 16); }
__device__ __forceinline__ float bfhi_(unsigned w) { return __builtin_bit_cast(float, w & 0xffff0000u); }
__device__ __forceinline__ float sigmoidf_(float x) { return __builtin_amdgcn_rcpf(1.0f + __expf(-x)); }
__device__ __forceinline__ void rstd8(const float* ss, int row0, float (&rs)[8]) {
    f32x4 v[8];
#pragma unroll
    for (int i = 0; i < 8; ++i) v[i] = *(const f32x4*)(ss + (unsigned)(row0 + (i >> 2) * HALF + (i & 3) * 16) * 4u);
#pragma unroll
    for (int i = 0; i < 8; ++i) rs[i] = __builtin_amdgcn_rsqf(((v[i][0] + v[i][1]) + (v[i][2] + v[i][3])) * (1.0f / 1024.0f) + 1e-6f);
}

template <int ACT> struct EpiScale {
    static constexpr bool PERM = true, AFTER_DRAIN = false;
    bf16_t* O; int ldc; const float* ss; float* flog; int flog_tile; int store_tiles;
    __device__ __forceinline__ void operator()(const f32x4 (&acc)[2][2][4][2], const Unit& u, int wr, int wc, int fr, int fq) const {
        const int row0 = u.pm * BM + wr * 64 + fr, col0 = u.pn * BM + wc * 32 + 8 * fq;
        float rs[8]; rstd8(ss, row0, rs);
#pragma unroll
        for (int ai = 0; ai < 2; ++ai)
#pragma unroll
            for (int m = 0; m < 4; ++m) { const int row = row0 + ai * HALF + m * 16; const float r_ = rs[ai * 4 + m];
#pragma unroll
                for (int bj = 0; bj < 2; ++bj) { f32x4 v0 = acc[ai][bj][m][0] * r_, v1 = acc[ai][bj][m][1] * r_;
                    if (ACT == 1) { v0 = (f32x4){sigmoidf_(v0[0]), sigmoidf_(v0[1]), sigmoidf_(v0[2]), sigmoidf_(v0[3])}; v1 = (f32x4){sigmoidf_(v1[0]), sigmoidf_(v1[1]), sigmoidf_(v1[2]), sigmoidf_(v1[3])}; }
                    if (u.pn < store_tiles) { u32x4 w; w.x = pk2_(v0[0], v0[1]); w.y = pk2_(v0[2], v0[3]); w.z = pk2_(v1[0], v1[1]); w.w = pk2_(v1[2], v1[3]);
                        *(u32x4*)(O + ((unsigned)row * (unsigned)ldc + (unsigned)(col0 + bj * HALF))) = w; }
                    if (u.pn == flog_tile && bj == 0 && wc == 0 && fq == 0) *(f32x4*)(flog + (unsigned)row * 4u) = v0; } }
    }
};
template <int FIRST> struct EpiBranch {
    static constexpr bool PERM = true, AFTER_DRAIN = false;
    bf16_t* T; const bf16_t* gates; int gcol0;
    __device__ __forceinline__ void operator()(const f32x4 (&acc)[2][2][4][2], const Unit& u, int wr, int wc, int fr, int fq) const {
        const int row0 = u.pm * BM + wr * 64 + fr, col0 = u.pn * BM + wc * 32 + 8 * fq;
#pragma unroll
        for (int ai = 0; ai < 2; ++ai)
#pragma unroll
        for (int mh = 0; mh < 2; ++mh) { u32x4 g[2][2], p[2][2];
#pragma unroll
            for (int mm = 0; mm < 2; ++mm)
#pragma unroll
                for (int bj = 0; bj < 2; ++bj) { const int row = row0 + ai * HALF + (2 * mh + mm) * 16, col = col0 + bj * HALF;
                    g[mm][bj] = *(const u32x4*)(gates + ((unsigned)row * 3072u + (unsigned)(gcol0 + col)));
                    if (!FIRST) p[mm][bj] = *(const u32x4*)(T + ((unsigned)row * 1024u + (unsigned)col)); else p[mm][bj] = (u32x4){0u, 0u, 0u, 0u}; }
#pragma unroll
            for (int mm = 0; mm < 2; ++mm)
#pragma unroll
                for (int bj = 0; bj < 2; ++bj) { const int m = 2 * mh + mm, row = row0 + ai * HALF + m * 16, col = col0 + bj * HALF;
                    const f32x4 a0 = acc[ai][bj][m][0], a1 = acc[ai][bj][m][1]; const u32x4 gg = g[mm][bj], pp = p[mm][bj]; u32x4 w;
                    w.x = pk2_(bflo_(pp.x) + bflo_(gg.x) * a0[0], bfhi_(pp.x) + bfhi_(gg.x) * a0[1]);
                    w.y = pk2_(bflo_(pp.y) + bflo_(gg.y) * a0[2], bfhi_(pp.y) + bfhi_(gg.y) * a0[3]);
                    w.z = pk2_(bflo_(pp.z) + bflo_(gg.z) * a1[0], bfhi_(pp.z) + bfhi_(gg.z) * a1[1]);
                    w.w = pk2_(bflo_(pp.w) + bflo_(gg.w) * a1[2], bfhi_(pp.w) + bfhi_(gg.w) * a1[3]);
                    *(u32x4*)(T + ((unsigned)row * 1024u + (unsigned)col)) = w; }
            asm volatile("" ::: "memory"); }
    }
};
template <bool IN_F32, bool OUT_F32> struct EpiResid {
    static constexpr bool PERM = true, AFTER_DRAIN = true;
    const float* Xin; const bf16_t* Hin; const bf16_t* Lin; float* X; bf16_t* Hout; bf16_t* Lout; float* ss;
    __device__ __forceinline__ void ldx(u32x4 (&x)[2][2][2], int row0, int col0, int b) const {
#pragma unroll
        for (int mm = 0; mm < 2; ++mm)
#pragma unroll
            for (int bj = 0; bj < 2; ++bj) { const unsigned xoff = (unsigned)(row0 + (b >> 1) * HALF + ((b & 1) * 2 + mm) * 16) * 1024u + (unsigned)(col0 + bj * HALF);
                if (IN_F32) { x[mm][bj][0] = *(const u32x4*)(Xin + xoff); x[mm][bj][1] = *(const u32x4*)(Xin + xoff + 4); }
                else { x[mm][bj][0] = *(const u32x4*)(Hin + xoff); x[mm][bj][1] = *(const u32x4*)(Lin + xoff); } }
    }
    __device__ __forceinline__ void fused(f32x4 (&acc)[2][2][4][2], const Unit& u, int wr, int wc, int fr, int fq, PG8_LAS unsigned char* lds, int wid, int lane) const {
        const int row0 = u.pm * BM + wr * 64 + fr, col0 = u.pn * BM + wc * 32 + 8 * fq;
        PG8_LAS float* P = (PG8_LAS float*)lds;
        u32x4 x[2][2][2][2];
        ldx(x[0], row0, col0, 0);
#pragma unroll
        for (int b = 0; b < 4; ++b) { const int ai = b >> 1;
            if (b + 1 < 4) ldx(x[(b + 1) & 1], row0, col0, b + 1);
#pragma unroll
            for (int mm = 0; mm < 2; ++mm) { const int m = (b & 1) * 2 + mm; const int row = row0 + ai * HALF + m * 16; float q = 0.f;
#pragma unroll
                for (int bj = 0; bj < 2; ++bj) { const unsigned xoff = (unsigned)row * 1024u + (unsigned)(col0 + bj * HALF);
                    const u32x4 r0 = x[b & 1][mm][bj][0], r1 = x[b & 1][mm][bj][1]; f32x4 x0, x1;
                    if (IN_F32) { x0 = __builtin_bit_cast(f32x4, r0); x1 = __builtin_bit_cast(f32x4, r1); }
                    else { x0 = (f32x4){bflo_(r0.x) + bflo_(r1.x), bfhi_(r0.x) + bfhi_(r1.x), bflo_(r0.y) + bflo_(r1.y), bfhi_(r0.y) + bfhi_(r1.y)};
                           x1 = (f32x4){bflo_(r0.z) + bflo_(r1.z), bfhi_(r0.z) + bfhi_(r1.z), bflo_(r0.w) + bflo_(r1.w), bfhi_(r0.w) + bfhi_(r1.w)}; }
                    const f32x4 v0 = x0 + acc[ai][bj][m][0], v1 = x1 + acc[ai][bj][m][1];
                    if (OUT_F32) { *(f32x4*)(X + xoff) = v0; *(f32x4*)(X + xoff + 4) = v1; }
                    else { u32x4 w; w.x = pk2_(v0[0], v0[1]); w.y = pk2_(v0[2], v0[3]); w.z = pk2_(v1[0], v1[1]); w.w = pk2_(v1[2], v1[3]);
                        u32x4 e; e.x = pk2_(v0[0] - bflo_(w.x), v0[1] - bfhi_(w.x)); e.y = pk2_(v0[2] - bflo_(w.y), v0[3] - bfhi_(w.y)); e.z = pk2_(v1[0] - bflo_(w.z), v1[1] - bfhi_(w.z)); e.w = pk2_(v1[2] - bflo_(w.w), v1[3] - bfhi_(w.w));
                        *(u32x4*)(Hout + xoff) = w; *(u32x4*)(Lout + xoff) = e;
                        q += (v0[0] * v0[0] + v0[1] * v0[1]) + (v0[2] * v0[2] + v0[3] * v0[3]) + (v1[0] * v1[0] + v1[1] * v1[1]) + (v1[2] * v1[2] + v1[3] * v1[3]); } }
                if (!OUT_F32) { q += __shfl_xor(q, 16); q += __shfl_xor(q, 32);
                    if (fq == 0) P[(ai * HALF + wr * 64 + m * 16 + fr) * 4 + wc] = q; } }
            asm volatile("" ::: "memory"); }
        if (OUT_F32) return;
        asm volatile("s_waitcnt lgkmcnt(0)" ::: "memory"); __builtin_amdgcn_s_barrier(); asm volatile("" ::: "memory");
        if (lane < 32) { const int row = wid * 32 + lane; const f32x4 pv = *(const PG8_LAS f32x4*)(P + row * 4);
            ss[(unsigned)(u.pm * BM + row) * 4u + (unsigned)u.pn] = (pv[0] + pv[1]) + (pv[2] + pv[3]); }
    }
};
struct EpiSwiglu {
    static constexpr bool PERM = true, AFTER_DRAIN = false;
    bf16_t* H; const float* ss;
    __device__ __forceinline__ void operator()(const f32x4 (&acc)[2][2][4][2], const Unit& u, int wr, int wc, int fr, int fq) const {
        const int row0 = u.pm * BM + wr * 64 + fr, col0 = u.pn * HALF + wc * 32 + 8 * fq;
        float rs[8]; rstd8(ss, row0, rs);
#pragma unroll
        for (int ai = 0; ai < 2; ++ai) { if (u.half == 2 - ai) continue;
#pragma unroll
            for (int m = 0; m < 4; ++m) { const int row = row0 + ai * HALF + m * 16; const float r_ = rs[ai * 4 + m];
                float h[8];
#pragma unroll
                for (int n = 0; n < 2; ++n)
#pragma unroll
                    for (int i = 0; i < 4; ++i) { const float g = acc[ai][0][m][n][i] * r_, uu = acc[ai][1][m][n][i] * r_; h[4 * n + i] = g * sigmoidf_(g) * uu; }
                u32x4 w; w.x = pk2_(h[0], h[1]); w.y = pk2_(h[2], h[3]); w.z = pk2_(h[4], h[5]); w.w = pk2_(h[6], h[7]);
                *(u32x4*)(H + ((unsigned)row * 2816u + (unsigned)col0)) = w; } }
    }
};
struct EpiProbe {
    static constexpr bool PERM = true, AFTER_DRAIN = false;
    float* sink; int flag;
    __device__ __forceinline__ void operator()(const f32x4 (&acc)[2][2][4][2], const Unit& u, int wr, int wc, int fr, int fq) const {
        if (flag) {
#pragma unroll
            for (int ai = 0; ai < 2; ++ai)
#pragma unroll
                for (int bj = 0; bj < 2; ++bj)
#pragma unroll
                    for (int m = 0; m < 4; ++m)
#pragma unroll
                        for (int n = 0; n < 2; ++n) *(f32x4*)(sink + (((u.pm * 4 + u.pn) * 512 + wr * 256 + wc * 64 + fq * 16 + fr) * 16 + ai * 8 + bj * 4 + m) * 8 + n * 4) = acc[ai][bj][m][n]; }
    }
};
template <class Epi, class Sched, bool ALIGN_EPI = false, bool SP2 = false>
__device__ __forceinline__ void gemm_phase(PG8_LAS unsigned char* lds, const Gemm g, const Sched& S, const Epi& E, const int tid) {
    const int wid = __builtin_amdgcn_readfirstlane(tid >> 6), lane = tid & 63, wr = wid >> 2, wc = wid & 3, fr = lane & 15, fq = lane >> 4;
    const int K = g.K, nt = K / BK, lda = g.lda ? g.lda : g.K;
    unsigned voffA[2], voffB[2];
#pragma unroll
    for (int i = 0; i < 2; ++i) { int R, C; stage_rc(tid * 16 + i * 8192, R, C); const int Rb = Epi::PERM ? ((R & ~31) + perm32(R & 31)) : R;
        voffA[i] = (unsigned)(R * lda + C) * 2u; voffB[i] = (unsigned)(Rb * K + C) * 2u; }
    const size_t kstep = (size_t)(BK * 2);
    const size_t hstep = (size_t)HALF * K * 2;
    const size_t tstep = 2 * hstep;
    const size_t hstepA = (size_t)HALF * lda * 2, tstepA = 2 * hstepA;
    const unsigned ldsw = (unsigned)wid * 1024u;
    const int aoff = lds_byte(wr * 64 + fr, fq * 8), boff = lds_byte(wc * 32 + fr, fq * 8);
#define PG8_SA(b, h) (((b) * 2 + (h)) * HTB)
#define PG8_SB(b, h) ((4 + (b) * 2 + (h)) * HTB)
#define PG8_STAGE(bufoff, gbase, voff) do { _Pragma("unroll") for (int _i = 0; _i < 2; ++_i) \
        __builtin_amdgcn_global_load_lds((const unsigned*)((const char*)(gbase) + (voff)[_i]), (PG8_LAS unsigned*)(lds + (bufoff) + ldsw + _i * 8192), 16, 0, 0); } while (0)
#define PG8_LDA(dst, b, h) do { _Pragma("unroll") for (int m = 0; m < 4; ++m) _Pragma("unroll") for (int k = 0; k < 2; ++k) dst[m][k] = *(const PG8_LAS bf16x8*)(lds + PG8_SA(b, h) + aoff + m * 2048 + k * 1024); } while (0)
#define PG8_LDB(dst, b, h) do { _Pragma("unroll") for (int n = 0; n < 2; ++n) _Pragma("unroll") for (int k = 0; k < 2; ++k) dst[n][k] = *(const PG8_LAS bf16x8*)(lds + PG8_SB(b, h) + boff + n * 2048 + k * 1024); } while (0)
#define PG8_MMA(ai, bj, At, Bt) do { __builtin_amdgcn_s_setprio(1); _Pragma("unroll") for (int m = 0; m < 4; ++m) _Pragma("unroll") for (int n = 0; n < 2; ++n) _Pragma("unroll") for (int k = 0; k < 2; ++k) \
        acc[ai][bj][m][n] = __builtin_amdgcn_mfma_f32_16x16x32_bf16(Bt[n][k], At[m][k], acc[ai][bj][m][n], 0, 0, 0); __builtin_amdgcn_s_setprio(0); } while (0)
#define PG8_WAIT_V(n) asm volatile("s_waitcnt vmcnt(" #n ")" ::: "memory")
#define PG8_WAIT_L(n) asm volatile("s_waitcnt lgkmcnt(" #n ")" ::: "memory")
#define PG8_BAR __builtin_amdgcn_s_barrier()
#define PG8_SCHED __builtin_amdgcn_sched_barrier(0)
    Unit cur, nxt; int ui = 0;
    if (!S.next(0, cur)) return;
    f32x4 acc[2][2][4][2];
#pragma unroll
    for (int a = 0; a < 2; ++a)
#pragma unroll
        for (int b = 0; b < 2; ++b)
#pragma unroll
            for (int m = 0; m < 4; ++m)
#pragma unroll
                for (int n = 0; n < 2; ++n) acc[a][b][m][n] = (f32x4){0.f, 0.f, 0.f, 0.f};
    bf16x8 At[4][2], B0[2][2], B1[2][2];
    const char* cA = (const char*)g.A + (size_t)cur.pm * tstepA; const char* cB = (const char*)g.Bt + (size_t)cur.pn * tstep;
    S.a_ready(cur);
    if constexpr (SP2) {
        PG8_STAGE(PG8_SB(0, 0), cB, voffB); PG8_STAGE(PG8_SB(0, 1), cB + hstep, voffB); PG8_STAGE(PG8_SA(0, 0), cA, voffA); PG8_STAGE(PG8_SA(0, 1), cA + hstepA, voffA);
        if (wr == 1) PG8_BAR;
        PG8_WAIT_V(2); PG8_BAR;
        PG8_STAGE(PG8_SB(1, 0), cB + kstep, voffB); PG8_STAGE(PG8_SA(1, 0), cA + kstep, voffA); PG8_STAGE(PG8_SB(1, 1), cB + hstep + kstep, voffB);
        PG8_WAIT_V(6); PG8_BAR;
    } else {
        PG8_STAGE(PG8_SB(0, 0), cB, voffB); PG8_STAGE(PG8_SA(0, 0), cA, voffA); PG8_STAGE(PG8_SB(0, 1), cB + hstep, voffB); PG8_STAGE(PG8_SA(0, 1), cA + hstepA, voffA);
        if (wr == 1) PG8_BAR;
        PG8_WAIT_V(4); PG8_BAR;
        PG8_STAGE(PG8_SB(1, 0), cB + kstep, voffB); PG8_STAGE(PG8_SA(1, 0), cA + kstep, voffA); PG8_STAGE(PG8_SB(1, 1), cB + hstep + kstep, voffB);
        PG8_WAIT_V(6); PG8_BAR;
    }
    for (;;) {
        const bool has_next = S.next(ui + 1, nxt);
        const char* nA = has_next ? (const char*)g.A + (size_t)nxt.pm * tstepA : cA; const char* nB = has_next ? (const char*)g.Bt + (size_t)nxt.pn * tstep : cB;
        for (int t = 0; t < nt; t += 2) {
            const bool last = (t == nt - 2);
            const char* a1 = cA + (size_t)(t + 1) * kstep;
            const char* a2 = last ? nA : cA + (size_t)(t + 2) * kstep; const char* b2 = last ? nB : cB + (size_t)(t + 2) * kstep;
            const char* a3 = a2 + kstep; const char* b3 = b2 + kstep;
            if (last && has_next) S.a_ready(nxt);
            if constexpr (SP2) {
            PG8_LDB(B0, 0, 0); PG8_LDB(B1, 0, 1); PG8_SCHED; PG8_LDA(At, 0, 0); PG8_STAGE(PG8_SA(1, 1), a1 + hstepA, voffA);
            PG8_WAIT_V(8); PG8_WAIT_L(0); PG8_BAR; if (!Sched::HALVES || cur.half != 2) { PG8_MMA(0, 0, At, B0); PG8_MMA(0, 1, At, B1); } PG8_BAR; PG8_SCHED;
            PG8_LDA(At, 0, 1); PG8_STAGE(PG8_SB(0, 0), b2, voffB); PG8_STAGE(PG8_SB(0, 1), b2 + hstep, voffB); PG8_STAGE(PG8_SA(0, 0), a2, voffA);
            PG8_WAIT_V(8); PG8_WAIT_L(0); PG8_BAR; if (!Sched::HALVES || cur.half != 1) { PG8_MMA(1, 0, At, B0); PG8_MMA(1, 1, At, B1); } PG8_BAR; PG8_SCHED;
            PG8_LDB(B0, 1, 0); PG8_LDB(B1, 1, 1); PG8_SCHED; PG8_LDA(At, 1, 0); PG8_STAGE(PG8_SA(0, 1), a2 + hstepA, voffA);
            PG8_WAIT_V(8); PG8_WAIT_L(0); PG8_BAR; if (!Sched::HALVES || cur.half != 2) { PG8_MMA(0, 0, At, B0); PG8_MMA(0, 1, At, B1); } PG8_BAR; PG8_SCHED;
            PG8_LDA(At, 1, 1); PG8_STAGE(PG8_SB(1, 0), b3, voffB); PG8_STAGE(PG8_SB(1, 1), b3 + hstep, voffB); PG8_STAGE(PG8_SA(1, 0), a3, voffA);
            PG8_WAIT_V(8); PG8_WAIT_L(0); PG8_BAR; if (!Sched::HALVES || cur.half != 1) { PG8_MMA(1, 0, At, B0); PG8_MMA(1, 1, At, B1); } PG8_BAR; PG8_SCHED;
            } else {
            PG8_LDB(B0, 0, 0); PG8_SCHED; PG8_LDA(At, 0, 0); PG8_STAGE(PG8_SA(1, 1), a1 + hstepA, voffA);
            PG8_WAIT_L(8); PG8_BAR; PG8_WAIT_L(0); PG8_MMA(0, 0, At, B0); PG8_BAR; PG8_SCHED;
            PG8_LDB(B1, 0, 1); PG8_STAGE(PG8_SB(0, 0), b2, voffB);
            PG8_BAR; PG8_WAIT_L(0); PG8_MMA(0, 1, At, B1); PG8_BAR;
            PG8_LDA(At, 0, 1); PG8_STAGE(PG8_SA(0, 0), a2, voffA);
            PG8_BAR; PG8_WAIT_L(0); PG8_MMA(1, 0, At, B0); PG8_BAR; PG8_SCHED;
            PG8_STAGE(PG8_SB(0, 1), b2 + hstep, voffB);
            PG8_WAIT_V(6); PG8_BAR; PG8_MMA(1, 1, At, B1); PG8_BAR;
            PG8_LDB(B0, 1, 0); PG8_SCHED; PG8_LDA(At, 1, 0); PG8_STAGE(PG8_SA(0, 1), a2 + hstepA, voffA);
            PG8_WAIT_L(8); PG8_BAR; PG8_WAIT_L(0); PG8_MMA(0, 0, At, B0); PG8_BAR; PG8_SCHED;
            PG8_LDB(B1, 1, 1); PG8_STAGE(PG8_SB(1, 0), b3, voffB);
            PG8_BAR; PG8_WAIT_L(0); PG8_MMA(0, 1, At, B1); PG8_BAR;
            PG8_LDA(At, 1, 1); PG8_STAGE(PG8_SA(1, 0), a3, voffA);
            PG8_BAR; PG8_WAIT_L(0); PG8_MMA(1, 0, At, B0); PG8_BAR; PG8_SCHED;
            PG8_STAGE(PG8_SB(1, 1), b3 + hstep, voffB);
            PG8_WAIT_V(6); PG8_BAR; PG8_MMA(1, 1, At, B1); PG8_BAR;
            }
        }
        if constexpr (ALIGN_EPI) { if (wr == 0) PG8_BAR; }
        if constexpr (!Epi::AFTER_DRAIN) { E(acc, cur, wr, wc, fr, fq); S.done(cur); }
        if (!has_next) break;
#pragma unroll
        for (int a = 0; a < 2; ++a)
#pragma unroll
            for (int b = 0; b < 2; ++b)
#pragma unroll
                for (int m = 0; m < 4; ++m)
#pragma unroll
                    for (int n = 0; n < 2; ++n) acc[a][b][m][n] = (f32x4){0.f, 0.f, 0.f, 0.f};
        cur = nxt; cA = nA; cB = nB; ++ui;
        if constexpr (ALIGN_EPI) { if (wr == 1) PG8_BAR; }
    }
    PG8_WAIT_V(0);
    if constexpr (!ALIGN_EPI) { if (wr == 0) PG8_BAR; }
    PG8_BAR;
    if constexpr (Epi::AFTER_DRAIN) { E.fused(acc, cur, wr, wc, fr, fq, lds, wid, lane); S.done(cur); }
}
template <class Sched>
__device__ __forceinline__ void gemm_phase_seg(PG8_LAS unsigned char* lds, const bf16_t* A0, const bf16_t* A1, const bf16_t* A2, const bf16_t* Bt0, const bf16_t* gates, bf16_t* T, const Sched& S, const int tid) {
    const int wid = __builtin_amdgcn_readfirstlane(tid >> 6), lane = tid & 63, wr = wid >> 2, wc = wid & 3, fr = lane & 15, fq = lane >> 4;
    constexpr int K = 256, nt = 12;
    unsigned voffA[2], voffB[2];
#pragma unroll
    for (int i = 0; i < 2; ++i) { int R, C; stage_rc(tid * 16 + i * 8192, R, C); const int Rb = (R & ~31) + perm32(R & 31);
        voffA[i] = (unsigned)(R * K + C) * 2u; voffB[i] = (unsigned)(Rb * K + C) * 2u; }
    const size_t kstep = (size_t)(BK * 2), hstep = (size_t)HALF * K * 2, tstep = 2 * hstep, tstepA = hstep, hstepA = 0, sstepB = (size_t)1024 * K * 2;
    const unsigned ldsw = (unsigned)wid * 1024u;
    const int aoff = lds_byte(wr * 64 + fr, fq * 8), boff = lds_byte(wc * 32 + fr, fq * 8);
#define PG8_SEGA(off, t) ((const char*)((t) < 4 ? A0 : (t) < 8 ? A1 : A2) + (off) + (size_t)((t) & 3) * kstep)
#define PG8_SEGB(off, t) ((const char*)Bt0 + (size_t)((t) >> 2) * sstepB + (off) + (size_t)((t) & 3) * kstep)
    Unit cur, nxt; int ui = 0;
    if (!S.next(0, cur)) return;
    f32x4 acc[2][2][4][2];
#pragma unroll
    for (int a = 0; a < 2; ++a)
#pragma unroll
        for (int b = 0; b < 2; ++b)
#pragma unroll
            for (int m = 0; m < 4; ++m)
#pragma unroll
                for (int n = 0; n < 2; ++n) acc[a][b][m][n] = (f32x4){0.f, 0.f, 0.f, 0.f};
    bf16x8 At[4][2], B0[2][2], B1[2][2];
    size_t cAo = (size_t)cur.pm * tstepA, cBo = (size_t)cur.pn * tstep;
    { const char* cA = PG8_SEGA(cAo, 0); const char* cB = PG8_SEGB(cBo, 0);
      PG8_STAGE(PG8_SB(0, 0), cB, voffB); PG8_STAGE(PG8_SB(0, 1), cB + hstep, voffB); PG8_STAGE(PG8_SA(0, 0), cA, voffA); PG8_STAGE(PG8_SA(0, 1), cA + hstepA, voffA);
      if (wr == 1) PG8_BAR;
      PG8_WAIT_V(2); PG8_BAR;
      PG8_STAGE(PG8_SB(1, 0), cB + kstep, voffB); PG8_STAGE(PG8_SA(1, 0), cA + kstep, voffA); PG8_STAGE(PG8_SB(1, 1), cB + hstep + kstep, voffB);
      PG8_WAIT_V(6); PG8_BAR; }
    for (;;) {
        const bool has_next = S.next(ui + 1, nxt);
        const size_t nAo = has_next ? (size_t)nxt.pm * tstepA : cAo, nBo = has_next ? (size_t)nxt.pn * tstep : cBo;
        for (int t = 0; t < nt; t += 2) {
            const bool last = (t == nt - 2);
            const char* a1 = PG8_SEGA(cAo, t + 1);
            const char* a2 = last ? PG8_SEGA(nAo, 0) : PG8_SEGA(cAo, t + 2); const char* b2 = last ? PG8_SEGB(nBo, 0) : PG8_SEGB(cBo, t + 2);
            const char* a3 = a2 + kstep; const char* b3 = b2 + kstep;
            PG8_LDB(B0, 0, 0); PG8_LDB(B1, 0, 1); PG8_SCHED; PG8_LDA(At, 0, 0); PG8_STAGE(PG8_SA(1, 1), a1 + hstepA, voffA);
            PG8_WAIT_V(8); PG8_WAIT_L(0); PG8_BAR; PG8_MMA(0, 0, At, B0); PG8_MMA(0, 1, At, B1); PG8_BAR; PG8_SCHED;
            PG8_STAGE(PG8_SB(0, 0), b2, voffB); PG8_STAGE(PG8_SB(0, 1), b2 + hstep, voffB); PG8_STAGE(PG8_SA(0, 0), a2, voffA);
            PG8_WAIT_V(8); PG8_WAIT_L(0); PG8_BAR; PG8_BAR; PG8_SCHED;
            PG8_LDB(B0, 1, 0); PG8_LDB(B1, 1, 1); PG8_SCHED; PG8_LDA(At, 1, 0); PG8_STAGE(PG8_SA(0, 1), a2 + hstepA, voffA);
            PG8_WAIT_V(8); PG8_WAIT_L(0); PG8_BAR; PG8_MMA(0, 0, At, B0); PG8_MMA(0, 1, At, B1); PG8_BAR; PG8_SCHED;
            PG8_STAGE(PG8_SB(1, 0), b3, voffB); PG8_STAGE(PG8_SB(1, 1), b3 + hstep, voffB); PG8_STAGE(PG8_SA(1, 0), a3, voffA);
            PG8_WAIT_V(8); PG8_WAIT_L(0); PG8_BAR; PG8_BAR; PG8_SCHED;
            if ((t & 3) == 2) {
                const int seg = t >> 2; unsigned row0 = (unsigned)(cur.pm * HALF + wr * 64 + fr), col0 = (unsigned)(cur.pn * BM + wc * 32 + 8 * fq); asm volatile("" : "+v"(row0), "+v"(col0));
#pragma unroll
                for (int bj = 0; bj < 2; ++bj) { u32x4 gg[4];
#pragma unroll
                    for (int m = 0; m < 4; ++m) gg[m] = *(const u32x4*)(gates + ((row0 + m * 16) * 3072u + ((unsigned)(seg * 1024 + bj * HALF) + col0)));
#pragma unroll
                    for (int m = 0; m < 4; ++m) { const u32x4 g_ = gg[m]; f32x4 a0 = acc[0][bj][m][0], a1 = acc[0][bj][m][1], t0 = acc[1][bj][m][0], t1 = acc[1][bj][m][1];
                        { float q0 = t0[0], q1 = t0[1], q2 = t0[2], q3 = t0[3], q4 = t1[0], q5 = t1[1], q6 = t1[2], q7 = t1[3];
#define PG8_FMAC(t, g, a) asm("v_fmac_f32 %0, %1, %2" : "+v"(t) : "v"(g), "v"(a))
                          PG8_FMAC(q0, bflo_(g_.x), a0[0]); PG8_FMAC(q1, bfhi_(g_.x), a0[1]); PG8_FMAC(q2, bflo_(g_.y), a0[2]); PG8_FMAC(q3, bfhi_(g_.y), a0[3]);
                          PG8_FMAC(q4, bflo_(g_.z), a1[0]); PG8_FMAC(q5, bfhi_(g_.z), a1[1]); PG8_FMAC(q6, bflo_(g_.w), a1[2]); PG8_FMAC(q7, bfhi_(g_.w), a1[3]);
#undef PG8_FMAC
                          t0 = (f32x4){q0, q1, q2, q3}; t1 = (f32x4){q4, q5, q6, q7}; }
                        acc[1][bj][m][0] = t0; acc[1][bj][m][1] = t1; acc[0][bj][m][0] = (f32x4){0.f, 0.f, 0.f, 0.f}; acc[0][bj][m][1] = (f32x4){0.f, 0.f, 0.f, 0.f};
                        if (seg == 2) { u32x4 w; w.x = pk2_(t0[0], t0[1]); w.y = pk2_(t0[2], t0[3]); w.z = pk2_(t1[0], t1[1]); w.w = pk2_(t1[2], t1[3]);
                            *(u32x4*)(T + ((row0 + m * 16) * 1024u + (col0 + bj * HALF))) = w; } }
                    asm volatile("" ::: "memory"); }
            }
        }
        if (wr == 0) PG8_BAR;
        if (!has_next) break;
#pragma unroll
        for (int b = 0; b < 2; ++b)
#pragma unroll
            for (int m = 0; m < 4; ++m)
#pragma unroll
                for (int n = 0; n < 2; ++n) acc[1][b][m][n] = (f32x4){0.f, 0.f, 0.f, 0.f};
        cur = nxt; cAo = nAo; cBo = nBo; ++ui;
        if (wr == 1) PG8_BAR;
    }
    PG8_WAIT_V(0);
    PG8_BAR;
#undef PG8_SEGA
#undef PG8_SEGB
#undef PG8_SA
#undef PG8_SB
#undef PG8_STAGE
#undef PG8_LDA
#undef PG8_LDB
#undef PG8_MMA
#undef PG8_WAIT_V
#undef PG8_WAIT_L
#undef PG8_BAR
#undef PG8_SCHED
}
}
#ifndef PG8_SP2
#define PG8_SP2 true
#endif
#ifndef PG8_ALIGN
#define PG8_ALIGN true
#endif
constexpr int NWAVES = 8;
constexpr int BATCH = 2, SEQ = 8192, D = 1024, M = BATCH * SEQ, DEPTH = 2;
constexpr int IN_COLS = 5892, NMIX = 3072, MIXLD = 2816, NGATE = 3072, DFF = 2816, NGU = 2 * DFF;
constexpr int C_RETQ = 0, C_RETK = 256, C_RETV = 512, C_RETG = 768, C_FOXQ = 1024, C_FOXK = 1280, C_FOXV = 1536, C_RW = 1792;
constexpr size_t MiB = 1u << 20;
constexpr size_t WS_CTL = 0, CTL_ZERO_BYTES = 64 * 1024;
constexpr size_t WS_WIN = 1 * MiB, WS_WGATE = 7 * MiB, WS_PBR = 13 * MiB, WS_WOUT = 14 * MiB + 512 * 1024, WS_WGU = 16 * MiB + 512 * 1024, WS_WDOWN = 27 * MiB + 512 * 1024;
constexpr size_t WS_XB = 33 * MiB;
constexpr size_t WS_RB = 65 * MiB;
constexpr size_t WS_BIG = 97 * MiB;
constexpr size_t WS_SW = 193 * MiB, WS_REC = 209 * MiB, WS_SA = 225 * MiB;
constexpr size_t WS_TT = 241 * MiB;
constexpr size_t WS_YL = WS_RB;
constexpr size_t WS_LS = WS_RB + 16 * MiB;
constexpr size_t WS_U = WS_BIG + 88 * MiB;
constexpr size_t WS_BS = 251 * MiB + 512 * 1024;
constexpr size_t WS_XLO = WS_SW;
constexpr size_t WS_SIN = WS_SW;
constexpr size_t WS_FO0 = WS_SA + 4 * MiB;
constexpr size_t WS_FL0 = WS_SA + 12 * MiB, WS_FL1 = WS_SA + 12 * MiB + 512 * 1024;
constexpr size_t WS_RP = 1 * MiB;
constexpr size_t WS_SEGT = 254 * MiB + 512 * 1024;
constexpr size_t WS_G2T = 254 * MiB;
constexpr size_t WS_YR = WS_REC, WS_YF = WS_REC + 8 * MiB, WS_YW = WS_TT;
constexpr size_t WS_SS1 = 249 * MiB, WS_SS2 = 250 * MiB;
constexpr size_t WS_FLOG = 251 * MiB, WS_CUM = 251 * MiB + 256 * 1024;
constexpr size_t WS_ROPE = 252 * MiB;
constexpr size_t WS_END = 256 * MiB;
constexpr int CW_TMO = 0, CW_CODE = 1, CW_BAR = 4096, CW_QUEUE = 8192;
constexpr int RING_OFF = 0, RING_BYTES = 131072;
constexpr int LDSCTL_OFF = RING_BYTES, MISC_OFF = LDSCTL_OFF + 320;
constexpr int LDS_BYTES = 147456;
#define GAS __attribute__((address_space(1)))
#define LAS __attribute__((address_space(3)))
typedef unsigned short bf16;
typedef unsigned v4u __attribute__((ext_vector_type(4)));
typedef float f32x4 __attribute__((ext_vector_type(4)));
typedef short bf16x8 __attribute__((ext_vector_type(8)));
typedef GAS unsigned gu32;
typedef GAS unsigned long long gu64;
#define RLX_AGENT __ATOMIC_RELAXED, __HIP_MEMORY_SCOPE_AGENT
#define LDS_WAIT() asm volatile("s_waitcnt lgkmcnt(0)" ::: "memory")
#define VM_WAIT() asm volatile("s_waitcnt vmcnt(0)" ::: "memory")
__device__ __forceinline__ unsigned long long rt() { return __builtin_amdgcn_s_memrealtime(); }
typedef float f32x2h __attribute__((ext_vector_type(2))); typedef __bf16 bf16x2h __attribute__((ext_vector_type(2)));
__device__ __forceinline__ unsigned f2bf(float f) { const f32x2h v = {f, f}; return __builtin_bit_cast(unsigned, __builtin_convertvector(v, bf16x2h)) & 0xffffu; }
typedef float f32x2g __attribute__((ext_vector_type(2))); typedef __bf16 bf16x2g __attribute__((ext_vector_type(2)));
__device__ __forceinline__ unsigned pk2(float lo, float hi) { const f32x2g v = {lo, hi}; return __builtin_bit_cast(unsigned, __builtin_convertvector(v, bf16x2g)); }

#define XB_TMO      128
#define XB_XCNT(j)  (256  + 64 * (j))
#define XB_XSUB(j)  (1280 + 64 * (j))
#define XB_XGEN(j)  (2304 + 64 * (j))
#define XB_TOP      3328
#define XB_TOPGEN   3392
#define XCD_BAR_WORDS 3456
#define XB_SPIN_CAP (1u << 18)

__device__ __forceinline__ unsigned xb_ld(unsigned* p)              { return __hip_atomic_load(p, __ATOMIC_RELAXED, __HIP_MEMORY_SCOPE_AGENT); }
__device__ __forceinline__ unsigned xb_add(unsigned* p, unsigned v) { return __hip_atomic_fetch_add(p, v, __ATOMIC_RELAXED, __HIP_MEMORY_SCOPE_AGENT); }
__device__ __forceinline__ unsigned xb_xcc_id() { return (unsigned)__builtin_amdgcn_s_getreg((3 << 11) | 20) & 0xFu; }
#define XB_SPIN(cond, bar) do { unsigned _sp = 0; while (cond) { __builtin_amdgcn_s_sleep(1); \
    if ((++_sp & 255u) == 0u) { if (xb_ld(&(bar)[XB_TMO])) break; if (_sp > XB_SPIN_CAP) { atomicAdd(&(bar)[XB_TMO], 1u); break; } } } } while (0)

struct XcdBarrier {
    unsigned* bar; unsigned x;
    volatile LAS unsigned* st;
};

__device__ __forceinline__ XcdBarrier xcd_barrier_post(unsigned* bar, volatile LAS unsigned* st) {
    XcdBarrier b; b.bar = bar; b.x = xb_xcc_id(); b.st = st;
    if (threadIdx.x == 0) (void)xb_add(&bar[XB_XCNT(b.x)], 1u);
    return b;
}
__device__ __forceinline__ void xcd_barrier_complete(unsigned* bar, unsigned x, unsigned& nloc, unsigned& nx) {
    const unsigned G = gridDim.x * gridDim.y * gridDim.z;
    unsigned sum, cnt, mine, sp = 0u;
    for (;;) {
        sum = 0u; cnt = 0u; mine = 0u;
#pragma unroll
        for (unsigned j = 0; j < 16; ++j) { const unsigned c = xb_ld(&bar[XB_XCNT(j)]); sum += c; cnt += (c > 0u) ? 1u : 0u; mine = (j == x) ? c : mine; }
        if (sum == G) break;
        __builtin_amdgcn_s_sleep(1);
        if ((++sp & 255u) == 0u) { if (xb_ld(&bar[XB_TMO])) break; if (sp > XB_SPIN_CAP) { atomicAdd(&bar[XB_TMO], 1u); break; } }
    }
    nloc = mine > 0u ? mine : 1u; nx = cnt > 0u ? cnt : 1u;
}

__device__ __forceinline__ void xcd_barrier(const XcdBarrier& b, const bool leader_thread) {
    asm volatile("s_waitcnt vmcnt(0)" ::: "memory");
    __syncthreads();
    if (leader_thread) {
        unsigned* bar = b.bar; asm volatile("" : "+s"(bar));
        __builtin_amdgcn_s_waitcnt(0);
        unsigned nloc = b.st[0], nx = b.st[1];
        if (nloc == 0u) { xcd_barrier_complete(bar, b.x, nloc, nx); b.st[0] = nloc; b.st[1] = nx; }
        const unsigned old = xb_add(&bar[XB_XSUB(b.x)], 1u);
        const unsigned gen = old / nloc;
        if (old + 1u == (gen + 1u) * nloc) {
            __builtin_amdgcn_fence(__ATOMIC_RELEASE, "agent");
            asm volatile("s_waitcnt vmcnt(0)" ::: "memory");
            const unsigned og = xb_add(&bar[XB_TOP], 1u);
            const unsigned tg = og / nx;
            if (og + 1u == (tg + 1u) * nx) xb_add(&bar[XB_TOPGEN], 1u);
            else XB_SPIN(xb_ld(&bar[XB_TOPGEN]) == tg, bar);
            __builtin_amdgcn_fence(__ATOMIC_ACQUIRE, "agent");
            xb_add(&bar[XB_XGEN(b.x)], 1u);
            asm volatile("s_waitcnt vmcnt(0)" ::: "memory");
        } else {
            XB_SPIN(xb_ld(&bar[XB_XGEN(b.x)]) == gen, bar);
            __builtin_amdgcn_fence(__ATOMIC_ACQUIRE, "agent");
            asm volatile("s_waitcnt vmcnt(0)" ::: "memory");
        }
    }
    __syncthreads();
}
#include <hip/hip_bf16.h>
#include <cmath>
namespace attn_body {
using bf16=__hip_bfloat16;
using bf16x8=__attribute__((ext_vector_type(8)))short;
using s16x4=__attribute__((ext_vector_type(4)))short;
using f32x16=__attribute__((ext_vector_type(16)))float;
using u32x4=__attribute__((ext_vector_type(4)))unsigned;
using f32x4v=__attribute__((ext_vector_type(4)))float;
constexpr int BATCH=2,NHEAD=4,SEQ=8192,D=64,DM=2816,OP=256;
constexpr int NW=8,QBLK=32,QB=QBLK*NW,KVBLK=64,NQB=SEQ/QB;
constexpr int ATTN_PITCH=DM, ATTN_UNIT_ROWS=QB;
__device__ __forceinline__ int crow(int r,int hi){return (r&3)+8*(r>>2)+4*hi;}
#define SBAR() __builtin_amdgcn_sched_barrier(0)
__device__ __forceinline__ void cmask(f32x16&p0,f32x16&p1,int jb,int qrel,int hi){
  const float NEG=-INFINITY; int kb=64*jb+4*hi;
  #pragma unroll
  for(int r=0;r<16;++r){int kv=kb+(r&3)+8*(r>>2); if(kv>qrel)p0[r]=NEG; if(kv+32>qrel)p1[r]=NEG;}
}

constexpr int NSLOT=3, SLOTB=8192;
constexpr int LDS_K=0, LDS_V=NSLOT*SLOTB, LDS_WS=2*NSLOT*SLOTB, LDS_OST=LDS_WS+NW*64*4, LDS_BIAS=LDS_OST+NW*4096, LDS_BYTES=LDS_BIAS+SEQ*4;
constexpr float C2=0.125f*1.4426950408889634f;
__device__ __forceinline__ void glds16(const void*gsrc,unsigned lds_dst){unsigned keep;
  asm volatile("s_mov_b32 %0, m0\n\ts_mov_b32 m0, %2\n\ts_nop 0\n\tglobal_load_lds_dwordx4 %1, off\n\ts_mov_b32 m0, %0":"=&s"(keep):"v"(gsrc),"s"(lds_dst):"memory");}
__device__ __forceinline__ float max3f(float a,float b,float c){float r;asm("v_max3_f32 %0, %1, %2, %3":"=v"(r):"v"(a),"v"(b),"v"(c));return r;}
__device__ __forceinline__ float max2f(float a,float b){float r;asm("v_max_f32_e32 %0, %1, %2":"=v"(r):"v"(a),"v"(b));return r;}
__device__ __forceinline__ float fadd_s(float a,float b){float r;asm("v_add_f32_e32 %0, %1, %2":"=v"(r):"v"(a),"v"(b));return r;}
__device__ __forceinline__ float fsub_s(float a,float b){float r;asm("v_sub_f32_e32 %0, %1, %2":"=v"(r):"v"(a),"v"(b));return r;}
typedef float f32x2_t __attribute__((ext_vector_type(2))); typedef __bf16 bf16x2_t __attribute__((ext_vector_type(2)));
__device__ __forceinline__ unsigned cvtpk_s(float lo,float hi){f32x2_t v={lo,hi};bf16x2_t b=__builtin_convertvector(v,bf16x2_t);return __builtin_bit_cast(unsigned,b);}
#define WAIT_BAR(N) asm volatile("s_waitcnt vmcnt(" #N ") lgkmcnt(0)\n\ts_barrier":::"memory")

__device__ __forceinline__ void qkt(f32x16&p0,f32x16&p1,const char*Kslot,const bf16x8*qr,int r32,int hi){
  const char*kb=Kslot+hi*1024+r32*16;
  #pragma unroll
  for(int d0=0;d0<4;++d0){
    const bf16x8 b0=*reinterpret_cast<const bf16x8*>(kb+d0*2048);
    const bf16x8 b1=*reinterpret_cast<const bf16x8*>(kb+d0*2048+512);
    p0=__builtin_amdgcn_mfma_f32_32x32x16_bf16(b0,qr[d0],p0,0,0,0);p1=__builtin_amdgcn_mfma_f32_32x32x16_bf16(b1,qr[d0],p1,0,0,0);}
}
typedef __attribute__((address_space(3))) const char* lds_cptr;
typedef short v4i16_t __attribute__((ext_vector_type(4)));
__device__ __forceinline__ void kload8(bf16x8*kf,lds_cptr kp){
  kf[0]=*(const __attribute__((address_space(3))) bf16x8*)(kp);      kf[1]=*(const __attribute__((address_space(3))) bf16x8*)(kp+512);
  kf[2]=*(const __attribute__((address_space(3))) bf16x8*)(kp+2048); kf[3]=*(const __attribute__((address_space(3))) bf16x8*)(kp+2560);
  kf[4]=*(const __attribute__((address_space(3))) bf16x8*)(kp+4096); kf[5]=*(const __attribute__((address_space(3))) bf16x8*)(kp+4608);
  kf[6]=*(const __attribute__((address_space(3))) bf16x8*)(kp+6144); kf[7]=*(const __attribute__((address_space(3))) bf16x8*)(kp+6656);
}
__device__ __forceinline__ void kload2(bf16x8*kf,lds_cptr kp,int j){ kf[2*j]=*(const __attribute__((address_space(3))) bf16x8*)(kp+j*2048); kf[2*j+1]=*(const __attribute__((address_space(3))) bf16x8*)(kp+j*2048+512); }
__device__ __forceinline__ s16x4 vtr(lds_cptr p){ return __builtin_bit_cast(s16x4,__builtin_amdgcn_ds_read_tr16_b64_v4i16((__attribute__((address_space(3))) v4i16_t*)p)); }
__device__ __forceinline__ float rowmax(const f32x16&p0,const f32x16&p1){
  float a=max3f(p0[0],p0[1],p1[0]),b=max3f(p0[2],p0[3],p1[1]);a=max3f(a,p1[2],p1[3]);
  #pragma unroll
  for(int r=4;r<16;r+=4){a=max3f(a,p0[r],p0[r+1]);b=max3f(b,p0[r+2],p0[r+3]);a=max3f(a,p1[r],p1[r+1]);b=max3f(b,p1[r+2],p1[r+3]);}
  const float m=max2f(a,b);
  auto rr=__builtin_amdgcn_permlane32_swap(__float_as_uint(m),__float_as_uint(m),false,false);
  return max2f(__uint_as_float(rr[0]),__uint_as_float(rr[1]));
}
__device__ __forceinline__ void pv(f32x16*o,int vb,bf16x8 pa0,bf16x8 pa1,bf16x8 pa2,bf16x8 pa3){
  #pragma unroll
  for(int d0=0;d0<2;++d0){s16x4 lo[4],hi[4];
    #pragma unroll
    for(int ks=0;ks<4;++ks){
      asm volatile("ds_read_b64_tr_b16 %0,%1 offset:%c2":"=&v"(lo[ks]):"v"(vb),"i"(d0*4096+ks*1024):"memory");
      asm volatile("ds_read_b64_tr_b16 %0,%1 offset:%c2":"=&v"(hi[ks]):"v"(vb),"i"(d0*4096+ks*1024+512):"memory");}
    asm volatile("s_waitcnt lgkmcnt(0)":::"memory");SBAR();
    #define PK(k) (bf16x8){lo[k][0],lo[k][1],lo[k][2],lo[k][3],hi[k][0],hi[k][1],hi[k][2],hi[k][3]}
    o[d0]=__builtin_amdgcn_mfma_f32_32x32x16_bf16(pa0,PK(0),o[d0],0,0,0);
    o[d0]=__builtin_amdgcn_mfma_f32_32x32x16_bf16(pa1,PK(1),o[d0],0,0,0);
    o[d0]=__builtin_amdgcn_mfma_f32_32x32x16_bf16(pa2,PK(2),o[d0],0,0,0);
    o[d0]=__builtin_amdgcn_mfma_f32_32x32x16_bf16(pa3,PK(3),o[d0],0,0,0);
    #undef PK
  }
}

#ifndef ATTN_STORE16
#define ATTN_STORE16(p,v) (*(u32x4*)(p)=(v))
#endif
template<int THRL,int NB=0> __device__ __forceinline__ void attn_unit(int b,int h,int qb,int T0in,int T1,bool mband,float skipthr,const bf16*Q,const bf16*__restrict__ K,const bf16*__restrict__ V,bf16*O,float*lse_out,float*lse_neg,const float*cum,const float*segt,char*shm,int tid){
  const int lane=tid&63,r32=lane&31,hi=lane>>5; const int wid=__builtin_amdgcn_readfirstlane(tid>>6);
  const long rowbase=(long)b*SEQ; const int q0=qb*QB;
  float off[8]; { float r_=0.f; _Pragma("unroll") for(int s_=0;s_<8;++s_){ off[s_]=r_; r_+=segt[s_]; } }
  float cref=cum[q0]; { const int sq=q0>>10; _Pragma("unroll") for(int s_=0;s_<8;++s_) if(s_==sq)cref+=off[s_]; }
  int T0=T0in;
  { int flag=0;
    if(tid<128){ const int jl=64*tid+63; float cj=cum[jl]; { const int sj=jl>>10; _Pragma("unroll") for(int s_=0;s_<8;++s_) if(s_==sj)cj+=off[s_]; } flag=((cref-cj)*1.4426950408889634f< -skipthr)?1:0; }
    const unsigned long long bal=__ballot(flag); int*cnt=(int*)(shm+LDS_WS);
    if(lane==0&&wid<2)cnt[wid]=__builtin_popcountll(bal);
    __syncthreads();
    const int nskip=cnt[0]+cnt[1];
    __syncthreads();
    if(!mband&&nskip>=T1){ if(hi==0)lse_out[(rowbase+q0+wid*QBLK+r32)*4+h]=-INFINITY; return; }
    int t0n=nskip<T1-4?nskip:T1-4; if(t0n>T0){ if((T1-t0n)&1)t0n-=1; T0=t0n; } }
  const bf16*Qw=Q+(rowbase+q0+wid*QBLK)*DM+h*D;
  const bf16*Kh=K+rowbase*DM+h*D,*Vh=V+rowbase*DM+h*D;
  const unsigned lds0=(unsigned)(uintptr_t)shm;
  float*wsf=(float*)(shm+LDS_WS)+wid*64;
  const bf16*ksrc=Kh+(long)(T0*KVBLK+lane)*DM+wid*8;
  const bf16*vsrc=Vh+(long)(T0*KVBLK+16*(wid&3)+(lane>>2))*DM+(wid>>2)*32+(lane&3)*8;
  const unsigned kdst=lds0+LDS_K+wid*1024, vdst=lds0+LDS_V+wid*1024;
  #define DMA_K(t,slot) glds16(ksrc+(long)(t)*KVBLK*DM,(unsigned)__builtin_amdgcn_readfirstlane(kdst+(slot)))
  #define DMA_V(t,slot) glds16(vsrc+(long)(t)*KVBLK*DM,(unsigned)__builtin_amdgcn_readfirstlane(vdst+(slot)))
  const int vb0=(int)(lds0+LDS_V)+((lane>>4)&1)*32+(lane&3)*8+(4*hi+((lane&15)>>2))*64;
  const char*Kbase=shm+LDS_K; bf16x8 kf[8];
  const lds_cptr shm3=(lds_cptr)shm; const lds_cptr kp0=shm3+LDS_K+hi*1024+r32*16; const lds_cptr vp0=shm3+LDS_V+((lane>>4)&1)*32+(lane&3)*8+(4*hi+((lane&15)>>2))*64;
  const int NT=T1-T0;
  {
    float*bl=(float*)(shm+LDS_BIAS);
    _Pragma("clang loop unroll(disable) vectorize(disable)") for(int j=tid*4;j<NT*KVBLK;j+=NW*64*4){ const int ja=T0*KVBLK+j; const float4 c4=*reinterpret_cast<const float4*>(cum+ja);
      float oj=0.f; { const int sj=ja>>10; _Pragma("unroll") for(int s_=0;s_<8;++s_) if(s_==sj)oj=off[s_]; } const float cr=cref-oj;
      float4 o4; o4.x=(cr-c4.x)*1.4426950408889634f;o4.y=(cr-c4.y)*1.4426950408889634f;o4.z=(cr-c4.z)*1.4426950408889634f;o4.w=(cr-c4.w)*1.4426950408889634f; *reinterpret_cast<float4*>(bl+j)=o4; }
    asm volatile("s_waitcnt vmcnt(0) lgkmcnt(0)":::"memory"); }
  const lds_cptr bp0=(lds_cptr)shm+LDS_BIAS+hi*16;
  #define LDBIAS(P0,P1,t) do{ if(NB){ _Pragma("unroll") for(int r_=0;r_<16;++r_){P0[r_]=0.f;P1[r_]=0.f;} break; } const lds_cptr bp_=bp0+(t)*256; _Pragma("unroll") for(int g_=0;g_<4;++g_){ const f32x4v a_=*(const __attribute__((address_space(3))) f32x4v*)(bp_+32*g_); const f32x4v c_=*(const __attribute__((address_space(3))) f32x4v*)(bp_+128+32*g_); \
      P0[4*g_]=a_[0];P0[4*g_+1]=a_[1];P0[4*g_+2]=a_[2];P0[4*g_+3]=a_[3]; P1[4*g_]=c_[0];P1[4*g_+1]=c_[1];P1[4*g_+2]=c_[2];P1[4*g_+3]=c_[3]; } }while(0)
  DMA_K(0,0);DMA_V(0,0);DMA_K(1,SLOTB);
  bf16x8 qr[4];
  #pragma unroll
  for(int d0=0;d0<4;++d0)qr[d0]=*reinterpret_cast<const bf16x8*>(&Qw[(long)r32*DM+d0*16+hi*8]);
  float mhat=0.f,l_reg=0.f;f32x16 o[2];o[0]=f32x16{};o[1]=f32x16{};
  const int qrel=wid*QBLK+r32;
  #define CMASK(P0,P1,t) do{int jb_=(t)-(NT-4); if(mband&&jb_>=0)cmask(P0,P1,jb_,qrel,hi);}while(0)
  bool resc=false;
  #define START(P0,P1) do{ const float rm=rowmax(P0,P1); resc=false; \
    { const float dl=rm; mhat=fadd_s(mhat,dl); \
      _Pragma("unroll") for(int r=0;r<16;++r){P0[r]=fsub_s(P0[r],dl);P1[r]=fsub_s(P1[r],dl);} } \
    _Pragma("unroll") for(int r=0;r<16;++r)P0[r]=__builtin_amdgcn_exp2f(P0[r]); }while(0)
  #define RESC() do{ if(resc){ asm volatile("s_waitcnt lgkmcnt(0)":::"memory"); \
      _Pragma("unroll") for(int d_=0;d_<2;++d_) _Pragma("unroll") for(int r=0;r<16;++r)o[d_][r]*=wsf[crow(r,hi)]; } }while(0)
  f32x16 pA0,pA1,pB0,pB1;
  int sl_prev=0,sl_cur=0,sl_next=SLOTB;
  #define ROT() do{sl_prev=sl_cur;sl_cur=sl_next;sl_next=(sl_next==(NSLOT-1)*SLOTB)?0:sl_next+SLOTB;}while(0)
  DMA_K(2,2*SLOTB);
  WAIT_BAR(3);
  LDBIAS(pA0,pA1,0); qkt(pA0,pA1,Kbase,qr,r32,hi);asm volatile("s_nop 15\n\ts_nop 7":"+v"(pA0),"+v"(pA1));CMASK(pA0,pA1,0);
  START(pA0,pA1);
  _Pragma("unroll") for(int r=0;r<16;++r)pA1[r]=__builtin_amdgcn_exp2f(pA1[r]);
  LDBIAS(pB0,pB1,1); _Pragma("unroll") for(int r=0;r<16;++r){pB0[r]-=mhat;pB1[r]-=mhat;}
  WAIT_BAR(0);
  DMA_K(3,0);DMA_V(1,SLOTB);
  ROT();
  kload8(kf,kp0+sl_cur);
  WAIT_BAR(2);
  s16x4 vlo[8],vhi[8]; u32x4 pw0,pw1,pw2,pw3;
  #define PKW(P,B) cvtpk_s(P[B],P[B+1])
  #define PAF(k) __builtin_bit_cast(bf16x8,pw##k)
  #define VFR(i) (bf16x8){vlo[i][0],vlo[i][1],vlo[i][2],vlo[i][3],vhi[i][0],vhi[i][1],vhi[i][2],vhi[i][3]}
  #define PIN(x) asm volatile("":"+v"(x))
  #define MX3(a,b,c) __builtin_fmaxf(__builtin_fmaxf((a),(b)),(c))
  #define GAPA(MF,A0,A1,A2,A3,W0,W1,PW) do{ MF; sacc+=A0; sacc+=A1; sacc+=A2; sacc+=A3; PIN(sacc); W0; W1; PIN(PW); SBAR(); }while(0)
  #define EX(v) __builtin_amdgcn_exp2f(v)
  #define GAPB(MF,X,B) do{ MF; X[B]=EX(X[B]); X[B+1]=EX(X[B+1]); X[B+2]=EX(X[B+2]); X[B+3]=EX(X[B+3]); PIN(X); SBAR(); }while(0)
  #define VRD(i) do{ vlo[i]=vtr(vp_+(((i)>>2)*4096+((i)&3)*1024)); vhi[i]=vtr(vp_+(((i)>>2)*4096+((i)&3)*1024+512)); }while(0)
  #define KRD(G,j) do{ if(G){ kload2(kf,kp0+sl_next,j); SBAR(); } }while(0)
  #define STEP(C0,C1,P0,P1,t,GK,GV,GL) do{ SBAR(); \
    const lds_cptr vp_=vp0+sl_prev; \
    VRD(0); SBAR(); float sacc=(P0[0]+P0[1]); \
    GAPA(C0=__builtin_amdgcn_mfma_f32_32x32x16_bf16(kf[0],qr[0],C0,0,0,0), P0[2],P0[3],P0[4],P0[5],     pw0[0]=PKW(P0,0), pw0[1]=PKW(P0,2), pw0); \
    VRD(4); SBAR(); GAPA(C1=__builtin_amdgcn_mfma_f32_32x32x16_bf16(kf[1],qr[0],C1,0,0,0), P0[6],P0[7],P0[8],P0[9],     pw0[2]=PKW(P0,4), pw0[3]=PKW(P0,6), pw0); \
    VRD(1); SBAR(); GAPA(C0=__builtin_amdgcn_mfma_f32_32x32x16_bf16(kf[2],qr[1],C0,0,0,0),   P0[10],P0[11],P0[12],P0[13], pw1[0]=PKW(P0,8), pw1[1]=PKW(P0,10), pw1); \
    VRD(5); SBAR(); GAPA(C1=__builtin_amdgcn_mfma_f32_32x32x16_bf16(kf[3],qr[1],C1,0,0,0),   P0[14],P0[15],P1[0],P1[1],   pw1[2]=PKW(P0,12),pw1[3]=PKW(P0,14), pw1); \
    VRD(2); SBAR(); GAPA(C0=__builtin_amdgcn_mfma_f32_32x32x16_bf16(kf[4],qr[2],C0,0,0,0),   P1[2],P1[3],P1[4],P1[5],     pw2[0]=PKW(P1,0), pw2[1]=PKW(P1,2), pw2); \
    VRD(6); SBAR(); GAPA(C1=__builtin_amdgcn_mfma_f32_32x32x16_bf16(kf[5],qr[2],C1,0,0,0),   P1[6],P1[7],P1[8],P1[9],     pw2[2]=PKW(P1,4), pw2[3]=PKW(P1,6), pw2); \
    VRD(3); SBAR(); GAPA(C0=__builtin_amdgcn_mfma_f32_32x32x16_bf16(kf[6],qr[3],C0,0,0,0),   P1[10],P1[11],P1[12],P1[13], pw3[0]=PKW(P1,8), pw3[1]=PKW(P1,10), pw3); \
    VRD(7); SBAR(); GAPA(C1=__builtin_amdgcn_mfma_f32_32x32x16_bf16(kf[7],qr[3],C1,0,0,0),   P1[14],P1[15],0.f,0.f,       pw3[2]=PKW(P1,12),pw3[3]=PKW(P1,14), pw3); \
    l_reg+=sacc; \
    if(GK){DMA_K((t)+3,sl_cur);} if(GV){DMA_V((t)+1,sl_next);} \
    CMASK(C0,C1,t); \
    { float a=MX3(C0[0],C0[1],C1[0]),b=MX3(C0[2],C0[3],C1[1]); a=MX3(a,C1[2],C1[3]); \
      _Pragma("unroll") for(int r=4;r<16;r+=4){a=MX3(a,C0[r],C0[r+1]);b=MX3(b,C0[r+2],C0[r+3]);a=MX3(a,C1[r],C1[r+1]);b=MX3(b,C1[r+2],C1[r+3]);} \
      float rm=__builtin_fmaxf(a,b); { auto rr=__builtin_amdgcn_permlane32_swap(__float_as_uint(rm),__float_as_uint(rm),false,false); rm=__builtin_fmaxf(__uint_as_float(rr[0]),__uint_as_float(rr[1])); } \
      resc=false; \
      if(__builtin_expect(__any(rm>(float)THRL),0)){ const float dl=__builtin_fmaxf(rm,0.f); mhat+=dl; \
        _Pragma("unroll") for(int r=0;r<16;++r){C0[r]-=dl;C1[r]-=dl;} \
        const float f=__builtin_amdgcn_exp2f(-dl); l_reg*=f; if(hi==0)wsf[r32]=f; resc=true; } } \
    SBAR(); \
    if(GL){ LDBIAS(P0,P1,(t)+1); SBAR(); } \
    GAPB(o[0]=__builtin_amdgcn_mfma_f32_32x32x16_bf16(PAF(0),VFR(0),o[0],0,0,0), C0,0); \
    GAPB(o[1]=__builtin_amdgcn_mfma_f32_32x32x16_bf16(PAF(0),VFR(4),o[1],0,0,0), C0,4); \
    KRD(GL,0); GAPB(o[0]=__builtin_amdgcn_mfma_f32_32x32x16_bf16(PAF(1),VFR(1),o[0],0,0,0), C0,8); \
    KRD(GL,1); GAPB(o[1]=__builtin_amdgcn_mfma_f32_32x32x16_bf16(PAF(1),VFR(5),o[1],0,0,0), C0,12); \
    KRD(GL,2); GAPB(o[0]=__builtin_amdgcn_mfma_f32_32x32x16_bf16(PAF(2),VFR(2),o[0],0,0,0), C1,0); \
    KRD(GL,3); GAPB(o[1]=__builtin_amdgcn_mfma_f32_32x32x16_bf16(PAF(2),VFR(6),o[1],0,0,0), C1,4); \
    GAPB(o[0]=__builtin_amdgcn_mfma_f32_32x32x16_bf16(PAF(3),VFR(3),o[0],0,0,0), C1,8); \
    GAPB(o[1]=__builtin_amdgcn_mfma_f32_32x32x16_bf16(PAF(3),VFR(7),o[1],0,0,0), C1,12); \
    if(GL&&NB!=2){ _Pragma("unroll") for(int r=0;r<16;++r){P0[r]-=mhat;P1[r]-=mhat;} PIN(P0); PIN(P1); SBAR(); } \
    }while(0)
  int t=1;
  #undef CMASK
  #define CMASK(P0,P1,t) do{}while(0)
  for(;t+5<NT;t+=2){
    STEP(pB0,pB1,pA0,pA1,t,true,true,true);     WAIT_BAR(2); RESC(); ROT();
    STEP(pA0,pA1,pB0,pB1,t+1,true,true,true);   WAIT_BAR(2); RESC(); ROT();
  }
  #undef CMASK
  #define CMASK(P0,P1,t) do{int jb_=(t)-(NT-4); if(mband&&jb_>=0)cmask(P0,P1,jb_,qrel,hi);}while(0)
  #define ENDW(tt) do{ if((tt)+3<NT){WAIT_BAR(2);} else if((tt)+2<NT){WAIT_BAR(1);} else {WAIT_BAR(0);} }while(0)
  for(;t+1<NT;t+=2){
    STEP(pB0,pB1,pA0,pA1,t,(t+3<NT),(t+1<NT),(t+1<NT));       ENDW(t);   RESC(); ROT();
    STEP(pA0,pA1,pB0,pB1,t+1,(t+4<NT),(t+2<NT),(t+2<NT));     ENDW(t+1); RESC(); ROT();
  }
  STEP(pB0,pB1,pA0,pA1,NT-1,false,false,false); RESC();
  { float sacc=pB0[0]+pB0[1]; _Pragma("unroll") for(int r=2;r<16;++r)sacc+=pB0[r]; _Pragma("unroll") for(int r=0;r<16;++r)sacc+=pB1[r]; l_reg+=sacc;
    pw0=(u32x4){PKW(pB0,0),PKW(pB0,2),PKW(pB0,4),PKW(pB0,6)};pw1=(u32x4){PKW(pB0,8),PKW(pB0,10),PKW(pB0,12),PKW(pB0,14)};pw2=(u32x4){PKW(pB1,0),PKW(pB1,2),PKW(pB1,4),PKW(pB1,6)};pw3=(u32x4){PKW(pB1,8),PKW(pB1,10),PKW(pB1,12),PKW(pB1,14)};
    SBAR(); pv(o,vb0+sl_cur,PAF(0),PAF(1),PAF(2),PAF(3)); }
  #undef PKW
  #undef PAF
  #undef VFR
  #undef PIN
  #undef MX3
  #undef GAPA
  #undef GAPB
  #undef EX
  #undef VRD
  #undef KRD
  #undef STEP
  #undef ENDW
  {auto rr=__builtin_amdgcn_permlane32_swap(__float_as_uint(l_reg),__float_as_uint(l_reg),false,false);l_reg=__uint_as_float(rr[0])+__uint_as_float(rr[1]);}
  if(hi==0){ wsf[32+r32]=l_reg; const long lrow=(rowbase+q0+wid*QBLK+r32)*4+h; lse_out[lrow]=mhat+__log2f(l_reg); if(lse_neg)lse_neg[lrow]=-INFINITY; } asm volatile("s_waitcnt lgkmcnt(0)":::"memory");
  float rli[16];
  #pragma unroll
  for(int r=0;r<16;++r)rli[r]=__builtin_amdgcn_rcpf(wsf[32+crow(r,hi)]);
  bf16*Ow=O+(rowbase+q0+wid*QBLK)*OP+h*D;
  { bf16*stg=(bf16*)(shm+LDS_OST)+wid*2048;
    #pragma unroll
    for(int r=0;r<16;++r){const int orow=crow(r,hi);
      #pragma unroll
      for(int d0=0;d0<2;++d0)stg[orow*64+d0*32+r32]=__float2bfloat16(o[d0][r]*rli[r]);}
    asm volatile("s_waitcnt lgkmcnt(0)":::"memory");
    #pragma unroll
    for(int i=0;i<4;++i){const int row=i*8+(lane>>3),ch=lane&7; const u32x4 v=*(const u32x4*)(stg+row*64+ch*8); ATTN_STORE16(Ow+(long)row*OP+ch*8,v);} }
  asm volatile("s_waitcnt lgkmcnt(0)\n\ts_barrier":::"memory");
  #undef DMA_K
  #undef DMA_V
  #undef CMASK
  #undef START
  #undef RESC
  #undef ROT
  #undef LDBIAS
}
constexpr int ATTN_LDS_BYTES=LDS_BYTES;
struct AttnTensors { const bf16* Q; const bf16* K; const bf16* V; bf16* O0; bf16* O1; float* L0; float* L1; const float* cum; const float* segt; };
constexpr int N_ITEMS=28*16+32;
template<int THRL=8,int NB=0> __device__ __forceinline__ void attn_phase_queue(char*lds,const AttnTensors&T,float skipthr,unsigned*ctr,volatile __attribute__((address_space(3))) unsigned*slot,int tid){
  unsigned nxt=0u; if(tid==0)nxt=__hip_atomic_fetch_add(ctr,1u,__ATOMIC_RELAXED,__HIP_MEMORY_SCOPE_AGENT);
  for(;;){
    if(tid==0)slot[0]=nxt;
    __syncthreads();
    const int idx=(int)__builtin_amdgcn_readfirstlane(slot[0]);
    __syncthreads();
    if(idx>=N_ITEMS)break;
    if(tid==0)nxt=__hip_atomic_fetch_add(ctr,1u,__ATOMIC_RELAXED,__HIP_MEMORY_SCOPE_AGENT);
    int qb,bh,part;
    if(idx<448){ qb=31-(idx>>4); bh=(idx&15)>>1; part=idx&1; } else { const int r=idx-448; qb=3-(r>>3); bh=r&7; part=2; }
    const int T0=(part==1)?2*qb+2:0, T1=(part==0)?2*qb+2:4*qb+4;
    attn_unit<THRL,NB>(bh/NHEAD,bh%NHEAD,qb,T0,T1,part!=0,skipthr,T.Q,T.K,T.V,part==0?T.O0:T.O1,part==0?T.L0:T.L1,part==2?T.L0:nullptr,T.cum+(long)bh*SEQ,T.segt+bh*8,lds,tid);
  }
}
#undef SBAR
#undef WAIT_BAR
}
struct Args { const float* in[24]; float* out; unsigned char* ws; int ph_lo, ph_hi; };
typedef const __attribute__((address_space(4))) Args* CArgs;
__device__ __forceinline__ CArgs get_args() { CArgs p = (CArgs)__builtin_amdgcn_kernarg_segment_ptr(); asm volatile("" : "+s"(p)); return p; }
struct Frame {
    LAS unsigned char* lds;
    volatile LAS unsigned* MISC;
    gu32* ctl;
    int tid, lane, wave;
    int vcu, G, bx;
};
__device__ __forceinline__ float bf2f(unsigned short b) { return __builtin_bit_cast(float, (unsigned)b << 16); }
__device__ __forceinline__ float bflo(unsigned w) { return __builtin_bit_cast(float, w << 16); }
__device__ __forceinline__ float bfhi(unsigned w) { return __builtin_bit_cast(float, w & 0xffff0000u); }
template <int CTRL> __device__ __forceinline__ float dppf(float x) { return __builtin_bit_cast(float, __builtin_amdgcn_mov_dpp(__builtin_bit_cast(int, x), CTRL, 0xf, 0xf, true)); }
__device__ __forceinline__ float row_sum16(float x) { x += dppf<0xB1>(x); x += dppf<0x4E>(x); x += dppf<0x141>(x); x += dppf<0x128>(x); return x; }
__device__ __forceinline__ float half_sum(float x) { auto rr = __builtin_amdgcn_permlane32_swap(__float_as_uint(x), __float_as_uint(x), false, false); return __uint_as_float(rr[0]) + __uint_as_float(rr[1]); }
__device__ __forceinline__ float pair16_sum(float x) { auto rr = __builtin_amdgcn_permlane16_swap(__float_as_uint(x), __float_as_uint(x), false, false); return __uint_as_float(rr[0]) + __uint_as_float(rr[1]); }
__device__ __forceinline__ float wave_sum_fast(float x) { return half_sum(pair16_sum(row_sum16(x))); }
__device__ __forceinline__ float wave_sum(float v) { return wave_sum_fast(v); }
__device__ __forceinline__ float sigm(float x) { return __builtin_amdgcn_rcpf(1.0f + __expf(-x)); }

template <class SRC>
__device__ __forceinline__ void conv_item(const float* W, int ldw, int K, bf16* WT, int dst0, int k0, const float* gain, LAS float* scr, int lane, SRC src) {
    const int cg = lane & 7, r8 = lane >> 3; const int sc = src(dst0 + 4 * cg); const int scc = sc < 0 ? 0 : sc;
#pragma unroll
    for (int i = 0; i < 8; ++i) { const int kk = 8 * i + r8;
        f32x4 v = *(const f32x4*)(W + (size_t)(k0 + kk) * ldw + scc); const float g = gain ? gain[k0 + kk] : 1.0f;
        if (sc < 0) v = (f32x4){0.f, 0.f, 0.f, 0.f};
        LAS float* d = scr + kk * 33 + 4 * cg; d[0] = v[0] * g; d[1] = v[1] * g; d[2] = v[2] * g; d[3] = v[3] * g; }
    LDS_WAIT(); asm volatile("" ::: "memory");
    const int c = lane & 7;
#pragma unroll
    for (int j = 0; j < 4; ++j) { const int n = (lane >> 3) + 8 * j; const LAS float* s = scr + (8 * c) * 33 + n;
        v4u o; o.x = pk2(s[0 * 33], s[1 * 33]); o.y = pk2(s[2 * 33], s[3 * 33]); o.z = pk2(s[4 * 33], s[5 * 33]); o.w = pk2(s[6 * 33], s[7 * 33]);
        *(GAS v4u*)(WT + (size_t)(dst0 + n) * K + k0 + 8 * c) = o; }
    LDS_WAIT(); asm volatile("" ::: "memory");
}
__device__ __forceinline__ void phase_weights(Frame& F, CArgs A, int l) {
    LAS float* scr = (LAS float*)(F.lds + RING_OFF + F.wave * 16384);
    const int gw = F.vcu * NWAVES + F.wave, NGW = F.G * NWAVES;
    const float* w_in = A->in[2] + (size_t)l * D * IN_COLS; const float* mixg = A->in[1] + (size_t)l * D;
    const float* p_ret = A->in[17] + (size_t)l * 256 * D; const float* p_fox = A->in[18] + (size_t)l * 256 * D; const float* p_rw = A->in[19] + (size_t)l * 256 * D;
    const float* w_out = A->in[20] + (size_t)l * D * D; const float* ffng = A->in[21] + (size_t)l * D;
    const float* w_gu = A->in[22] + (size_t)l * D * NGU; const float* w_down = A->in[23] + (size_t)l * DFF * D;
    bf16* Win_t = (bf16*)(A->ws + WS_WIN); bf16* Wgate_t = (bf16*)(A->ws + WS_WGATE); bf16* Pbr_t = (bf16*)(A->ws + WS_PBR);
    bf16* Wout_t = (bf16*)(A->ws + WS_WOUT); bf16* Wgu_t = (bf16*)(A->ws + WS_WGU); bf16* Wdown_t = (bf16*)(A->ws + WS_WDOWN);
    constexpr int I_IN = (NMIX / 32) * (D / 64), I_G = (NGATE / 32) * (D / 64), I_P = (D / 32) * (256 / 64), I_O = (D / 32) * (D / 64), I_GU = (NGU / 32) * (D / 64), I_DN = (D / 32) * (DFF / 64);
    constexpr int I_G2 = (256 / 32) * (128 / 64);
    constexpr int NITEMS = I_IN + I_G + 3 * I_P + I_O + I_GU + I_DN + I_G2;
    for (int it = gw; it < NITEMS; it += NGW) {
        int r = it;
        if (r < I_IN) { const int nb = r % (NMIX / 32), kb = r / (NMIX / 32);
            conv_item(w_in, IN_COLS, D, Win_t, nb * 32, kb * 64, mixg, scr, F.lane, [](int d) { return d < 1792 ? d : (d < 2816 ? d + 4 : (d < 2820 ? d - 1024 : -1)); }); continue; } r -= I_IN;
        if (r < I_G) { const int nb = r % (NGATE / 32), kb = r / (NGATE / 32);
            conv_item(w_in, IN_COLS, D, Wgate_t, nb * 32, kb * 64, mixg, scr, F.lane, [](int d) { return d + 2820; }); continue; } r -= I_G;
        if (r < 3 * I_P) { const int b = r / I_P, q = r % I_P, nb = q % (D / 32), kb = q / (D / 32); const float* src = b == 0 ? p_ret : (b == 1 ? p_fox : p_rw);
            conv_item(src, D, 256, Pbr_t + (size_t)b * D * 256, nb * 32, kb * 64, nullptr, scr, F.lane, [](int d) { return d; }); continue; } r -= 3 * I_P;
        if (r < I_O) { const int nb = r % (D / 32), kb = r / (D / 32);
            conv_item(w_out, D, D, Wout_t, nb * 32, kb * 64, nullptr, scr, F.lane, [](int d) { return d; }); continue; } r -= I_O;
        if (r < I_GU) { const int nb = r % (NGU / 32), kb = r / (NGU / 32);
            conv_item(w_gu, NGU, D, Wgu_t, nb * 32, kb * 64, ffng, scr, F.lane, [](int d) { const int t = d >> 8, w = d & 255; return w < 128 ? 128 * t + w : DFF + 128 * t + (w - 128); }); continue; } r -= I_GU;
        if (r < I_DN) { const int nb = r % (D / 32), kb = r / (D / 32);
            conv_item(w_down, D, DFF, Wdown_t, nb * 32, kb * 64, nullptr, scr, F.lane, [](int d) { return d; }); continue; } r -= I_DN;
        { const int nb = r % 8, kb = r / 8;
            conv_item(A->in[12] + (size_t)l * 128 * 256, 256, 128, (bf16*)(A->ws + WS_G2T), nb * 32, kb * 64, nullptr, scr, F.lane, [](int d) { return d; }); }
    }
}
__device__ __forceinline__ void phase_prologue(Frame& F, CArgs A) {
    const int gw = F.vcu * NWAVES + F.wave, NGW = F.G * NWAVES;
    const float* x = A->in[0]; bf16* XB = (bf16*)(A->ws + WS_XB); float* SS1 = (float*)(A->ws + WS_SS1);
    for (int m = gw; m < M; m += NGW) {
        const GAS f32x4* xr = (const GAS f32x4*)(x + (size_t)m * D) + F.lane; GAS f32x4* orow = (GAS f32x4*)(A->out + (size_t)m * D) + F.lane;
        GAS unsigned long long* o8 = (GAS unsigned long long*)(XB + (size_t)m * D) + F.lane; float s = 0.f;
#pragma unroll
        for (int j = 0; j < 4; ++j) { const f32x4 v = xr[64 * j]; s += (v.x * v.x + v.y * v.y) + (v.z * v.z + v.w * v.w);
            o8[64 * j] = (unsigned long long)pk2(v.x, v.y) | ((unsigned long long)pk2(v.z, v.w) << 32); }
        s = wave_sum(s);
        if (F.lane < 4) SS1[(size_t)m * 4 + F.lane] = F.lane == 0 ? s : 0.f;
    }
    float* rope = (float*)(A->ws + WS_ROPE);
    for (int e = (F.vcu * NWAVES + F.wave) * 64 + F.lane; e < SEQ * 32; e += NGW * 64) { const int t = e >> 5, i = e & 31;
        const float inv = exp2f(-(float)i * (13.287712379549449f / 32.0f)); const float ang = (float)t * inv;
        double rev = (double)ang * 0.15915494309189535; rev -= rint(rev); const float rv = (float)rev;
        rope[2 * e] = __builtin_amdgcn_cosf(rv); rope[2 * e + 1] = __builtin_amdgcn_sinf(rv); }
}
__device__ __forceinline__ void unpack8(const v4u w, float* f) { f[0] = bflo(w.x); f[1] = bfhi(w.x); f[2] = bflo(w.y); f[3] = bfhi(w.y); f[4] = bflo(w.z); f[5] = bfhi(w.z); f[6] = bflo(w.w); f[7] = bfhi(w.w); }
__device__ __forceinline__ float log_sigmoid(float z) { return fminf(z, 0.f) - __logf(1.0f + __expf(-fabsf(z))); }
__device__ __forceinline__ void phase_cumsum(Frame& F, CArgs A, int l) {
    LAS float* part = (LAS float*)(F.lds);
#pragma unroll 1
    for (int item = F.vcu; item < 64; item += F.G) {
        const int bh = item >> 3, seg = item & 7, b = bh >> 2, h = bh & 3; const float bias = A->in[6][l * 4 + h];
        const int t0 = seg * 1024 + F.tid * 2;
        const float* fl = (const float*)(A->ws + WS_FLOG) + ((size_t)b * SEQ + t0) * 4 + h; float* cum = (float*)(A->ws + WS_CUM) + (size_t)bh * SEQ + t0;
        const float lf0 = log_sigmoid(fl[0] + bias), lf1 = log_sigmoid(fl[4] + bias); const float s = lf0 + lf1;
        float incl = s;
#pragma unroll
        for (int o = 1; o < 64; o <<= 1) { const float t = __shfl_up(incl, o); if (F.lane >= o) incl += t; }
        __syncthreads();
        if (F.lane == 63) part[F.wave] = incl;
        __syncthreads();
        float run = incl - s;
        for (int w = 0; w < F.wave; ++w) run += part[w];
        cum[0] = run + lf0; cum[1] = run + s;
        if (F.tid == NWAVES * 64 - 1) ((float*)(A->ws + WS_SEGT))[bh * 8 + seg] = run + s;
    }
}
__device__ __forceinline__ float fox_skip_threshold(Frame& F, CArgs A, int l) {
    float gq = fabsf(A->in[4][l * 64 + F.lane]), gk = fabsf(A->in[5][l * 64 + F.lane]);
#pragma unroll
    for (int o = 1; o < 64; o <<= 1) { gq = fmaxf(gq, __shfl_xor(gq, o)); gk = fmaxf(gk, __shfl_xor(gk, o)); }
    const float bound = 0.125f * 1.4426950408889634f * 64.0f * gq * gk * 1.03f;
    return 64.0f + 2.0f * bound;
}
__device__ __forceinline__ void phase_fox_prep(Frame& F, CArgs A, int l) {
    const int gw = F.vcu * NWAVES + F.wave, NGW = F.G * NWAVES, lane = F.lane;
    bf16* MIXIN = (bf16*)(A->ws + WS_BIG); const float* gain = (lane < 32 ? A->in[4] : A->in[5]) + l * 64 + (lane & 7) * 8;
    const float sc = lane < 32 ? 0.125f * 1.4426950408889634f : 1.0f;
    float gv[8];
#pragma unroll
    for (int e = 0; e < 8; ++e) gv[e] = gain[e] * sc;
    for (int m = gw; m < M; m += NGW) {
        v4u* p = (v4u*)(MIXIN + (size_t)m * MIXLD + C_FOXQ + 8 * lane); const v4u w = *p;
        float f[8] = {bflo(w.x), bfhi(w.x), bflo(w.y), bfhi(w.y), bflo(w.z), bfhi(w.z), bflo(w.w), bfhi(w.w)};
        float ss = 0.f;
#pragma unroll
        for (int e = 0; e < 8; ++e) ss += f[e] * f[e];
        ss += dppf<0xB1>(ss); ss += dppf<0x4E>(ss); ss += dppf<0x141>(ss);
        const float rs = __builtin_amdgcn_rsqf(ss * (1.f / 64.f) + 1e-6f);
        v4u o; o.x = pk2(f[0] * rs * gv[0], f[1] * rs * gv[1]); o.y = pk2(f[2] * rs * gv[2], f[3] * rs * gv[3]); o.z = pk2(f[4] * rs * gv[4], f[5] * rs * gv[5]); o.w = pk2(f[6] * rs * gv[6], f[7] * rs * gv[7]);
        *p = o;
    }
}
constexpr int STG_OFF = 132096;
__device__ __forceinline__ float lerp_col(const bf16* MIXIN, int m, int t, int col, float mu) {
    const float cur = bf2f(MIXIN[(size_t)m * MIXLD + C_RW + col]); const float prev = t > 0 ? bf2f(MIXIN[(size_t)(m - 1) * MIXLD + C_RW + col]) : 0.f;
    return cur + (prev - cur) * mu;
}
typedef short pbf16x8 __attribute__((ext_vector_type(8)));
__device__ __forceinline__ void phase_rwkv_prep(Frame& F, CArgs A, int l) {
    const float* w2 = A->in[9] + (size_t)l * 64 * 256; const float* a2 = A->in[11] + (size_t)l * 64 * 256;
    const float* mu = A->in[7] + (size_t)l * 1024; const float* w0 = A->in[8] + l * 256; const float* a0 = A->in[10] + l * 256;
    const bf16* MIXIN = (const bf16*)(A->ws + WS_BIG); float* SW = (float*)(A->ws + WS_SW); float* SA = (float*)(A->ws + WS_SA);
    const int lane = F.lane, fr = lane & 15, fq = lane >> 4, w = F.wave;
    pbf16x8 bh_[2][2][2], bl_[2][2][2];
#pragma unroll
    for (int mt = 0; mt < 2; ++mt)
#pragma unroll
        for (int nt = 0; nt < 2; ++nt)
#pragma unroll
            for (int ks = 0; ks < 2; ++ks) { const float* W = (mt ? a2 : w2) + (size_t)(32 * ks + 8 * fq) * 256 + 32 * w + 16 * nt + fr; unsigned hw[4], lw[4];
#pragma unroll
                for (int j = 0; j < 4; ++j) { const float x0 = W[(2 * j) * 256], x1 = W[(2 * j + 1) * 256]; const unsigned h0 = f2bf(x0), h1 = f2bf(x1);
                    hw[j] = h0 | (h1 << 16); lw[j] = pk2(x0 - bf2f((unsigned short)h0), x1 - bf2f((unsigned short)h1)); }
                bh_[mt][nt][ks] = __builtin_bit_cast(pbf16x8, (v4u){hw[0], hw[1], hw[2], hw[3]}); bl_[mt][nt][ks] = __builtin_bit_cast(pbf16x8, (v4u){lw[0], lw[1], lw[2], lw[3]}); }
#pragma unroll 1
    for (int item = F.vcu; item < M / 64; item += F.G) {
        const size_t mb = (size_t)item * 64;
        __syncthreads();
        { const int tok = F.tid >> 3, c = F.tid & 7; const size_t m = mb + tok; const int t = (int)(m & (SEQ - 1));
          const v4u* cp = (const v4u*)(MIXIN + m * MIXLD + C_RW + 768 + 16 * c); const v4u* pp = (const v4u*)(MIXIN + (m > 0 ? m - 1 : 0) * MIXLD + C_RW + 768 + 16 * c);
          float cur[16], prv[16]; unpack8(cp[0], cur); unpack8(cp[1], cur + 8);
          unpack8(pp[0], prv); unpack8(pp[1], prv + 8);
          if (t == 0) {
#pragma unroll
              for (int e = 0; e < 16; ++e) prv[e] = 0.f; }
          const float* mup = mu + 768 + 16 * c; unsigned hw[8], lw[8];
#pragma unroll
          for (int e = 0; e < 8; ++e) { float x0 = cur[2 * e] + (prv[2 * e] - cur[2 * e]) * mup[2 * e], x1 = cur[2 * e + 1] + (prv[2 * e + 1] - cur[2 * e + 1]) * mup[2 * e + 1];
              if (c < 4) { x0 = 1.0f - 2.0f * __builtin_amdgcn_rcpf(1.0f + __expf(2.0f * x0)); x1 = 1.0f - 2.0f * __builtin_amdgcn_rcpf(1.0f + __expf(2.0f * x1)); }
              const unsigned h0 = f2bf(x0), h1 = f2bf(x1); hw[e] = h0 | (h1 << 16); lw[e] = pk2(x0 - bf2f((unsigned short)h0), x1 - bf2f((unsigned short)h1)); }
          LAS unsigned char* xh = F.lds + (((c >> 2) * 2 + 0) * 64 + tok) * 144 + 32 * (c & 3); LAS unsigned char* xl = F.lds + (((c >> 2) * 2 + 1) * 64 + tok) * 144 + 32 * (c & 3);
          *(LAS v4u*)xh = (v4u){hw[0], hw[1], hw[2], hw[3]}; *(LAS v4u*)(xh + 16) = (v4u){hw[4], hw[5], hw[6], hw[7]};
          *(LAS v4u*)xl = (v4u){lw[0], lw[1], lw[2], lw[3]}; *(LAS v4u*)(xl + 16) = (v4u){lw[4], lw[5], lw[6], lw[7]}; }
        __syncthreads();
#pragma unroll
        for (int mt = 0; mt < 4; ++mt)
#pragma unroll
            for (int mat = 0; mat < 2; ++mat) { f32x4 acc[2] = {(f32x4){0.f, 0.f, 0.f, 0.f}, (f32x4){0.f, 0.f, 0.f, 0.f}};
#pragma unroll
                for (int ks = 0; ks < 2; ++ks) { const pbf16x8 ah = *(const LAS pbf16x8*)(F.lds + ((mat * 2 + 0) * 64 + 16 * mt + fr) * 144 + (32 * ks + 8 * fq) * 2);
                    const pbf16x8 al = *(const LAS pbf16x8*)(F.lds + ((mat * 2 + 1) * 64 + 16 * mt + fr) * 144 + (32 * ks + 8 * fq) * 2);
#pragma unroll
                    for (int nt = 0; nt < 2; ++nt) { acc[nt] = __builtin_amdgcn_mfma_f32_16x16x32_bf16(ah, bh_[mat][nt][ks], acc[nt], 0, 0, 0);
                        acc[nt] = __builtin_amdgcn_mfma_f32_16x16x32_bf16(ah, bl_[mat][nt][ks], acc[nt], 0, 0, 0); acc[nt] = __builtin_amdgcn_mfma_f32_16x16x32_bf16(al, bh_[mat][nt][ks], acc[nt], 0, 0, 0); } }
#pragma unroll
                for (int nt = 0; nt < 2; ++nt) { const int ch = 32 * w + 16 * nt + fr; const float bias = mat ? a0[ch] : w0[ch];
#pragma unroll
                    for (int r = 0; r < 4; ++r) { const size_t m = mb + 16 * mt + 4 * fq + r; const float z = acc[nt][r] + bias;
                        if (mat == 0) { const float nz = -z; const float sp = fmaxf(nz, 0.f) + __logf(1.0f + __expf(-fabsf(nz))); SW[m * 256 + ch] = __expf(-__expf(-sp - 0.5f)); }
                        else SA[m * 256 + ch] = sigm(z); } } }
    }
}
template <int VAR> __device__ __forceinline__ void phase_rwkv_scan1(Frame& F, CArgs A, int l) {
    const int w2 = F.wave >> 2, p = F.wave & 3, lane = F.lane, kh = lane >> 5, row = 32 * w2 + (lane & 31);
    const bf16* MIXIN = (const bf16*)(A->ws + WS_BIG); const float* SW = (const float*)(A->ws + WS_SW); const float* SA = (const float*)(A->ws + WS_SA);
    float* YL = (float*)(A->ws + WS_YL); bf16* U = (bf16*)(A->ws + WS_U); float* LS = (float*)(A->ws + WS_LS); bf16* TT = (bf16*)(A->ws + WS_TT); float* BS = (float*)(A->ws + WS_BS);
    LAS float* ops_u = (LAS float*)(F.lds) + p * 4096;
    LAS float* gfin = (LAS float*)(F.lds + 65536) + p * 64;
    LAS float* vst = (LAS float*)(F.lds + 66560) + F.wave * 1024;
    const float* mu = A->in[7] + (size_t)l * 1024;
#pragma unroll 1
    for (int wg = F.vcu; wg < 256; wg += F.G) {
        const int bh = wg >> 5, b = bh >> 2, h = bh & 3, chunk = 4 * (wg & 31) + p, t0 = chunk * 64, hk = h * 64 + lane, hr = h * 64 + row;
        const size_t m0 = (size_t)b * SEQ + t0;
        const float mur = mu[hk], muk = mu[256 + hk], muv = mu[512 + hr], kkp = A->in[13][l * 256 + hk], kap = A->in[14][l * 256 + hk], rkp = A->in[15][l * 256 + hk];
        float Sl[32], Si[32];
#pragma unroll
        for (int k = 0; k < 32; ++k) { Sl[k] = 0.f; Si[k] = (32 * kh + k == row) ? 1.f : 0.f; }
        float vprev = 0.f, gam = 1.f;
        { const size_t mp = m0 > 0 ? m0 - 1 : 0; const float v_ = bf2f(MIXIN[mp * MIXLD + C_RW + 512 + hr]); if (t0 > 0) vprev = v_; }
        float kc[4], xr[4], xw[8], aa[4], kp0_, rp0_, vn[8];
#define RW_LOAD(sb_, VD) do { const size_t mf_ = m0 + 8 * (sb_) + 4 * w2; const size_t mp_ = mf_ > 0 ? mf_ - 1 : 0; const bool z_ = (t0 + 8 * (sb_) + 4 * w2) == 0; \
            { const float k_ = bf2f(MIXIN[mp_ * MIXLD + C_RW + 256 + hk]), r_ = bf2f(MIXIN[mp_ * MIXLD + C_RW + hk]); kp0_ = z_ ? 0.f : k_; rp0_ = z_ ? 0.f : r_; } \
            _Pragma("unroll") for (int j = 0; j < 4; ++j) { const size_t m = mf_ + j; \
            kc[j] = bf2f(MIXIN[m * MIXLD + C_RW + 256 + hk]); aa[j] = SA[m * 256 + hk]; xr[j] = bf2f(MIXIN[m * MIXLD + C_RW + hk]); } \
            _Pragma("unroll") for (int j = 0; j < 8; ++j) { xw[j] = SW[(m0 + 8 * (sb_) + j) * 256 + hk]; VD[j] = bf2f(MIXIN[(m0 + 8 * (sb_) + j) * MIXLD + C_RW + 512 + hr]); } } while (0)
#define RW_COMP(sb_) do { LAS float* ob_ = ops_u + ((sb_) & 1) * 2048 + (4 * w2) * 256; float kprev = kp0_, rprev = rp0_; \
            _Pragma("unroll") for (int j = 0; j < 8; ++j) vst[(((sb_) & 1) * 8 + j) * 64 + lane] = vn[j]; \
            _Pragma("unroll") for (int jj = 0; jj < 8; ++jj) { const float gprev = gam; gam = gam * xw[jj]; \
              if ((jj >> 2) == w2) { const int j = jj & 3; const float kl = kc[j] + (kprev - kc[j]) * muk; kprev = kc[j]; const float a = aa[j]; \
                float kk = kl * kkp; const float n2 = wave_sum_fast(kk * kk); kk = kk * __builtin_amdgcn_rsqf(fmaxf(n2, 1e-24f)); \
                const float kp = kl * (1.f + (a - 1.f) * kap); const float r = xr[j] + (rprev - xr[j]) * mur; rprev = xr[j]; const float ginv = __builtin_amdgcn_rcpf(gam); \
                ob_[j * 256 + lane] = kk * gprev; ob_[j * 256 + 64 + lane] = -kk * a * ginv; ob_[j * 256 + 128 + lane] = kp * ginv; ob_[j * 256 + 192 + lane] = r * gam; \
                const float bs = wave_sum_fast(r * kp * rkp); if (lane == 0) BS[(m0 + 8 * (sb_) + jj) * 4 + h] = bs; } } } while (0)
        __syncthreads();
        RW_LOAD(0, vn); RW_COMP(0);
#pragma unroll 1
        for (int sb = 0; sb < 8; ++sb) {
            __syncthreads();
            if (sb < 7 && VAR != 2) RW_LOAD(sb + 1, vn);
            const LAS float* ob = ops_u + (sb & 1) * 2048 + 32 * kh;
#pragma unroll 1
            for (int j = 0; j < (VAR == 1 ? 0 : 8); ++j) { const size_t m = m0 + 8 * sb + j; const LAS f32x4* o4 = (const LAS f32x4*)(ob + j * 256); const float vraw = vst[((sb & 1) * 8 + j) * 64 + lane];
                f32x4 kkc[8];
#pragma unroll
                for (int q = 0; q < 8; ++q) kkc[q] = o4[q];
                f32x4 rg[3][3];
#pragma unroll
                for (int g = 0; g < 3; ++g) { rg[g][0] = o4[16 + g]; rg[g][1] = o4[32 + g]; rg[g][2] = o4[48 + g]; }
                asm volatile("" ::: "memory");
                float sl0 = 0.f, sl1 = 0.f, si0 = 0.f, si1 = 0.f;
#pragma unroll
                for (int q = 0; q < 8; ++q) { const f32x4 kk4 = kkc[q];
                    sl0 = fmaf(Sl[4 * q], kk4[0], sl0); sl1 = fmaf(Sl[4 * q + 1], kk4[1], sl1); sl0 = fmaf(Sl[4 * q + 2], kk4[2], sl0); sl1 = fmaf(Sl[4 * q + 3], kk4[3], sl1);
                    si0 = fmaf(Si[4 * q], kk4[0], si0); si1 = fmaf(Si[4 * q + 1], kk4[1], si1); si0 = fmaf(Si[4 * q + 2], kk4[2], si0); si1 = fmaf(Si[4 * q + 3], kk4[3], si1); }
                const float sal = half_sum(sl0 + sl1), sai = half_sum(si0 + si1);
                const float v = vraw + (vprev - vraw) * muv; vprev = vraw;
                float yl0 = 0.f, yl1 = 0.f, yi0 = 0.f, yi1 = 0.f;
#pragma unroll
                for (int q = 0; q < 8; ++q) {
                    const f32x4 nb4 = rg[q % 3][0], kp4 = rg[q % 3][1], r4 = rg[q % 3][2];
#pragma unroll
                    for (int e = 0; e < 4; ++e) { const int k = 4 * q + e;
                        Sl[k] = fmaf(sal, nb4[e], fmaf(v, kp4[e], Sl[k])); Si[k] = fmaf(sai, nb4[e], Si[k]);
                        if (e & 1) { yl1 = fmaf(Sl[k], r4[e], yl1); yi1 = fmaf(Si[k], r4[e], yi1); } else { yl0 = fmaf(Sl[k], r4[e], yl0); yi0 = fmaf(Si[k], r4[e], yi0); } }
                    if (q < 5) { rg[q % 3][0] = o4[16 + q + 3]; rg[q % 3][1] = o4[32 + q + 3]; rg[q % 3][2] = o4[48 + q + 3]; }
                    asm volatile("" ::: "memory"); }
                const float yl = half_sum(yl0 + yl1), yi = half_sum(yi0 + yi1);
                if (kh == 0) { YL[m * 256 + hr] = yl; U[m * 256 + hr] = (bf16)f2bf(yi); }
                }
            if (sb < 7 && VAR != 2) { RW_COMP(sb + 1); }
            if (sb == 6 && w2 == 0) gfin[lane] = gam;
        }
#undef RW_LOAD
#undef RW_COMP
        { f32x4 gf[8];
#pragma unroll
          for (int q = 0; q < 8; ++q) gf[q] = ((const LAS f32x4*)(gfin + 32 * kh))[q];
          f32x4* lp = (f32x4*)(LS + (((size_t)bh * 128 + chunk) * 64 + row) * 64 + 32 * kh);
#pragma unroll
          for (int q = 0; q < 8; ++q) lp[q] = (f32x4){Sl[4 * q] * gf[q][0], Sl[4 * q + 1] * gf[q][1], Sl[4 * q + 2] * gf[q][2], Sl[4 * q + 3] * gf[q][3]};
          bf16* tp = TT + ((size_t)bh * 128 + chunk) * 4096 + (size_t)(32 * kh) * 64 + row;
#pragma unroll
          for (int k = 0; k < 32; ++k) tp[k * 64] = (bf16)f2bf(Si[k] * gf[k >> 2][k & 3]); }
    }
}
__device__ __forceinline__ void phase_rwkv_carry(Frame& F, CArgs A, int l) {
    const float* LS = (const float*)(A->ws + WS_LS); float* SIN = (float*)(A->ws + WS_SIN); const bf16* TT = (const bf16*)(A->ws + WS_TT);
    const int lane = F.lane, tid = F.tid, wv = F.wave, fr = lane & 15, fq = lane >> 4;
    constexpr int STG = 13568;
    typedef unsigned v2u_ __attribute__((ext_vector_type(2)));
#pragma unroll 1
    for (int g = F.vcu >> 3; g < 32; g += (F.G + 7) / 8) { const int bh = g >> 2, rg = g & 3;
        __syncthreads();
        if (wv >= 4) {
            const int lt = tid - 256; const bf16* tsrc = TT + ((size_t)bh * 128 * 64 + (lt >> 2)) * 64 + 16 * (lt & 3);
            const int tdst = (lt >> 2) * 144 + (lt & 3) * 32;
            const float* lsrc = LS + (size_t)bh * 128 * 4096 + (16 * rg + (lt >> 4)) * 64 + 4 * (lt & 15);
            const int ldst = 9216 + (lt >> 4) * 272 + (lt & 15) * 16;
            v4u rt[16][3];
#define CL_LD(slot, n_) do { rt[slot][0] = *(const v4u*)(tsrc + (size_t)(n_) * 4096); rt[slot][1] = *(const v4u*)(tsrc + (size_t)(n_) * 4096 + 8); \
                rt[slot][2] = *(const v4u*)(lsrc + (size_t)(n_) * 4096); } while (0)
#define CL_WR(slot, n_) do { LAS unsigned char* st_ = F.lds + ((n_) & 1) * STG; *(LAS v4u*)(st_ + tdst) = rt[slot][0]; *(LAS v4u*)(st_ + tdst + 16) = rt[slot][1]; \
                *(LAS v4u*)(st_ + ldst) = rt[slot][2]; } while (0)
#pragma unroll
            for (int i = 0; i < 16; ++i) CL_LD(i, i);
            CL_WR(0, 0); CL_LD(0, 16);
            __syncthreads();
#define CL_LSTEP(n_, slot) do { const int nw_ = (n_) + 1 < 127 ? (n_) + 1 : 126, nl_ = (n_) + 17 < 127 ? (n_) + 17 : 126; CL_WR(((slot) + 1) & 15, nw_); CL_LD(((slot) + 1) & 15, nl_); __syncthreads(); } while (0)
#pragma unroll 1
            for (int nb = 0; nb < 128; nb += 16) { CL_LSTEP(nb, 0); CL_LSTEP(nb + 1, 1); CL_LSTEP(nb + 2, 2); CL_LSTEP(nb + 3, 3); CL_LSTEP(nb + 4, 4); CL_LSTEP(nb + 5, 5); CL_LSTEP(nb + 6, 6); CL_LSTEP(nb + 7, 7);
                CL_LSTEP(nb + 8, 8); CL_LSTEP(nb + 9, 9); CL_LSTEP(nb + 10, 10); CL_LSTEP(nb + 11, 11); CL_LSTEP(nb + 12, 12); CL_LSTEP(nb + 13, 13); CL_LSTEP(nb + 14, 14); CL_LSTEP(nb + 15, 15); }
#undef CL_LD
#undef CL_WR
#undef CL_LSTEP
        } else {
            float* sp = SIN + (size_t)bh * 128 * 4096 + (size_t)(16 * rg + fr) * 64 + 4 * fq;
            __syncthreads();
            v4u sb0 = (v4u){0u, 0u, 0u, 0u}, sb1 = (v4u){0u, 0u, 0u, 0u};
#define CL_CSTEP(n_, slot) do { if (wv == 0) { const LAS unsigned char* st_ = F.lds + ((n_) & 1) * STG; f32x4 acc[4];     \
                _Pragma("unroll") for (int jt = 0; jt < 4; ++jt) acc[jt] = *(const LAS f32x4*)(st_ + 9216 + fr * 272 + (16 * jt + 4 * fq) * 4);     \
                _Pragma("unroll") for (int ks = 0; ks < 2; ++ks) { const pbf16x8 bfr = __builtin_bit_cast(pbf16x8, ks == 0 ? sb0 : sb1); \
                    _Pragma("unroll") for (int jt = 0; jt < 4; ++jt) { const LAS unsigned char* ab = st_ + (16 * jt + fr) * 144 + (32 * ks + 4 * fq) * 2; \
                        const v2u_ lo_ = *(const LAS v2u_*)ab, hi_ = *(const LAS v2u_*)(ab + 32); \
                        acc[jt] = __builtin_amdgcn_mfma_f32_16x16x32_bf16(__builtin_bit_cast(pbf16x8, (v4u){lo_.x, lo_.y, hi_.x, hi_.y}), bfr, acc[jt], 0, 0, 0); } } \
                const int nd_ = (n_) < 127 ? (n_) + 1 : 0;        \
                _Pragma("unroll") for (int jt = 0; jt < 4; ++jt) *(f32x4*)(sp + (size_t)nd_ * 4096 + 16 * jt) = acc[jt]; \
                sb0 = (v4u){pk2(acc[0][0], acc[0][1]), pk2(acc[0][2], acc[0][3]), pk2(acc[1][0], acc[1][1]), pk2(acc[1][2], acc[1][3])}; \
                sb1 = (v4u){pk2(acc[2][0], acc[2][1]), pk2(acc[2][2], acc[2][3]), pk2(acc[3][0], acc[3][1]), pk2(acc[3][2], acc[3][3])}; } \
                __syncthreads(); } while (0)
#pragma unroll 1
            for (int nb = 0; nb < 128; nb += 8) { CL_CSTEP(nb, 0); CL_CSTEP(nb + 1, 1); CL_CSTEP(nb + 2, 2); CL_CSTEP(nb + 3, 3); CL_CSTEP(nb + 4, 4); CL_CSTEP(nb + 5, 5); CL_CSTEP(nb + 6, 6); CL_CSTEP(nb + 7, 7); }
#undef CL_CSTEP
        }
    }
}
typedef short rbf16x8 __attribute__((ext_vector_type(8)));
__device__ __forceinline__ void phase_rwkv_fix(Frame& F, CArgs A, int l) {
    LAS unsigned char* XG = F.lds;
    const bf16* MIXIN = (const bf16*)(A->ws + WS_BIG); bf16* YW = (bf16*)(A->ws + WS_YW); const float* YL = (const float*)(A->ws + WS_YL); const bf16* U = (const bf16*)(A->ws + WS_U);
    const float* SIN = (const float*)(A->ws + WS_SIN); const float* BS = (const float*)(A->ws + WS_BS); const bf16* G2T = (const bf16*)(A->ws + WS_G2T);
    const float* mu = A->in[7] + (size_t)l * 1024; const float* gn = A->in[16] + l * 256;
    const int lane = F.lane, su = F.wave >> 1, tp = F.wave & 1, ut = F.tid & 127, fr = lane & 15, fq = lane >> 4;
#pragma unroll 1
    for (int u0 = 4 * F.vcu; u0 < 1024; u0 += 4 * F.G) {
        const int unit = u0 + su, bh = unit >> 7, chunk = unit & 127, b = bh >> 2, h = bh & 3; const size_t mb = (size_t)b * SEQ + chunk * 64;
        __syncthreads();
        { const int tok = ut >> 1, q2 = ut & 1; const size_t m = mb + tok; const int t = chunk * 64 + tok;
          const v4u* cp = (const v4u*)(MIXIN + m * MIXLD + C_RW + 896 + 64 * q2); const v4u* pp = (const v4u*)(MIXIN + (m > 0 ? m - 1 : 0) * MIXLD + C_RW + 896 + 64 * q2);
#pragma unroll
          for (int c = 0; c < 8; ++c) { const v4u cw = cp[c]; v4u pw = pp[c]; if (t == 0) pw = (v4u){0u, 0u, 0u, 0u};
              const float* mup = mu + 896 + 64 * q2 + 8 * c; float o[8];
              const unsigned cwa[4] = {cw.x, cw.y, cw.z, cw.w}, pwa[4] = {pw.x, pw.y, pw.z, pw.w};
#pragma unroll
              for (int e = 0; e < 4; ++e) { const float c0 = bflo(cwa[e]), c1 = bfhi(cwa[e]), p0 = bflo(pwa[e]), p1 = bfhi(pwa[e]);
                  o[2 * e] = sigm(c0 + (p0 - c0) * mup[2 * e]); o[2 * e + 1] = sigm(c1 + (p1 - c1) * mup[2 * e + 1]); }
              v4u w; w.x = pk2(o[0], o[1]); w.y = pk2(o[2], o[3]); w.z = pk2(o[4], o[5]); w.w = pk2(o[6], o[7]);
              *(LAS v4u*)(XG + ((su * 64 + tok) * 136 + 64 * q2 + 8 * c) * 2) = w; } }
        __syncthreads();
        f32x4 acc[2][4], accg[2][4];
#pragma unroll
        for (int th = 0; th < 2; ++th)
#pragma unroll
            for (int vt = 0; vt < 4; ++vt) { acc[th][vt] = (f32x4){0.f, 0.f, 0.f, 0.f}; accg[th][vt] = (f32x4){0.f, 0.f, 0.f, 0.f}; }
        if (chunk > 0) {
            const float* sin_ = SIN + ((size_t)bh * 128 + chunk) * 4096;
#pragma unroll
            for (int ks = 0; ks < 2; ++ks) {
                const rbf16x8 af0 = *(const rbf16x8*)(U + (mb + 32 * tp + fr) * 256 + h * 64 + 32 * ks + 8 * fq);
                const rbf16x8 af1 = *(const rbf16x8*)(U + (mb + 32 * tp + 16 + fr) * 256 + h * 64 + 32 * ks + 8 * fq);
#pragma unroll
                for (int vt = 0; vt < 4; ++vt) { const f32x4* sp = (const f32x4*)(sin_ + (16 * vt + fr) * 64 + 32 * ks + 8 * fq); const f32x4 s0 = sp[0], s1 = sp[1];
                    v4u bw; bw.x = pk2(s0[0], s0[1]); bw.y = pk2(s0[2], s0[3]); bw.z = pk2(s1[0], s1[1]); bw.w = pk2(s1[2], s1[3]);
                    const rbf16x8 bfr = __builtin_bit_cast(rbf16x8, bw);
                    acc[0][vt] = __builtin_amdgcn_mfma_f32_16x16x32_bf16(af0, bfr, acc[0][vt], 0, 0, 0);
                    acc[1][vt] = __builtin_amdgcn_mfma_f32_16x16x32_bf16(af1, bfr, acc[1][vt], 0, 0, 0); } }
        }
#pragma unroll
        for (int ks = 0; ks < 4; ++ks) {
            const rbf16x8 af0 = *(const LAS rbf16x8*)(XG + ((su * 64 + 32 * tp + fr) * 136 + 32 * ks + 8 * fq) * 2);
            const rbf16x8 af1 = *(const LAS rbf16x8*)(XG + ((su * 64 + 32 * tp + 16 + fr) * 136 + 32 * ks + 8 * fq) * 2);
#pragma unroll
            for (int vt = 0; vt < 4; ++vt) { const rbf16x8 bfr = *(const rbf16x8*)(G2T + (size_t)(h * 64 + 16 * vt + fr) * 128 + 32 * ks + 8 * fq);
                accg[0][vt] = __builtin_amdgcn_mfma_f32_16x16x32_bf16(af0, bfr, accg[0][vt], 0, 0, 0);
                accg[1][vt] = __builtin_amdgcn_mfma_f32_16x16x32_bf16(af1, bfr, accg[1][vt], 0, 0, 0); } }
#pragma unroll
        for (int th = 0; th < 2; ++th)
#pragma unroll
        for (int r = 0; r < 4; ++r) { const size_t m = mb + 32 * tp + 16 * th + 4 * fq + r; const int t = chunk * 64 + 32 * tp + 16 * th + 4 * fq + r;
            float y[4]; float sm = 0.f;
#pragma unroll
            for (int vt = 0; vt < 4; ++vt) { y[vt] = YL[m * 256 + h * 64 + 16 * vt + fr] + acc[th][vt][r]; sm += y[vt]; }
            sm = row_sum16(sm);
            const float mean = sm * (1.f / 64.f); float vs = 0.f;
#pragma unroll
            for (int vt = 0; vt < 4; ++vt) { y[vt] -= mean; vs += y[vt] * y[vt]; }
            vs = row_sum16(vs);
            const float rs = __builtin_amdgcn_rsqf(vs * (1.f / 64.f) + 64e-5f); const float bsv = BS[m * 4 + h];
#pragma unroll
            for (int vt = 0; vt < 4; ++vt) { const int ch = h * 64 + 16 * vt + fr;
                const float vc = bf2f(MIXIN[m * MIXLD + C_RW + 512 + ch]), vpl = bf2f(MIXIN[(m > 0 ? m - 1 : 0) * MIXLD + C_RW + 512 + ch]), vp = t > 0 ? vpl : 0.f, vv = vc + (vp - vc) * mu[512 + ch];
                YW[m * 256 + ch] = (bf16)f2bf((y[vt] * rs * gn[ch] + bsv * vv) * accg[th][vt][r]); } }
    }
}
constexpr int LQ = 72, LKP = 136;
constexpr int RL_QS = 0, RL_KS = 18432, RL_VT = 36864, RL_KD = 54272, RL_PS = 71680;
constexpr size_t WS_UB = 1 * MiB;
typedef short rbf16x8 __attribute__((ext_vector_type(8)));
__device__ __forceinline__ void rot8(const float* rope, int pos, int c, const float* lo, const float* hi, float* olo, float* ohi) {
    const f32x4* rp = (const f32x4*)(rope + ((size_t)pos * 32 + 8 * c) * 2);
#pragma unroll
    for (int q = 0; q < 4; ++q) { const f32x4 cs = rp[q];
        olo[2 * q] = lo[2 * q] * cs[0] - hi[2 * q] * cs[1]; ohi[2 * q] = lo[2 * q] * cs[1] + hi[2 * q] * cs[0];
        olo[2 * q + 1] = lo[2 * q + 1] * cs[2] - hi[2 * q + 1] * cs[3]; ohi[2 * q + 1] = lo[2 * q + 1] * cs[3] + hi[2 * q + 1] * cs[2]; }
}
__device__ __forceinline__ void ret_stage_vt(Frame& F, const bf16* MIXIN, size_t mb, int h) {
    const int j = F.tid & 127, dg = F.tid >> 7; const v4u* vp = (const v4u*)(MIXIN + (mb + j) * MIXLD + C_RETV + h * 64 + 16 * dg);
    const v4u a = vp[0], c = vp[1]; LAS bf16* Vt = (LAS bf16*)(F.lds + RL_VT) + (16 * dg) * LKP + j;
    const unsigned w[8] = {a.x, a.y, a.z, a.w, c.x, c.y, c.z, c.w};
#pragma unroll
    for (int e = 0; e < 8; ++e) { Vt[(2 * e) * LKP] = (bf16)(w[e] & 0xffffu); Vt[(2 * e + 1) * LKP] = (bf16)(w[e] >> 16); }
}
__device__ __forceinline__ void phase_ret_state(Frame& F, CArgs A, int l) {
    const bf16* MIXIN = (const bf16*)(A->ws + WS_BIG); const float* rope = (const float*)(A->ws + WS_ROPE); bf16* UB = (bf16*)(A->ws + WS_UB);
    const int lane = F.lane, fr = lane & 15, fq = lane >> 4, w = F.wave;
#pragma unroll 1
    for (int u = F.vcu; u < 512; u += F.G) {
        const int bh = u >> 6, n = u & 63, b = bh >> 2, h = bh & 3; const size_t mb = (size_t)b * SEQ + n * 128;
        const float lg2g = log2f(1.0f - exp2f(-5.0f - (float)h));
        __syncthreads();
        { const int j = F.tid & 127, c2 = F.tid >> 7; const bf16* kp = MIXIN + (mb + j) * MIXLD + C_RETK + h * 64 + 8 * c2;
          float lo[8], hi[8], olo[8], ohi[8]; unpack8(*(const v4u*)kp, lo); unpack8(*(const v4u*)(kp + 32), hi);
          rot8(rope, n * 128 + j, c2, lo, hi, olo, ohi); const float dk = __builtin_amdgcn_exp2f((float)(127 - j) * lg2g);
          LAS bf16* Kd = (LAS bf16*)(F.lds + RL_KD) + j;
#pragma unroll
          for (int e = 0; e < 8; ++e) { Kd[(8 * c2 + e) * LKP] = (bf16)f2bf(olo[e] * dk); Kd[(32 + 8 * c2 + e) * LKP] = (bf16)f2bf(ohi[e] * dk); } }
        ret_stage_vt(F, MIXIN, mb, h);
        __syncthreads();
#pragma unroll
        for (int ti = 0; ti < 2; ++ti) { const int tI = 2 * w + ti, at = tI >> 2, ct = tI & 3; f32x4 acc = (f32x4){0.f, 0.f, 0.f, 0.f};
#pragma unroll
            for (int ks = 0; ks < 4; ++ks) { const rbf16x8 af = *(const LAS rbf16x8*)(F.lds + RL_KD + ((16 * at + fr) * LKP + 32 * ks + 8 * fq) * 2);
                const rbf16x8 bfr = *(const LAS rbf16x8*)(F.lds + RL_VT + ((16 * ct + fr) * LKP + 32 * ks + 8 * fq) * 2);
                acc = __builtin_amdgcn_mfma_f32_16x16x32_bf16(af, bfr, acc, 0, 0, 0); }
#pragma unroll
            for (int r = 0; r < 4; ++r) UB[((size_t)(bh * 64 + n) * 64 + 16 * at + 4 * fq + r) * 64 + 16 * ct + fr] = (bf16)f2bf(acc[r]); }
    }
}
__device__ __forceinline__ void phase_ret_carry(Frame& F, CArgs A, int l) {
    const bf16* UB = (const bf16*)(A->ws + WS_UB); bf16* RP = (bf16*)(A->ws + WS_RP);
    const int nthr = (F.G + 3) / 4 * NWAVES * 64;
#pragma unroll 1
    for (int e = (F.vcu >> 2) * NWAVES * 64 + F.tid; e < 32768; e += nthr) {
        const int bh = e >> 12, idx = e & 4095, h = bh & 3; const float dec = exp2f(128.0f * log2f(1.0f - exp2f(-5.0f - (float)h)));
        const bf16* p = UB + (size_t)bh * 64 * 4096 + idx; bf16* o = RP + (size_t)bh * 64 * 4096 + idx; float R = 0.f;
#pragma unroll 1
        for (int n0 = 0; n0 < 64; n0 += 32) { float u[32];
#pragma unroll
            for (int n = 0; n < 32; ++n) u[n] = bf2f(p[(size_t)(n0 + n) * 4096]);
#pragma unroll
            for (int n = 0; n < 32; ++n) { o[(size_t)(n0 + n) * 4096] = (bf16)f2bf(R); R = R * dec + u[n]; } }
    }
}
__device__ __forceinline__ void phase_fox_combine(Frame& F, CArgs A) {
    const bf16* O0 = (const bf16*)(A->ws + WS_FO0); bf16* O1 = (bf16*)(A->ws + WS_YF); const float* L0 = (const float*)(A->ws + WS_FL0); const float* L1 = (const float*)(A->ws + WS_FL1);
#pragma unroll 1
    for (int it = F.vcu * NWAVES * 64 + F.tid; it < M * 32; it += F.G * NWAVES * 64) {
        const int m = it >> 5, c8 = it & 31, h = c8 >> 3; const float l0 = L0[(size_t)m * 4 + h], l1 = L1[(size_t)m * 4 + h];
        if (l0 == -INFINITY) continue;
        const float mx = fmaxf(l0, l1), w0 = exp2f(l0 - mx), w1 = exp2f(l1 - mx), inv = 1.0f / (w0 + w1);
        const v4u a = *(const v4u*)(O0 + (size_t)m * 256 + 8 * c8); v4u* op = (v4u*)(O1 + (size_t)m * 256 + 8 * c8); const v4u c = *op;
        float fa[8], fc[8]; unpack8(a, fa); unpack8(c, fc);
#pragma unroll
        for (int e = 0; e < 8; ++e) fa[e] = (w0 * fa[e] + w1 * fc[e]) * inv;
        v4u o; o.x = pk2(fa[0], fa[1]); o.y = pk2(fa[2], fa[3]); o.z = pk2(fa[4], fa[5]); o.w = pk2(fa[6], fa[7]); *op = o;
    }
}
__device__ __forceinline__ void phase_ret_out(Frame& F, CArgs A, int l, unsigned* ctr) {
    const bf16* MIXIN = (const bf16*)(A->ws + WS_BIG); const float* rope = (const float*)(A->ws + WS_ROPE); const bf16* UB = (const bf16*)(A->ws + WS_RP);
    bf16* YR = (bf16*)(A->ws + WS_YR); const float* rgn = A->in[3] + l * 256;
    const int lane = F.lane, fr = lane & 15, fq = lane >> 4, w = F.wave;
    volatile LAS unsigned* slot = (volatile LAS unsigned*)(F.lds + STG_OFF);
    unsigned nxt = 0u; if (F.tid == 0) nxt = __hip_atomic_fetch_add(ctr, 1u, __ATOMIC_RELAXED, __HIP_MEMORY_SCOPE_AGENT);
#pragma unroll 1
    for (;;) {
        __syncthreads();
        if (F.tid == 0) slot[0] = nxt;
        __syncthreads();
        const int u = (int)__builtin_amdgcn_readfirstlane(slot[0]);
        if (u >= 512) break;
        if (F.tid == 0) nxt = __hip_atomic_fetch_add(ctr, 1u, __ATOMIC_RELAXED, __HIP_MEMORY_SCOPE_AGENT);
        const int bh = u >> 6, n = u & 63, b = bh >> 2, h = bh & 3; const size_t mb = (size_t)b * SEQ + n * 128;
        const float lg2g = log2f(1.0f - exp2f(-5.0f - (float)h));
        unsigned gr[4][4];
#pragma unroll
        for (int r = 0; r < 4; ++r)
#pragma unroll
            for (int c = 0; c < 4; ++c) gr[r][c] = MIXIN[(mb + 16 * w + 4 * fq + r) * MIXLD + C_RETG + h * 64 + 16 * c + fr];
        __syncthreads();
        { const int j = F.tid >> 2, c = F.tid & 3; const bf16* qp = MIXIN + (mb + j) * MIXLD + C_RETQ + h * 64 + 8 * c; const bf16* kp = MIXIN + (mb + j) * MIXLD + C_RETK + h * 64 + 8 * c;
          float lo[8], hi[8], olo[8], ohi[8];
          unpack8(*(const v4u*)qp, lo); unpack8(*(const v4u*)(qp + 32), hi); rot8(rope, n * 128 + j, c, lo, hi, olo, ohi);
          { v4u a, d; a.x = pk2(olo[0] * 0.125f, olo[1] * 0.125f); a.y = pk2(olo[2] * 0.125f, olo[3] * 0.125f); a.z = pk2(olo[4] * 0.125f, olo[5] * 0.125f); a.w = pk2(olo[6] * 0.125f, olo[7] * 0.125f);
            d.x = pk2(ohi[0] * 0.125f, ohi[1] * 0.125f); d.y = pk2(ohi[2] * 0.125f, ohi[3] * 0.125f); d.z = pk2(ohi[4] * 0.125f, ohi[5] * 0.125f); d.w = pk2(ohi[6] * 0.125f, ohi[7] * 0.125f);
            *(LAS v4u*)(F.lds + RL_QS + (j * LQ + 8 * c) * 2) = a; *(LAS v4u*)(F.lds + RL_QS + (j * LQ + 32 + 8 * c) * 2) = d; }
          unpack8(*(const v4u*)kp, lo); unpack8(*(const v4u*)(kp + 32), hi); rot8(rope, n * 128 + j, c, lo, hi, olo, ohi);
          { v4u a, d; a.x = pk2(olo[0], olo[1]); a.y = pk2(olo[2], olo[3]); a.z = pk2(olo[4], olo[5]); a.w = pk2(olo[6], olo[7]);
            d.x = pk2(ohi[0], ohi[1]); d.y = pk2(ohi[2], ohi[3]); d.z = pk2(ohi[4], ohi[5]); d.w = pk2(ohi[6], ohi[7]);
            *(LAS v4u*)(F.lds + RL_KS + (j * LQ + 8 * c) * 2) = a; *(LAS v4u*)(F.lds + RL_KS + (j * LQ + 32 + 8 * c) * 2) = d; } }
        ret_stage_vt(F, MIXIN, mb, h);
        if (n > 0) { const int dk = F.tid >> 3, dv0 = 8 * (F.tid & 7); const v4u rw = *(const v4u*)(UB + (size_t)(bh * 64 + n) * 4096 + dk * 64 + dv0);
            LAS bf16* Rt = (LAS bf16*)(F.lds + RL_KD) + dv0 * LQ + dk; const unsigned ww[4] = {rw.x, rw.y, rw.z, rw.w};
#pragma unroll
            for (int e = 0; e < 4; ++e) { Rt[(2 * e) * LQ] = (bf16)(ww[e] & 0xffffu); Rt[(2 * e + 1) * LQ] = (bf16)(ww[e] >> 16); } }
        __syncthreads();
        const int whalf = w >> 1;
#pragma unroll
        for (int c = 0; c < 8; ++c) { if (c <= 2 * whalf + 1) { f32x4 s = (f32x4){0.f, 0.f, 0.f, 0.f};
                if (c <= w) {
#pragma unroll
                    for (int ks = 0; ks < 2; ++ks) { const rbf16x8 af = *(const LAS rbf16x8*)(F.lds + RL_QS + ((16 * w + fr) * LQ + 32 * ks + 8 * fq) * 2);
                        const rbf16x8 bfr = *(const LAS rbf16x8*)(F.lds + RL_KS + ((16 * c + fr) * LQ + 32 * ks + 8 * fq) * 2);
                        s = __builtin_amdgcn_mfma_f32_16x16x32_bf16(af, bfr, s, 0, 0, 0); } }
#pragma unroll
                for (int r = 0; r < 4; ++r) { const int i = 16 * w + 4 * fq + r, j = 16 * c + fr; const float pv = (j <= i) ? s[r] * __builtin_amdgcn_exp2f((float)(i - j) * lg2g) : 0.f;
                    *(LAS bf16*)(F.lds + RL_PS + (i * LKP + j) * 2) = (bf16)f2bf(pv); } } }
        f32x4 o[4];
#pragma unroll
        for (int c = 0; c < 4; ++c) o[c] = (f32x4){0.f, 0.f, 0.f, 0.f};
        if (n > 0) {
#pragma unroll
            for (int ks = 0; ks < 2; ++ks) { const rbf16x8 af = *(const LAS rbf16x8*)(F.lds + RL_QS + ((16 * w + fr) * LQ + 32 * ks + 8 * fq) * 2);
#pragma unroll
                for (int c = 0; c < 4; ++c) { const rbf16x8 bfr = *(const LAS rbf16x8*)(F.lds + RL_KD + ((16 * c + fr) * LQ + 32 * ks + 8 * fq) * 2);
                    o[c] = __builtin_amdgcn_mfma_f32_16x16x32_bf16(af, bfr, o[c], 0, 0, 0); } }
#pragma unroll
            for (int r = 0; r < 4; ++r) { const float qd = __builtin_amdgcn_exp2f((float)(16 * w + 4 * fq + r + 1) * lg2g);
#pragma unroll
                for (int c = 0; c < 4; ++c) o[c][r] *= qd; }
        }
#pragma unroll
        for (int ks = 0; ks < 4; ++ks) { if (ks <= whalf) { const rbf16x8 af = *(const LAS rbf16x8*)(F.lds + RL_PS + ((16 * w + fr) * LKP + 32 * ks + 8 * fq) * 2);
#pragma unroll
                for (int c = 0; c < 4; ++c) { const rbf16x8 bfr = *(const LAS rbf16x8*)(F.lds + RL_VT + ((16 * c + fr) * LKP + 32 * ks + 8 * fq) * 2);
                    o[c] = __builtin_amdgcn_mfma_f32_16x16x32_bf16(af, bfr, o[c], 0, 0, 0); } } }
#pragma unroll
        for (int r = 0; r < 4; ++r) { const size_t m = mb + 16 * w + 4 * fq + r; float sm = (o[0][r] + o[1][r]) + (o[2][r] + o[3][r]);
            sm = row_sum16(sm);
            const float mean = sm * (1.f / 64.f); float d[4], vs = 0.f;
#pragma unroll
            for (int c = 0; c < 4; ++c) { d[c] = o[c][r] - mean; vs += d[c] * d[c]; }
            vs = row_sum16(vs);
            const float rs = __builtin_amdgcn_rsqf(vs * (1.f / 64.f) + 1e-5f);
#pragma unroll
            for (int c = 0; c < 4; ++c) { const int ch = h * 64 + 16 * c + fr; const float gg = bf2f((bf16)gr[r][c]);
                YR[m * 256 + ch] = (bf16)f2bf(d[c] * rs * rgn[ch] * (gg * sigm(gg))); } }
    }
}
constexpr int PH_PER_LAYER = 11, N_PHASES = 1 + DEPTH * PH_PER_LAYER;
#ifndef PROBE_DUP
#define PROBE_DUP 0
#endif
#ifndef PROBE_VAR
#define PROBE_VAR 0
#endif
#ifndef MK_THRL
#define MK_THRL 64
#define OUT_HI(A) ((bf16*)(A)->out + (size_t)M * D)
#define OUT_LO(A) ((bf16*)(A)->out)
#endif
#ifndef MK_ONE_LAUNCH
#define MK_ONE_LAUNCH 1
#endif
__device__ __forceinline__ Frame make_frame(unsigned char* lds_generic, int wave_s) {
    Frame F;
    asm volatile("" : "+s"(wave_s));
    int lane_v; asm volatile("v_mbcnt_lo_u32_b32 %0, -1, 0\n\tv_mbcnt_hi_u32_b32 %0, -1, %0" : "=v"(lane_v));
    int tid = wave_s * 64 + lane_v;
    int bx = blockIdx.x, G = gridDim.x; asm volatile("" : "+s"(bx), "+s"(G));
    F.lds = (LAS unsigned char*)lds_generic;
    F.MISC = (volatile LAS unsigned*)(F.lds + MISC_OFF);
    F.tid = tid; F.lane = tid & 63; F.wave = __builtin_amdgcn_readfirstlane(tid >> 6);
    F.G = G; F.vcu = (G % 8 == 0) ? (bx % 8) * (G / 8) + bx / 8 : bx; F.bx = bx;
    F.ctl = nullptr;
    return F;
}
#define IN(k) (lo <= (k) && (k) < hi)
#define SEAM(k) do { if (IN(k) && IN((k) + 1)) { int w_ = wave0; asm volatile("" : "+s"(w_)); int l_; asm volatile("v_mbcnt_lo_u32_b32 %0, -1, 0\n\tv_mbcnt_hi_u32_b32 %0, -1, %0" : "=v"(l_)); xcd_barrier(bar, w_ == 0 && l_ == 0); if ((PROBE_DUP >> 20) & 1) { xcd_barrier(bar, w_ == 0 && l_ == 0); xcd_barrier(bar, w_ == 0 && l_ == 0); } } } while (0)
#define WSP(T, off) ((T*)(A->ws + (off)))
#define LOCAL_SEAM(k) do { if (IN(k) && IN((k) + 1)) { asm volatile("s_waitcnt vmcnt(0)" ::: "memory"); __syncthreads(); __builtin_amdgcn_fence(__ATOMIC_ACQUIRE, "agent"); asm volatile("s_waitcnt vmcnt(0)" ::: "memory"); __syncthreads(); } } while (0)
#define BARRIER_NOW() do { int w_ = wave0; asm volatile("" : "+s"(w_)); int l_; asm volatile("v_mbcnt_lo_u32_b32 %0, -1, 0\n\tv_mbcnt_hi_u32_b32 %0, -1, %0" : "=v"(l_)); xcd_barrier(bar, w_ == 0 && l_ == 0); } while (0)
template <int l> __device__ __forceinline__ void run_layer(unsigned char* lds, const XcdBarrier& bar, const int lo, const int hi, const int wave0) {
        const int pb = 1 + l * PH_PER_LAYER;
        if (IN(pb + 0)) { for (int rep_ = 0; rep_ < ((PROBE_DUP >> 0) & 1) + 1; ++rep_) { if (rep_) BARRIER_NOW(); CArgs A = get_args(); Frame F = make_frame(lds, wave0); phase_weights(F, A, l); } SEAM(pb + 0); }
        if (IN(pb + 1)) { for (int rep_ = 0; rep_ < ((PROBE_DUP >> 1) & 1) + 1; ++rep_) { if (rep_) BARRIER_NOW(); CArgs A = get_args(); Frame F = make_frame(lds, wave0); pg8::Gemm g{l == 0 ? WSP(bf16, WS_XB) : OUT_HI(A), WSP(bf16, WS_WIN), M, NMIX, D, 0}; pg8::StaticOrder S; S.init(M, NMIX, F.G, F.bx);
                  pg8::EpiScale<0> E{WSP(bf16, WS_BIG), MIXLD, WSP(float, WS_SS1), WSP(float, WS_FLOG), 11, 11};
                  pg8::gemm_phase<pg8::EpiScale<0>, pg8::StaticOrder, PG8_ALIGN, PG8_SP2>(F.lds + RING_OFF, g, S, E, F.tid); } SEAM(pb + 1); }
        if (IN(pb + 2)) { for (int rep_ = 0; rep_ < ((PROBE_DUP >> 2) & 1) + 1; ++rep_) { if (rep_) BARRIER_NOW(); { CArgs A = get_args(); Frame F = make_frame(lds, wave0); phase_cumsum(F, A, l); if (rep_ == 0) phase_fox_prep(F, A, l); } { CArgs A = get_args(); Frame F = make_frame(lds, wave0); phase_rwkv_prep(F, A, l); } { CArgs A = get_args(); Frame F = make_frame(lds, wave0); phase_ret_state(F, A, l); } } SEAM(pb + 2); }
        if (IN(pb + 3)) { for (int rep_ = 0; rep_ < ((PROBE_DUP >> 3) & 1) + 1; ++rep_) { if (rep_) BARRIER_NOW(); CArgs A = get_args(); Frame F = make_frame(lds, wave0); phase_rwkv_scan1<0>(F, A, l); } { CArgs A = get_args(); Frame F = make_frame(lds, wave0); if ((F.vcu & 3) == 1) phase_ret_carry(F, A, l); } SEAM(pb + 3); }
        if (IN(pb + 4)) { { CArgs A = get_args(); Frame F = make_frame(lds, wave0); if ((F.vcu & 7) == 0) phase_rwkv_carry(F, A, l); }

#if (PROBE_DUP >> 11) & 1
                  BARRIER_NOW(); { CArgs A = get_args(); Frame F = make_frame(lds, wave0); if ((F.vcu & 7) == 0) phase_rwkv_carry(F, A, l); }

#endif
                  #if (PROBE_DUP >> 12) & 1
                  { CArgs A = get_args(); Frame F = make_frame(lds, wave0);
                    const attn_body::AttnTensors AT{(const attn_body::bf16*)WSP(bf16, WS_BIG) + C_FOXQ, (const attn_body::bf16*)WSP(bf16, WS_BIG) + C_FOXK, (const attn_body::bf16*)WSP(bf16, WS_BIG) + C_FOXV,
                        (attn_body::bf16*)WSP(bf16, WS_FO0), (attn_body::bf16*)WSP(bf16, WS_YF), WSP(float, WS_FL0), WSP(float, WS_FL1), WSP(float, WS_CUM), WSP(float, WS_SEGT)};
                    attn_body::attn_phase_queue<MK_THRL, PROBE_VAR>((char*)lds + RING_OFF, AT, fox_skip_threshold(F, A, l), (unsigned*)(A->ws + WS_CTL) + CW_QUEUE + 64 * l + 32, (volatile LAS unsigned*)((LAS unsigned char*)lds + STG_OFF), F.tid); } BARRIER_NOW();
#endif
                  { CArgs A = get_args(); Frame F = make_frame(lds, wave0);
                    const attn_body::AttnTensors AT{(const attn_body::bf16*)WSP(bf16, WS_BIG) + C_FOXQ, (const attn_body::bf16*)WSP(bf16, WS_BIG) + C_FOXK, (const attn_body::bf16*)WSP(bf16, WS_BIG) + C_FOXV,
                        (attn_body::bf16*)WSP(bf16, WS_FO0), (attn_body::bf16*)WSP(bf16, WS_YF), WSP(float, WS_FL0), WSP(float, WS_FL1), WSP(float, WS_CUM), WSP(float, WS_SEGT)};
                    attn_body::attn_phase_queue<MK_THRL>((char*)lds + RING_OFF, AT, fox_skip_threshold(F, A, l), (unsigned*)(A->ws + WS_CTL) + CW_QUEUE + 64 * l, (volatile LAS unsigned*)((LAS unsigned char*)lds + STG_OFF), F.tid); }

                  { CArgs A = get_args(); Frame F = make_frame(lds, wave0); phase_ret_out(F, A, l, (unsigned*)(A->ws + WS_CTL) + CW_QUEUE + 64 * l + 16); }
                  SEAM(pb + 4); }
        if (IN(pb + 5)) { for (int rep_ = 0; rep_ < ((PROBE_DUP >> 5) & 1) + 1; ++rep_) { if (rep_) BARRIER_NOW(); { CArgs A = get_args(); Frame F = make_frame(lds, wave0); phase_rwkv_fix(F, A, l); if ((PROBE_DUP >> 16) & 1) { BARRIER_NOW(); phase_rwkv_fix(F, A, l); } }  { CArgs A = get_args(); Frame F = make_frame(lds, wave0); phase_fox_combine(F, A); } } SEAM(pb + 5); }
        if (IN(pb + 6)) { for (int rep_ = 0; rep_ < ((PROBE_DUP >> 6) & 1) + 1; ++rep_) { if (rep_) BARRIER_NOW(); CArgs A = get_args(); Frame F = make_frame(lds, wave0); pg8::Gemm g{l == 0 ? WSP(bf16, WS_XB) : OUT_HI(A), WSP(bf16, WS_WGATE), M, NGATE, D, 0}; pg8::StaticOrder S; S.init(M, NGATE, F.G, F.bx);
                  pg8::EpiScale<1> E{WSP(bf16, WS_BIG), NGATE, WSP(float, WS_SS1), nullptr, -1, 12};
                  pg8::gemm_phase<pg8::EpiScale<1>, pg8::StaticOrder, PG8_ALIGN, PG8_SP2>(F.lds + RING_OFF, g, S, E, F.tid); } SEAM(pb + 6); }
        if (IN(pb + 7)) { for (int rep_ = 0; rep_ < ((PROBE_DUP >> 7) & 1) + 1; ++rep_) { if (rep_) BARRIER_NOW();
                  { CArgs A = get_args(); Frame F = make_frame(lds, wave0); pg8::StaticOrder S; S.init(2 * M, D, F.G, F.bx);
                    pg8::gemm_phase_seg<pg8::StaticOrder>(F.lds + RING_OFF, WSP(bf16, WS_YR), WSP(bf16, WS_YF), WSP(bf16, WS_YW), WSP(bf16, WS_PBR), WSP(bf16, WS_BIG), WSP(bf16, WS_XB), S, F.tid); }
                  } SEAM(pb + 7); }
        if (IN(pb + 8)) { if ((PROBE_DUP >> 8) & 1) { CArgs A = get_args(); Frame F = make_frame(lds, wave0); pg8::Gemm g{WSP(bf16, WS_XB), WSP(bf16, WS_WOUT), M, D, D, 0}; pg8::StaticOrder S; S.init(M, D, F.G, F.bx); pg8::EpiProbe E{A->out, A->ph_hi < 0};
                  pg8::gemm_phase<pg8::EpiProbe, pg8::StaticOrder, PG8_ALIGN, PG8_SP2>(F.lds + RING_OFF, g, S, E, F.tid); BARRIER_NOW(); }
                  CArgs A = get_args(); Frame F = make_frame(lds, wave0); pg8::Gemm g{WSP(bf16, WS_XB), WSP(bf16, WS_WOUT), M, D, D, 0}; pg8::StaticOrder S; S.init(M, D, F.G, F.bx);
                  if constexpr (l == 0) { pg8::EpiResid<true, false> E{A->in[0], nullptr, nullptr, nullptr, WSP(bf16, WS_RB), WSP(bf16, WS_XLO), WSP(float, WS_SS2)};
                      pg8::gemm_phase<pg8::EpiResid<true, false>, pg8::StaticOrder, false, PG8_SP2>(F.lds + RING_OFF, g, S, E, F.tid); }
                  else { pg8::EpiResid<false, false> E{nullptr, OUT_HI(A), OUT_LO(A), nullptr, WSP(bf16, WS_RB), WSP(bf16, WS_XLO), WSP(float, WS_SS2)};
                      pg8::gemm_phase<pg8::EpiResid<false, false>, pg8::StaticOrder, false, PG8_SP2>(F.lds + RING_OFF, g, S, E, F.tid); }
                  SEAM(pb + 8); }
        if (IN(pb + 9)) { for (int rep_ = 0; rep_ < ((PROBE_DUP >> 9) & 1) + 1; ++rep_) { if (rep_) BARRIER_NOW(); CArgs A = get_args(); Frame F = make_frame(lds, wave0); pg8::Gemm g{WSP(bf16, WS_RB), WSP(bf16, WS_WGU), M, NGU, D, 0}; pg8::HalfTailOrder S; S.init(M, NGU, F.G, F.bx);
                  pg8::EpiSwiglu E{WSP(bf16, WS_BIG), WSP(float, WS_SS2)};
                  pg8::gemm_phase<pg8::EpiSwiglu, pg8::HalfTailOrder, PG8_ALIGN, PG8_SP2>(F.lds + RING_OFF, g, S, E, F.tid); } SEAM(pb + 9); }
        if (IN(pb + 10)) { if ((PROBE_DUP >> 10) & 1) { CArgs A = get_args(); Frame F = make_frame(lds, wave0); pg8::Gemm g{WSP(bf16, WS_BIG), WSP(bf16, WS_WDOWN), M, D, DFF, 0}; pg8::StaticOrder S; S.init(M, D, F.G, F.bx); pg8::EpiProbe E{A->out, A->ph_hi < 0};
                  pg8::gemm_phase<pg8::EpiProbe, pg8::StaticOrder, PG8_ALIGN, PG8_SP2>(F.lds + RING_OFF, g, S, E, F.tid); BARRIER_NOW(); }
                  CArgs A = get_args(); Frame F = make_frame(lds, wave0); pg8::Gemm g{WSP(bf16, WS_BIG), WSP(bf16, WS_WDOWN), M, D, DFF, 0}; pg8::StaticOrder S; S.init(M, D, F.G, F.bx);
                  if constexpr (l == DEPTH - 1) { pg8::EpiResid<false, true> E{nullptr, WSP(bf16, WS_RB), WSP(bf16, WS_XLO), A->out, nullptr, nullptr, nullptr};
                      pg8::gemm_phase<pg8::EpiResid<false, true>, pg8::StaticOrder, false, PG8_SP2>(F.lds + RING_OFF, g, S, E, F.tid); }
                  else { pg8::EpiResid<false, false> E{nullptr, WSP(bf16, WS_RB), WSP(bf16, WS_XLO), nullptr, OUT_HI(A), OUT_LO(A), WSP(float, WS_SS1)};
                      pg8::gemm_phase<pg8::EpiResid<false, false>, pg8::StaticOrder, false, PG8_SP2>(F.lds + RING_OFF, g, S, E, F.tid); }
                  SEAM(pb + 10); }
    }
#ifndef MK_NO_PK
#define MK_NO_PK 0
#endif
#if MK_NO_PK
#define MK_KATTR __attribute__((target("no-packed-fp32-ops")))
#else
#define MK_KATTR
#endif
__global__ void __launch_bounds__(NWAVES * 64, 2) MK_KATTR mega_fwd(Args args) {
    extern __shared__ __attribute__((aligned(16))) unsigned char lds[];
    const int wave0 = __builtin_amdgcn_readfirstlane((int)threadIdx.x >> 6);
    { const int tid0 = threadIdx.x;
      for (int u = tid0; u < (LDS_BYTES - LDSCTL_OFF) / 4; u += NWAVES * 64) ((LAS unsigned*)((LAS unsigned char*)lds + LDSCTL_OFF))[u] = 0u; }
    __syncthreads();
    XcdBarrier bar = xcd_barrier_post((unsigned*)((gu32*)(args.ws + WS_CTL) + CW_BAR), (volatile LAS unsigned*)((LAS unsigned char*)lds + MISC_OFF) + 8);
    const int lo = args.ph_lo, hi = args.ph_hi;
    if (IN(0)) { CArgs A = get_args(); Frame F = make_frame(lds, wave0); phase_prologue(F, A); }
    run_layer<0>(lds, bar, lo, hi, wave0);
    run_layer<1>(lds, bar, lo, hi, wave0);
}

#undef IN
#undef SEAM
#undef WSP
#undef LOCAL_SEAM
#undef BARRIER_NOW
extern "C" void kernel_launch(void* const* d_in, const int* in_sizes, int n_in, void* d_out, int out_size, void* d_ws, size_t ws_size, hipStream_t stream) {
    static int grid = 0;
    if (grid == 0) {
        if (n_in != 24 || in_sizes[0] != M * D || out_size != M * D || ws_size < WS_END) { fprintf(stderr, "kernel_launch: unexpected shapes (n_in %d, in0 %d, out %d, ws %zu); nothing launched\n", n_in, n_in > 0 ? in_sizes[0] : -1, out_size, ws_size); grid = -1; return; }
        int dev = 0, cus = 0;
        if (hipGetDevice(&dev) != hipSuccess || hipDeviceGetAttribute(&cus, hipDeviceAttributeMultiprocessorCount, dev) != hipSuccess) { grid = -1; return; }
        if (hipFuncSetAttribute((const void*)mega_fwd, hipFuncAttributeMaxDynamicSharedMemorySize, LDS_BYTES) != hipSuccess) { fprintf(stderr, "kernel_launch: hipFuncSetAttribute failed\n"); grid = -1; return; }
        (void)hipGetLastError();
        grid = cus;
    }
    if (grid < 0) return;
    if (hipMemsetAsync((char*)d_ws + WS_CTL, 0, CTL_ZERO_BYTES, stream) != hipSuccess) return;
    Args a{};
    for (int i = 0; i < 24; ++i) a.in[i] = (const float*)d_in[i];
    a.out = (float*)d_out; a.ws = (unsigned char*)d_ws;
#if MK_ONE_LAUNCH
    a.ph_lo = 0; a.ph_hi = N_PHASES;
    hipLaunchKernelGGL(mega_fwd, dim3(grid), dim3(NWAVES * 64), LDS_BYTES, stream, a);
#else
    for (int ph = 0; ph < N_PHASES; ++ph) { a.ph_lo = ph; a.ph_hi = ph + 1;
        hipLaunchKernelGGL(mega_fwd, dim3(grid), dim3(NWAVES * 64), LDS_BYTES, stream, a); }
#endif
}
```
